# Optimizing an MI355X kernel written in HIP

```python
import jax, jax.numpy as jnp
from jax import lax
import numpy as np

D_MODEL = 1024
BATCH = 8
SEQ = 2048
DEPTH = 4

N_MIXERS = 3
DEEPNORM_ALPHA = (2.0 * DEPTH) ** 0.25
DEEPNORM_BETA = (8.0 * DEPTH) ** -0.25
LN_EPS = 1e-5
NEG_INF = -1e30

CONV_KERNEL = 31
SHORT_KERNEL = 3
NSA_HEADS = 16
NSA_KV_HEADS = 4
NSA_GROUP = NSA_HEADS // NSA_KV_HEADS
HEAD_DIM = D_MODEL // NSA_HEADS
CMP_BLOCK = 32
CMP_STRIDE = 16
SLC_BLOCK = 64
SLC_TOP_N = 16
SLC_FORCED_LOCAL = 2
FORCE_BONUS = 1e4
WINDOW = 512
PHI_HIDDEN = 2 * HEAD_DIM
NSA_QBLK = 64
NSA_IN_COLS = NSA_HEADS * HEAD_DIM + 6 * NSA_KV_HEADS * HEAD_DIM + 3 * NSA_HEADS
D_FF = 2816
N_EXPERTS = 8
TOP_K = 2
D_FF_EXPERT = 3584

kernel_name = "hybrid_conformer_shortconv_nsa_moe_deepnorm"


def _count(period, phase):
    return len(range(phase, DEPTH, period))


def _layer_norm(x, g, b):
    xf = x.astype(jnp.float32)
    mu = jnp.mean(xf, -1, keepdims=True)
    var = jnp.mean(jnp.square(xf - mu), -1, keepdims=True)
    y = (xf - mu) * lax.rsqrt(var + LN_EPS)
    return (y * g.astype(jnp.float32) + b.astype(jnp.float32)).astype(x.dtype)


def _causal_depthwise_conv(x, w):
    k = w.shape[0]
    return lax.conv_general_dilated(
        x, w[:, None, :], window_strides=(1,), padding=[(k - 1, 0)],
        dimension_numbers=("NWC", "WIO", "NWC"), feature_group_count=x.shape[-1])


def _masked_softmax(s, mask):
    s = jnp.where(mask, s.astype(jnp.float32), NEG_INF)
    m = jnp.max(s, -1, keepdims=True)
    e = jnp.exp(s - m) * mask
    return e / jnp.maximum(jnp.sum(e, -1, keepdims=True), 1e-30)


def conformer_conv(x, w_in, w_dw, b_dw, ln_g, ln_b, w_out):
    a, gate = jnp.split(x @ w_in, 2, axis=-1)
    u = a * jax.nn.sigmoid(gate)
    u = _causal_depthwise_conv(u, w_dw) + b_dw
    u = jax.nn.silu(_layer_norm(u, ln_g, ln_b))
    return u @ w_out


def short_gated_conv(x, w_in, w_conv, w_out):
    b_gate, c_gate, h = jnp.split(x @ w_in, 3, axis=-1)
    y = b_gate * _causal_depthwise_conv(c_gate * h, w_conv)
    return y @ w_out


def _compress(kv, pe, w1, w2):
    B, T, Hk, dh = kv.shape
    n_cmp = (T - CMP_BLOCK) // CMP_STRIDE + 1
    idx = jnp.arange(n_cmp)[:, None] * CMP_STRIDE + jnp.arange(CMP_BLOCK)[None, :]
    blocks = kv[:, idx] + pe[:, None, :]
    blocks = jnp.moveaxis(blocks, 3, 1).reshape(B, Hk, n_cmp, CMP_BLOCK * dh)
    return jax.nn.gelu(blocks @ w1) @ w2


def native_sparse_attention(x, w_in, pe_k, pe_v, wk1, wk2, wv1, wv2, w_out):
    B, T, _ = x.shape
    H, Hk, G, dh = NSA_HEADS, NSA_KV_HEADS, NSA_GROUP, HEAD_DIM
    qd, kd = H * dh, Hk * dh
    cuts = [qd, qd + kd, qd + 2 * kd, qd + 3 * kd, qd + 4 * kd, qd + 5 * kd, qd + 6 * kd]
    q, kc, vc, ks, vs, kw, vw, g = jnp.split(x @ w_in, cuts, axis=-1)
    q = q.reshape(B, T, Hk, G, dh).transpose(0, 2, 3, 1, 4) * (dh ** -0.5)
    kv_shape = (B, T, Hk, dh)
    kc, vc = kc.reshape(kv_shape), vc.reshape(kv_shape)
    ks = ks.reshape(kv_shape).transpose(0, 2, 1, 3)
    vs = vs.reshape(kv_shape).transpose(0, 2, 1, 3)
    kw = kw.reshape(kv_shape).transpose(0, 2, 1, 3)
    vw = vw.reshape(kv_shape).transpose(0, 2, 1, 3)
    t_pos = jnp.arange(T)

    k_cmp = _compress(kc, pe_k, wk1, wk2)
    v_cmp = _compress(vc, pe_v, wv1, wv2)
    n_cmp = k_cmp.shape[2]
    cmp_start = jnp.arange(n_cmp) * CMP_STRIDE
    mask_c = (cmp_start + CMP_BLOCK - 1)[None, :] <= t_pos[:, None]
    p_cmp = _masked_softmax(jnp.einsum("bhgtd,bhcd->bhgtc", q, k_cmp), mask_c)
    o_cmp = jnp.einsum("bhgtc,bhcd->bhgtd", p_cmp.astype(v_cmp.dtype), v_cmp)

    n_slc = T // SLC_BLOCK
    blk = jnp.arange(n_slc)
    slc_start = blk * SLC_BLOCK
    overlap = ((cmp_start[:, None] < (slc_start + SLC_BLOCK)[None, :]) &
               ((cmp_start + CMP_BLOCK)[:, None] > slc_start[None, :])).astype(jnp.float32)
    imp = jnp.einsum("bhgtc,cn->bhtn", p_cmp, overlap)
    valid = slc_start[None, :] <= t_pos[:, None]
    d_cur = (t_pos // SLC_BLOCK)[:, None] - blk[None, :]
    forced = (blk[None, :] == 0) | ((d_cur >= 0) & (d_cur < SLC_FORCED_LOCAL))
    score = jnp.where(forced, FORCE_BONUS, jnp.where(valid, imp, NEG_INF))
    top_n = min(SLC_TOP_N, n_slc)
    _, sel = lax.top_k(score, top_n)

    ks_blk = ks.reshape(B, Hk, n_slc, SLC_BLOCK, dh)
    vs_blk = vs.reshape(B, Hk, n_slc, SLC_BLOCK, dh)
    kw_pad = jnp.pad(kw, ((0, 0), (0, 0), (WINDOW, 0), (0, 0)))
    vw_pad = jnp.pad(vw, ((0, 0), (0, 0), (WINDOW, 0), (0, 0)))
    QB = NSA_QBLK
    nq = T // QB
    q_blocks = jnp.moveaxis(q.reshape(B, Hk, G, nq, QB, dh), 3, 0)
    sel_blocks = jnp.moveaxis(sel.reshape(B, Hk, nq, QB, top_n), 2, 0)
    bi = jnp.arange(B)[:, None, None, None]
    hi = jnp.arange(Hk)[None, :, None, None]

    def local_branches(args):
        qi, q_b, sel_b = args
        t_b = qi * QB + jnp.arange(QB)
        k_sel = ks_blk[bi, hi, sel_b]
        v_sel = vs_blk[bi, hi, sel_b].reshape(B, Hk, QB, top_n * SLC_BLOCK, dh)
        pos = sel_b[..., None] * SLC_BLOCK + jnp.arange(SLC_BLOCK)
        mask_s = (pos <= t_b[:, None, None]).reshape(B, Hk, 1, QB, top_n * SLC_BLOCK)
        s_sel = jnp.einsum("bhgqd,bhqnsd->bhgqns", q_b, k_sel).reshape(B, Hk, G, QB, top_n * SLC_BLOCK)
        p_sel = _masked_softmax(s_sel, mask_s)
        o_sel = jnp.einsum("bhgqk,bhqkd->bhgqd", p_sel.astype(v_sel.dtype), v_sel)
        k_win = lax.dynamic_slice_in_dim(kw_pad, qi * QB, WINDOW + QB, axis=2)
        v_win = lax.dynamic_slice_in_dim(vw_pad, qi * QB, WINDOW + QB, axis=2)
        kpos = qi * QB - WINDOW + jnp.arange(WINDOW + QB)
        diff = t_b[:, None] - kpos[None, :]
        mask_w = (diff >= 0) & (diff < WINDOW) & (kpos[None, :] >= 0)
        p_win = _masked_softmax(jnp.einsum("bhgqd,bhkd->bhgqk", q_b, k_win), mask_w)
        o_win = jnp.einsum("bhgqk,bhkd->bhgqd", p_win.astype(v_win.dtype), v_win)
        return o_sel, o_win

    o_sel, o_win = lax.map(local_branches, (jnp.arange(nq), q_blocks, sel_blocks))
    o_sel = jnp.moveaxis(o_sel, 0, 3).reshape(B, Hk, G, T, dh)
    o_win = jnp.moveaxis(o_win, 0, 3).reshape(B, Hk, G, T, dh)

    gates = jax.nn.sigmoid(g.reshape(B, T, Hk, G, 3).transpose(0, 2, 3, 1, 4))
    o = gates[..., 0:1] * o_cmp + gates[..., 1:2] * o_sel + gates[..., 2:3] * o_win
    o = o.transpose(0, 3, 1, 2, 4).reshape(B, T, H * dh)
    return o @ w_out


def swiglu(x, w_gate, w_up, w_down):
    return (jax.nn.silu(x @ w_gate) * (x @ w_up)) @ w_down


def moe_swiglu(x, w_router, w_gate, w_up, w_down):
    logits = (x @ w_router).astype(jnp.float32)
    top_val, top_idx = lax.top_k(logits, TOP_K)
    wts = jax.nn.softmax(top_val, axis=-1)
    gates = jnp.sum(jax.nn.one_hot(top_idx, N_EXPERTS, dtype=jnp.float32) * wts[..., None], axis=-2)
    out = jnp.zeros_like(x)
    for e in range(N_EXPERTS):
        h = jax.nn.silu(x @ w_gate[e]) * (x @ w_up[e])
        out = out + gates[..., e:e + 1].astype(x.dtype) * (h @ w_down[e])
    return out


def setup_inputs(seed: int = 0) -> dict:
    key = jax.random.key(seed)
    ks = iter(jax.random.split(key, 40))
    f32 = jnp.float32
    D, dh = D_MODEL, HEAD_DIM
    nA, nB, nC = _count(N_MIXERS, 0), _count(N_MIXERS, 1), _count(N_MIXERS, 2)
    nDense, nMoE = _count(2, 0), _count(2, 1)

    def nrm(shape, scale):
        return jax.random.normal(next(ks), shape, f32) * scale

    def gain(shape):
        return 1.0 + nrm(shape, 0.02)

    beta = DEEPNORM_BETA
    return {
        "x": nrm((BATCH, SEQ, D), 1.0),
        "ln_mix_g": gain((DEPTH, D)),
        "ln_mix_b": nrm((DEPTH, D), 0.02),
        "ln_ffn_g": gain((DEPTH, D)),
        "ln_ffn_b": nrm((DEPTH, D), 0.02),
        "conf_w_in": nrm((nA, D, 2 * D), D ** -0.5),
        "conf_w_dw": nrm((nA, CONV_KERNEL, D), CONV_KERNEL ** -0.5),
        "conf_b_dw": nrm((nA, D), 0.02),
        "conf_ln_g": gain((nA, D)),
        "conf_ln_b": nrm((nA, D), 0.02),
        "conf_w_out": nrm((nA, D, D), beta * D ** -0.5),
        "sc_w_in": nrm((nB, D, 3 * D), D ** -0.5),
        "sc_w_conv": nrm((nB, SHORT_KERNEL, D), SHORT_KERNEL ** -0.5),
        "sc_w_out": nrm((nB, D, D), beta * D ** -0.5),
        "nsa_w_in": nrm((nC, D, NSA_IN_COLS), D ** -0.5),
        "nsa_pe_k": nrm((nC, CMP_BLOCK, dh), 0.1),
        "nsa_pe_v": nrm((nC, CMP_BLOCK, dh), 0.1),
        "nsa_wk1": nrm((nC, CMP_BLOCK * dh, PHI_HIDDEN), (CMP_BLOCK * dh) ** -0.5),
        "nsa_wk2": nrm((nC, PHI_HIDDEN, dh), PHI_HIDDEN ** -0.5),
        "nsa_wv1": nrm((nC, CMP_BLOCK * dh, PHI_HIDDEN), (CMP_BLOCK * dh) ** -0.5),
        "nsa_wv2": nrm((nC, PHI_HIDDEN, dh), PHI_HIDDEN ** -0.5),
        "nsa_w_out": nrm((nC, D, D), beta * D ** -0.5),
        "ffn_w_gate": nrm((nDense, D, D_FF), D ** -0.5),
        "ffn_w_up": nrm((nDense, D, D_FF), D ** -0.5),
        "ffn_w_down": nrm((nDense, D_FF, D), beta * D_FF ** -0.5),
        "moe_w_router": nrm((nMoE, D, N_EXPERTS), D ** -0.5),
        "moe_w_gate": nrm((nMoE, N_EXPERTS, D, D_FF_EXPERT), D ** -0.5),
        "moe_w_up": nrm((nMoE, N_EXPERTS, D, D_FF_EXPERT), D ** -0.5),
        "moe_w_down": nrm((nMoE, N_EXPERTS, D_FF_EXPERT, D), beta * D_FF_EXPERT ** -0.5),
    }


def reference(x, ln_mix_g, ln_mix_b, ln_ffn_g, ln_ffn_b,
              conf_w_in, conf_w_dw, conf_b_dw, conf_ln_g, conf_ln_b, conf_w_out,
              sc_w_in, sc_w_conv, sc_w_out,
              nsa_w_in, nsa_pe_k, nsa_pe_v, nsa_wk1, nsa_wk2, nsa_wv1, nsa_wv2, nsa_w_out,
              ffn_w_gate, ffn_w_up, ffn_w_down,
              moe_w_router, moe_w_gate, moe_w_up, moe_w_down):
    for i in range(DEPTH):
        kind, j = i % N_MIXERS, i // N_MIXERS
        if kind == 0:
            mix = conformer_conv(x, conf_w_in[j], conf_w_dw[j], conf_b_dw[j],
                                 conf_ln_g[j], conf_ln_b[j], conf_w_out[j])
        elif kind == 1:
            mix = short_gated_conv(x, sc_w_in[j], sc_w_conv[j], sc_w_out[j])
        else:
            mix = native_sparse_attention(x, nsa_w_in[j], nsa_pe_k[j], nsa_pe_v[j],
                                          nsa_wk1[j], nsa_wk2[j], nsa_wv1[j], nsa_wv2[j],
                                          nsa_w_out[j])
        x = _layer_norm(DEEPNORM_ALPHA * x + mix, ln_mix_g[i], ln_mix_b[i])
        f = i // 2
        if i % 2 == 0:
            ffn = swiglu(x, ffn_w_gate[f], ffn_w_up[f], ffn_w_down[f])
        else:
            ffn = moe_swiglu(x, moe_w_router[f], moe_w_gate[f], moe_w_up[f], moe_w_down[f])
        x = _layer_norm(DEEPNORM_ALPHA * x + ffn, ln_ffn_g[i], ln_ffn_b[i])
    return x
```

```cpp
#include <hip/hip_runtime.h>
#include <cstdio>
#include <cstdint>

constexpr int BATCH = 8, SEQ = 2048, DM = 1024, MTOK = BATCH * SEQ, DEPTH = 4;
constexpr int CONV_K = 31, SHORT_K = 3;
constexpr int NH = 16, NKV = 4, NG = 4, HD = 64;
constexpr int CMP_BLOCK = 32, CMP_STRIDE = 16, NCMP = (SEQ - CMP_BLOCK) / CMP_STRIDE + 1;
constexpr int SLC_BLOCK = 64, NSLC = SEQ / SLC_BLOCK, TOPN = 16, WINDOW = 512, PHI = 128;
constexpr int NSA_COLS = NH * HD + 6 * NKV * HD + 3 * NH;
constexpr int DFF = 2816, NEXP = 8, DFFE = 3584;
constexpr float LN_EPS = 1e-5f;
#define ALPHA_F 1.681792830507429f

typedef float f32x16 __attribute__((ext_vector_type(16)));

__device__ __forceinline__ float wave_sum(float v) {
#pragma unroll
    for (int o = 1; o < 64; o <<= 1) v += __shfl_xor(v, o);
    return v;
}
__device__ __forceinline__ float block_sum256(float v, float* red) {
    v = wave_sum(v);
    __syncthreads();
    if ((threadIdx.x & 63) == 0) red[threadIdx.x >> 6] = v;
    __syncthreads();
    return (red[0] + red[1]) + (red[2] + red[3]);
}
__device__ __forceinline__ float sigmoidf_(float x) { return 1.0f / (1.0f + expf(-x)); }
__device__ __forceinline__ float siluf_(float x) { return x / (1.0f + expf(-x)); }
__device__ __forceinline__ float gelu_tanh(float x) { return 0.5f * x * (1.0f + tanhf(0.7978845608028654f * (x + 0.044715f * x * x * x))); }

__global__ __launch_bounds__(256) void ngemm(const float* __restrict__ A, int lda, const int* __restrict__ gather, const int* __restrict__ mcount, int M,
                                             const float* __restrict__ W, int ldw, int N, int K, float* __restrict__ C, int ldc) {
    __shared__ float As[128][17];
    __shared__ float Bs[16][132];
    if (mcount) { const int mc = *mcount; M = mc < M ? mc : M; }
    const int bm = blockIdx.y * 128, bn = blockIdx.x * 128;
    if (bm >= M) return;
    const int tid = threadIdx.x, lane = tid & 63, w = tid >> 6, wr = w >> 1, wc = w & 1;
    const int ar = tid >> 1, ak = (tid & 1) * 8;
    const int arow = bm + ar; const bool aok = arow < M;
    const int asrc = aok ? (gather ? gather[arow] : arow) : 0;
    const float* ap = A + (size_t)asrc * lda + ak;
    const int bk = tid >> 4, bc = (tid & 15) * 8;
    const bool bok = (bn + bc + 8) <= N;
    const float* bp = W + (size_t)bk * ldw + bn + bc;
    f32x16 acc[2][2];
#pragma unroll
    for (int i = 0; i < 2; ++i)
#pragma unroll
        for (int j = 0; j < 2; ++j)
#pragma unroll
            for (int r = 0; r < 16; ++r) acc[i][j][r] = 0.f;
    for (int k0 = 0; k0 < K; k0 += 16) {
        float4 a0 = make_float4(0.f, 0.f, 0.f, 0.f), a1 = a0, b0 = a0, b1 = a0;
        if (aok) { a0 = *(const float4*)(ap + k0); a1 = *(const float4*)(ap + k0 + 4); }
        if (bok) { b0 = *(const float4*)(bp + (size_t)k0 * ldw); b1 = *(const float4*)(bp + (size_t)k0 * ldw + 4); }
        __syncthreads();
        As[ar][ak + 0] = a0.x; As[ar][ak + 1] = a0.y; As[ar][ak + 2] = a0.z; As[ar][ak + 3] = a0.w;
        As[ar][ak + 4] = a1.x; As[ar][ak + 5] = a1.y; As[ar][ak + 6] = a1.z; As[ar][ak + 7] = a1.w;
        *(float4*)&Bs[bk][bc] = b0; *(float4*)&Bs[bk][bc + 4] = b1;
        __syncthreads();
#pragma unroll
        for (int kk = 0; kk < 16; kk += 2) {
            float a[2], b[2];
#pragma unroll
            for (int i = 0; i < 2; ++i) a[i] = As[wr * 64 + i * 32 + (lane & 31)][kk + (lane >> 5)];
#pragma unroll
            for (int j = 0; j < 2; ++j) b[j] = Bs[kk + (lane >> 5)][wc * 64 + j * 32 + (lane & 31)];
#pragma unroll
            for (int i = 0; i < 2; ++i)
#pragma unroll
                for (int j = 0; j < 2; ++j) acc[i][j] = __builtin_amdgcn_mfma_f32_32x32x2f32(a[i], b[j], acc[i][j], 0, 0, 0);
        }
    }
#pragma unroll
    for (int i = 0; i < 2; ++i)
#pragma unroll
        for (int j = 0; j < 2; ++j)
#pragma unroll
            for (int r = 0; r < 16; ++r) {
                const int row = bm + wr * 64 + i * 32 + (r & 3) + 8 * (r >> 2) + 4 * (lane >> 5);
                const int col = bn + wc * 64 + j * 32 + (lane & 31);
                if (row < M && col < N) C[(size_t)row * ldc + col] = acc[i][j][r];
            }
}

__global__ void n_glu(const float* __restrict__ t, float* __restrict__ u) {
    const size_t i = (size_t)blockIdx.x * blockDim.x + threadIdx.x; if (i >= (size_t)MTOK * DM) return;
    const size_t m = i / DM; const int c = (int)(i % DM);
    u[i] = t[m * 2 * DM + c] * sigmoidf_(t[m * 2 * DM + DM + c]);
}
__global__ __launch_bounds__(256) void n_conf_dw(const float* __restrict__ u, const float* __restrict__ wdw, const float* __restrict__ bdw, const float* __restrict__ g, const float* __restrict__ bb, float* __restrict__ out) {
    __shared__ float red[8];
    const int m = blockIdx.x, t = m % SEQ, c = threadIdx.x * 4;
    float4 acc = *(const float4*)(bdw + c);
    for (int k = 0; k < CONV_K; ++k) { const int tt = t - (CONV_K - 1) + k; if (tt < 0) continue;
        const float4 w = *(const float4*)(wdw + k * DM + c), x = *(const float4*)(u + (size_t)(m - t + tt) * DM + c);
        acc.x += w.x * x.x; acc.y += w.y * x.y; acc.z += w.z * x.z; acc.w += w.w * x.w; }
    const float mean = block_sum256((acc.x + acc.y) + (acc.z + acc.w), red) * (1.0f / DM);
    const float dx = acc.x - mean, dy = acc.y - mean, dz = acc.z - mean, dw = acc.w - mean;
    const float var = block_sum256((dx * dx + dy * dy) + (dz * dz + dw * dw), red) * (1.0f / DM);
    const float rstd = 1.0f / sqrtf(var + LN_EPS);
    const float4 gg = *(const float4*)(g + c), b4 = *(const float4*)(bb + c);
    float4 o; o.x = siluf_(dx * rstd * gg.x + b4.x); o.y = siluf_(dy * rstd * gg.y + b4.y); o.z = siluf_(dz * rstd * gg.z + b4.z); o.w = siluf_(dw * rstd * gg.w + b4.w);
    *(float4*)(out + (size_t)m * DM + c) = o;
}
__global__ __launch_bounds__(256) void n_ln_res(const float* __restrict__ x, const float* __restrict__ mix, const float* __restrict__ g, const float* __restrict__ bb, float* __restrict__ xo) {
    __shared__ float red[8];
    const int m = blockIdx.x, c = threadIdx.x * 4;
    const float4 xv = *(const float4*)(x + (size_t)m * DM + c), mv = *(const float4*)(mix + (size_t)m * DM + c);
    float4 v; v.x = ALPHA_F * xv.x + mv.x; v.y = ALPHA_F * xv.y + mv.y; v.z = ALPHA_F * xv.z + mv.z; v.w = ALPHA_F * xv.w + mv.w;
    const float mean = block_sum256((v.x + v.y) + (v.z + v.w), red) * (1.0f / DM);
    const float dx = v.x - mean, dy = v.y - mean, dz = v.z - mean, dw = v.w - mean;
    const float var = block_sum256((dx * dx + dy * dy) + (dz * dz + dw * dw), red) * (1.0f / DM);
    const float rstd = 1.0f / sqrtf(var + LN_EPS);
    const float4 gg = *(const float4*)(g + c), b4 = *(const float4*)(bb + c);
    float4 o; o.x = dx * rstd * gg.x + b4.x; o.y = dy * rstd * gg.y + b4.y; o.z = dz * rstd * gg.z + b4.z; o.w = dw * rstd * gg.w + b4.w;
    *(float4*)(xo + (size_t)m * DM + c) = o;
}
__global__ void n_swiglu(const float* __restrict__ g, const float* __restrict__ u, float* __restrict__ h, const int* __restrict__ mcount, int rows, int n) {
    if (mcount) { const int mc = *mcount; rows = mc < rows ? mc : rows; }
    const size_t i = (size_t)blockIdx.x * blockDim.x + threadIdx.x; if (i >= (size_t)rows * n) return;
    h[i] = siluf_(g[i]) * u[i];
}
__global__ void n_shortconv(const float* __restrict__ t, const float* __restrict__ w, float* __restrict__ y) {
    const size_t i = (size_t)blockIdx.x * blockDim.x + threadIdx.x; if (i >= (size_t)MTOK * DM) return;
    const int m = (int)(i / DM), c = (int)(i % DM), tt = m % SEQ;
    float acc = 0.f;
    for (int k = 0; k < SHORT_K; ++k) { const int ts = tt - (SHORT_K - 1) + k; if (ts < 0) continue;
        const float* r = t + (size_t)(m - tt + ts) * 3 * DM; acc += w[k * DM + c] * (r[DM + c] * r[2 * DM + c]); }
    y[i] = t[(size_t)m * 3 * DM + c] * acc;
}

__global__ __launch_bounds__(128) void n_compress(const float* __restrict__ T, const float* __restrict__ pek, const float* __restrict__ pev, const float* __restrict__ wk1, const float* __restrict__ wk2,
                                                  const float* __restrict__ wv1, const float* __restrict__ wv2, float* __restrict__ cmp) {
    __shared__ float in[CMP_BLOCK * HD]; __shared__ float hid[PHI];
    const int c = blockIdx.x, bh = blockIdx.y, kv = blockIdx.z, b = bh / NKV, hk = bh % NKV, tid = threadIdx.x;
    const float* pe = kv ? pev : pek; const float* w1 = kv ? wv1 : wk1; const float* w2 = kv ? wv2 : wk2;
    const int col0 = NH * HD + kv * NKV * HD + hk * HD;
    for (int i = tid; i < CMP_BLOCK * HD; i += 128) { const int j = i / HD, d = i % HD; in[i] = T[(size_t)(b * SEQ + c * CMP_STRIDE + j) * NSA_COLS + col0 + d] + pe[i]; }
    __syncthreads();
    float a = 0.f;
    for (int i = 0; i < CMP_BLOCK * HD; ++i) a += in[i] * w1[(size_t)i * PHI + tid];
    hid[tid] = gelu_tanh(a);
    __syncthreads();
    if (tid < HD) { float o = 0.f; for (int j = 0; j < PHI; ++j) o += hid[j] * w2[j * HD + tid]; cmp[((size_t)(kv * BATCH * NKV + bh) * 128 + c) * HD + tid] = o; }
}

#define NATT_TILE 32
__device__ __forceinline__ void natt_load_tile(float (*Kt)[HD], float (*Vt)[HD], const float* kp, const float* vp, size_t stride, int nrows) {
    __syncthreads();
    for (int i = threadIdx.x; i < NATT_TILE * HD / 4; i += 256) { const int r = i / (HD / 4), d4 = (i % (HD / 4)) * 4;
        float4 kx = make_float4(0.f, 0.f, 0.f, 0.f), vx = kx;
        if (r < nrows) { kx = *(const float4*)(kp + (size_t)r * stride + d4); vx = *(const float4*)(vp + (size_t)r * stride + d4); }
        *(float4*)&Kt[r][d4] = kx; *(float4*)&Vt[r][d4] = vx; }
    __syncthreads();
}
__global__ __launch_bounds__(256) void n_nsa_attn(const float* __restrict__ T, const float* __restrict__ cmp, float* __restrict__ O) {
    __shared__ float Kt[NATT_TILE][HD]; __shared__ float Vt[NATT_TILE][HD];
    __shared__ float impS[64][NG][NSLC]; __shared__ float scS[64][NSLC + 1];
    const int qi = blockIdx.x, bh = blockIdx.y, b = bh / NKV, hk = bh % NKV, tid = threadIdx.x, g = tid >> 6, tl = tid & 63, t = qi * 64 + tl;
    const size_t mrow = (size_t)b * SEQ + t; const int hcol = (hk * NG + g) * HD;
    float q[HD];
#pragma unroll
    for (int d = 0; d < HD; ++d) q[d] = T[mrow * NSA_COLS + hcol + d] * 0.125f;
    const float* gp = T + mrow * NSA_COLS + (NH * HD + 6 * NKV * HD) + hk * 12 + g * 3;
    const float g0 = sigmoidf_(gp[0]), g1 = sigmoidf_(gp[1]), g2 = sigmoidf_(gp[2]);
    float acc[HD]; float mx, l;
#define NATT_RESET() do { mx = -1e30f; l = 0.f; _Pragma("unroll") for (int d = 0; d < HD; ++d) acc[d] = 0.f; } while (0)
#define NATT_DOT(s, kk) do { s = 0.f; _Pragma("unroll") for (int d = 0; d < HD; d += 4) { const float4 kx = *(const float4*)&Kt[kk][d]; s += q[d] * kx.x + q[d + 1] * kx.y + q[d + 2] * kx.z + q[d + 3] * kx.w; } } while (0)
#define NATT_UPD(s, kk) do { const float mn = fmaxf(mx, s), sc = expf(mx - mn), p = expf(s - mn); l = l * sc + p; mx = mn; \
        _Pragma("unroll") for (int d = 0; d < HD; d += 4) { const float4 vx = *(const float4*)&Vt[kk][d]; acc[d] = acc[d] * sc + p * vx.x; acc[d + 1] = acc[d + 1] * sc + p * vx.y; acc[d + 2] = acc[d + 2] * sc + p * vx.z; acc[d + 3] = acc[d + 3] * sc + p * vx.w; } } while (0)
    float* op = O + mrow * DM + hcol;
    const float* kc = cmp + (size_t)bh * 128 * HD; const float* vc = cmp + (size_t)(BATCH * NKV + bh) * 128 * HD;
    NATT_RESET();
    for (int c0 = 0; c0 < NCMP; c0 += NATT_TILE) {
        natt_load_tile(Kt, Vt, kc + (size_t)c0 * HD, vc + (size_t)c0 * HD, HD, NCMP - c0 < NATT_TILE ? NCMP - c0 : NATT_TILE);
        for (int kk = 0; kk < NATT_TILE; ++kk) { const int c = c0 + kk; if (c < NCMP && c * CMP_STRIDE + CMP_BLOCK - 1 <= t) { float s; NATT_DOT(s, kk); NATT_UPD(s, kk); } }
    }
    { const float inv = g0 / fmaxf(l, 1e-30f);
#pragma unroll
      for (int d = 0; d < HD; d += 4) *(float4*)(op + d) = make_float4(acc[d] * inv, acc[d + 1] * inv, acc[d + 2] * inv, acc[d + 3] * inv); }
    { const float invl = 1.0f / fmaxf(l, 1e-30f); float cur = 0.f, nxt = 0.f;
      for (int c0 = 0; c0 < 128; c0 += NATT_TILE) {
        natt_load_tile(Kt, Vt, kc + (size_t)c0 * HD, vc + (size_t)c0 * HD, HD, NCMP - c0 < NATT_TILE ? NCMP - c0 : NATT_TILE);
        for (int kk = 0; kk < NATT_TILE; ++kk) { const int c = c0 + kk; float p = 0.f;
            if (c < NCMP && c * CMP_STRIDE + CMP_BLOCK - 1 <= t) { float s; NATT_DOT(s, kk); p = expf(s - mx) * invl; }
            cur += p; if ((c & 3) == 3) { nxt = p; impS[tl][g][c >> 2] = cur; cur = nxt; } }
      } }
    __syncthreads();
    if (g == 0) { for (int n = 0; n < NSLC; ++n) { const float imp = (impS[tl][0][n] + impS[tl][1][n]) + (impS[tl][2][n] + impS[tl][3][n]);
        const bool forced = (n == 0) || (n == qi) || (n == qi - 1); const bool valid = n <= qi;
        scS[tl][n] = forced ? 1e4f : (valid ? imp : -1e30f); } }
    __syncthreads();
    unsigned selmask = 0u;
    for (int n = 0; n < NSLC; ++n) { const float sn = scS[tl][n]; int rank = 0;
        for (int m2 = 0; m2 < NSLC; ++m2) { const float sm = scS[tl][m2]; rank += (sm > sn || (sm == sn && m2 < n)) ? 1 : 0; }
        if (rank < TOPN) selmask |= (1u << n); }
    NATT_RESET();
    for (int j = 0; j <= qi; ++j)
        for (int hf = 0; hf < 2; ++hf) { const int p0 = j * 64 + hf * 32;
            const float* kp = T + ((size_t)b * SEQ + p0) * NSA_COLS + (NH * HD + 2 * NKV * HD) + hk * HD; const float* vp = kp + NKV * HD;
            natt_load_tile(Kt, Vt, kp, vp, NSA_COLS, NATT_TILE);
            if ((selmask >> j) & 1u) for (int kk = 0; kk < NATT_TILE; ++kk) if (p0 + kk <= t) { float s; NATT_DOT(s, kk); NATT_UPD(s, kk); } }
    { const float inv = g1 / fmaxf(l, 1e-30f);
#pragma unroll
      for (int d = 0; d < HD; d += 4) { float4 o = *(float4*)(op + d); o.x += acc[d] * inv; o.y += acc[d + 1] * inv; o.z += acc[d + 2] * inv; o.w += acc[d + 3] * inv; *(float4*)(op + d) = o; } }
    NATT_RESET();
    for (int j = (qi >= 8 ? qi - 8 : 0); j <= qi; ++j)
        for (int hf = 0; hf < 2; ++hf) { const int p0 = j * 64 + hf * 32;
            const float* kp = T + ((size_t)b * SEQ + p0) * NSA_COLS + (NH * HD + 4 * NKV * HD) + hk * HD; const float* vp = kp + NKV * HD;
            natt_load_tile(Kt, Vt, kp, vp, NSA_COLS, NATT_TILE);
            for (int kk = 0; kk < NATT_TILE; ++kk) { const int df = t - (p0 + kk); if (df >= 0 && df < WINDOW) { float s; NATT_DOT(s, kk); NATT_UPD(s, kk); } } }
    { const float inv = g2 / fmaxf(l, 1e-30f);
#pragma unroll
      for (int d = 0; d < HD; d += 4) { float4 o = *(float4*)(op + d); o.x += acc[d] * inv; o.y += acc[d + 1] * inv; o.z += acc[d + 2] * inv; o.w += acc[d + 3] * inv; *(float4*)(op + d) = o; } }
#undef NATT_RESET
#undef NATT_DOT
#undef NATT_UPD
}

constexpr int MOE_CAP = 8192;
__global__ __launch_bounds__(256) void n_router(const float* __restrict__ x, const float* __restrict__ wr, int* __restrict__ cnt, int* __restrict__ list, int* __restrict__ tsel, float* __restrict__ twt) {
    const int m = blockIdx.x * 4 + (threadIdx.x >> 6), lane = threadIdx.x & 63;
    float lg[NEXP];
#pragma unroll
    for (int e = 0; e < NEXP; ++e) lg[e] = 0.f;
    for (int k = lane; k < DM; k += 64) { const float xv = x[(size_t)m * DM + k];
#pragma unroll
        for (int e = 0; e < NEXP; ++e) lg[e] += xv * wr[k * NEXP + e]; }
#pragma unroll
    for (int e = 0; e < NEXP; ++e) lg[e] = wave_sum(lg[e]);
    if (lane == 0) {
        int e1 = 0; float v1 = lg[0];
#pragma unroll
        for (int e = 1; e < NEXP; ++e) if (lg[e] > v1) { v1 = lg[e]; e1 = e; }
        int e2 = -1; float v2 = -3.4e38f;
#pragma unroll
        for (int e = 0; e < NEXP; ++e) if (e != e1 && lg[e] > v2) { v2 = lg[e]; e2 = e; }
        const float p2 = expf(v2 - v1), w1 = 1.0f / (1.0f + p2), w2 = p2 / (1.0f + p2);
        const int s1 = atomicAdd(cnt + e1, 1), s2 = atomicAdd(cnt + e2, 1);
        if (s1 < MOE_CAP) list[e1 * MOE_CAP + s1] = m;
        if (s2 < MOE_CAP) list[e2 * MOE_CAP + s2] = m;
        tsel[m * 4 + 0] = e1; tsel[m * 4 + 1] = s1; tsel[m * 4 + 2] = e2; tsel[m * 4 + 3] = s2; twt[m * 2] = w1; twt[m * 2 + 1] = w2;
    }
}
__global__ __launch_bounds__(256) void n_moe_scatter(const float* __restrict__ Y, const int* __restrict__ cnt, const int* __restrict__ list, const int* __restrict__ tsel, const float* __restrict__ twt, int e, float* __restrict__ F) {
    const int slot = blockIdx.x; int c = cnt[e]; c = c < MOE_CAP ? c : MOE_CAP; if (slot >= c) return;
    const int m = list[e * MOE_CAP + slot]; const float w = (tsel[m * 4] == e) ? twt[m * 2] : twt[m * 2 + 1];
    const int col = threadIdx.x * 4; const float4 y = *(const float4*)(Y + (size_t)slot * DM + col); float4 f = *(float4*)(F + (size_t)m * DM + col);
    f.x += w * y.x; f.y += w * y.y; f.z += w * y.z; f.w += w * y.w; *(float4*)(F + (size_t)m * DM + col) = f;
}

static void gemm(hipStream_t st, const float* A, int lda, const int* gather, const int* mcount, int M, const float* W, int ldw, int N, int K, float* C, int ldc) {
    hipLaunchKernelGGL(ngemm, dim3((N + 127) / 128, (M + 127) / 128), dim3(256), 0, st, A, lda, gather, mcount, M, W, ldw, N, K, C, ldc);
}
struct Inputs { const float* p[29]; };
enum { I_X = 0, I_LMG, I_LMB, I_LFG, I_LFB, I_CWIN, I_CWDW, I_CBDW, I_CLNG, I_CLNB, I_CWOUT, I_SWIN, I_SWCONV, I_SWOUT, I_NWIN, I_NPEK, I_NPEV, I_NWK1, I_NWK2, I_NWV1, I_NWV2, I_NWOUT,
       I_FWG, I_FWU, I_FWD, I_MWR, I_MWG, I_MWU, I_MWD };

extern "C" void kernel_launch(void* const* d_in, const int* in_sizes, int n_in, void* d_out, int out_size, void* d_ws, size_t ws_size, hipStream_t stream) {
    (void)in_sizes; (void)n_in; (void)out_size; (void)ws_size;
    Inputs in; for (int i = 0; i < 29; ++i) in.p[i] = (const float*)d_in[i];
    constexpr size_t MiB = 1u << 20;
    unsigned char* ws = (unsigned char*)d_ws;
    float* X0 = (float*)(ws + 0 * MiB);
    float* X1 = (float*)(ws + 64 * MiB);
    float* BA = (float*)(ws + 128 * MiB);
    float* BB = (float*)(ws + 336 * MiB);
    float* BC = (float*)(ws + 544 * MiB);
    float* BD = (float*)(ws + 608 * MiB);
    int* cnt = (int*)(ws + 672 * MiB); int* list = cnt + 64; int* tsel = list + NEXP * MOE_CAP; float* twt = (float*)(tsel + MTOK * 4);
    float* cmp = (float*)(ws + 676 * MiB);
    const float* x = in.p[I_X];
    const int EW = 256;
    for (int i = 0; i < DEPTH; ++i) {
        const int kind = i % 3, j = i / 3, f = i / 2;
        float* mix = BC;
        if (kind == 0) {
            gemm(stream, x, DM, nullptr, nullptr, MTOK, in.p[I_CWIN] + (size_t)j * DM * 2 * DM, 2 * DM, 2 * DM, DM, BA, 2 * DM);
            hipLaunchKernelGGL(n_glu, dim3(MTOK * DM / EW), dim3(EW), 0, stream, BA, BB);
            hipLaunchKernelGGL(n_conf_dw, dim3(MTOK), dim3(256), 0, stream, BB, in.p[I_CWDW] + (size_t)j * CONV_K * DM, in.p[I_CBDW] + j * DM, in.p[I_CLNG] + j * DM, in.p[I_CLNB] + j * DM, BD);
            gemm(stream, BD, DM, nullptr, nullptr, MTOK, in.p[I_CWOUT] + (size_t)j * DM * DM, DM, DM, DM, mix, DM);
        } else if (kind == 1) {
            gemm(stream, x, DM, nullptr, nullptr, MTOK, in.p[I_SWIN] + (size_t)j * DM * 3 * DM, 3 * DM, 3 * DM, DM, BA, 3 * DM);
            hipLaunchKernelGGL(n_shortconv, dim3(MTOK * DM / EW), dim3(EW), 0, stream, BA, in.p[I_SWCONV] + (size_t)j * SHORT_K * DM, BD);
            gemm(stream, BD, DM, nullptr, nullptr, MTOK, in.p[I_SWOUT] + (size_t)j * DM * DM, DM, DM, DM, mix, DM);
        } else {
            gemm(stream, x, DM, nullptr, nullptr, MTOK, in.p[I_NWIN] + (size_t)j * DM * NSA_COLS, NSA_COLS, NSA_COLS, DM, BA, NSA_COLS);
            hipLaunchKernelGGL(n_compress, dim3(NCMP, BATCH * NKV, 2), dim3(128), 0, stream, BA, in.p[I_NPEK] + j * CMP_BLOCK * HD, in.p[I_NPEV] + j * CMP_BLOCK * HD,
                               in.p[I_NWK1] + (size_t)j * CMP_BLOCK * HD * PHI, in.p[I_NWK2] + j * PHI * HD, in.p[I_NWV1] + (size_t)j * CMP_BLOCK * HD * PHI, in.p[I_NWV2] + j * PHI * HD, cmp);
            hipLaunchKernelGGL(n_nsa_attn, dim3(SEQ / 64, BATCH * NKV), dim3(256), 0, stream, BA, cmp, BD);
            gemm(stream, BD, DM, nullptr, nullptr, MTOK, in.p[I_NWOUT] + (size_t)j * DM * DM, DM, DM, DM, mix, DM);
        }
        float* x1 = X0; float* x2 = X1;
        hipLaunchKernelGGL(n_ln_res, dim3(MTOK), dim3(256), 0, stream, x, mix, in.p[I_LMG] + i * DM, in.p[I_LMB] + i * DM, x1);
        float* ffn = BC;
        if (i % 2 == 0) {
            gemm(stream, x1, DM, nullptr, nullptr, MTOK, in.p[I_FWG] + (size_t)f * DM * DFF, DFF, DFF, DM, BA, DFF);
            gemm(stream, x1, DM, nullptr, nullptr, MTOK, in.p[I_FWU] + (size_t)f * DM * DFF, DFF, DFF, DM, BB, DFF);
            hipLaunchKernelGGL(n_swiglu, dim3((unsigned)(((size_t)MTOK * DFF + EW - 1) / EW)), dim3(EW), 0, stream, BA, BB, BA, (const int*)nullptr, MTOK, DFF);
            gemm(stream, BA, DFF, nullptr, nullptr, MTOK, in.p[I_FWD] + (size_t)f * DFF * DM, DM, DM, DFF, ffn, DM);
        } else {
            (void)hipMemsetAsync(cnt, 0, 256, stream);
            (void)hipMemsetAsync(ffn, 0, (size_t)MTOK * DM * 4, stream);
            hipLaunchKernelGGL(n_router, dim3(MTOK / 4), dim3(256), 0, stream, x1, in.p[I_MWR] + (size_t)f * DM * NEXP, cnt, list, tsel, twt);
            for (int e = 0; e < NEXP; ++e) {
                const size_t wo = ((size_t)f * NEXP + e) * DM * DFFE;
                gemm(stream, x1, DM, list + e * MOE_CAP, cnt + e, MOE_CAP, in.p[I_MWG] + wo, DFFE, DFFE, DM, BA, DFFE);
                gemm(stream, x1, DM, list + e * MOE_CAP, cnt + e, MOE_CAP, in.p[I_MWU] + wo, DFFE, DFFE, DM, BB, DFFE);
                hipLaunchKernelGGL(n_swiglu, dim3((unsigned)(((size_t)MOE_CAP * DFFE + EW - 1) / EW)), dim3(EW), 0, stream, BA, BB, BA, (const int*)(cnt + e), MOE_CAP, DFFE);
                gemm(stream, BA, DFFE, nullptr, cnt + e, MOE_CAP, in.p[I_MWD] + wo, DM, DM, DFFE, BD, DM);
                hipLaunchKernelGGL(n_moe_scatter, dim3(MOE_CAP), dim3(256), 0, stream, BD, cnt, list, tsel, twt, e, ffn);
            }
        }
        float* xo = (i == DEPTH - 1) ? (float*)d_out : x2;
        hipLaunchKernelGGL(n_ln_res, dim3(MTOK), dim3(256), 0, stream, x1, ffn, in.p[I_LFG] + i * DM, in.p[I_LFB] + i * DM, xo);
        x = xo;
    }
}
```

```cpp
#define FAST_PREFIX 8
#define ONE_LAUNCH 0
#include <hip/hip_runtime.h>
#include <cstdio>
#include <cstdint>

constexpr int BATCH = 8, SEQ = 2048, DM = 1024, MTOK = BATCH * SEQ, DEPTH = 4;
constexpr int CONV_K = 31, SHORT_K = 3;
constexpr int NH = 16, NKV = 4, NG = 4, HD = 64;
constexpr int CMP_BLOCK = 32, CMP_STRIDE = 16, NCMP = (SEQ - CMP_BLOCK) / CMP_STRIDE + 1;
constexpr int SLC_BLOCK = 64, NSLC = SEQ / SLC_BLOCK, TOPN = 16, WINDOW = 512, PHI = 128;
constexpr int NSA_COLS = NH * HD + 6 * NKV * HD + 3 * NH;
constexpr int DFF = 2816, NEXP = 8, DFFE = 3584;
constexpr float LN_EPS = 1e-5f;
#define ALPHA_F 1.681792830507429f

typedef float f32x16 __attribute__((ext_vector_type(16)));

__device__ __forceinline__ float wave_sum(float v) {
#pragma unroll
    for (int o = 1; o < 64; o <<= 1) v += __shfl_xor(v, o);
    return v;
}
__device__ __forceinline__ float block_sum256(float v, float* red) {
    v = wave_sum(v);
    __syncthreads();
    if ((threadIdx.x & 63) == 0) red[threadIdx.x >> 6] = v;
    __syncthreads();
    return (red[0] + red[1]) + (red[2] + red[3]);
}
__device__ __forceinline__ float sigmoidf_(float x) { return 1.0f / (1.0f + expf(-x)); }
__device__ __forceinline__ float siluf_(float x) { return x / (1.0f + expf(-x)); }
__device__ __forceinline__ float gelu_tanh(float x) { return 0.5f * x * (1.0f + tanhf(0.7978845608028654f * (x + 0.044715f * x * x * x))); }

__global__ __launch_bounds__(256) void ngemm(const float* __restrict__ A, int lda, const int* __restrict__ gather, const int* __restrict__ mcount, int M,
                                             const float* __restrict__ W, int ldw, int N, int K, float* __restrict__ C, int ldc) {
    __shared__ float As[128][17];
    __shared__ float Bs[16][132];
    if (mcount) { const int mc = *mcount; M = mc < M ? mc : M; }
    const int bm = blockIdx.y * 128, bn = blockIdx.x * 128;
    if (bm >= M) return;
    const int tid = threadIdx.x, lane = tid & 63, w = tid >> 6, wr = w >> 1, wc = w & 1;
    const int ar = tid >> 1, ak = (tid & 1) * 8;
    const int arow = bm + ar; const bool aok = arow < M;
    const int asrc = aok ? (gather ? gather[arow] : arow) : 0;
    const float* ap = A + (size_t)asrc * lda + ak;
    const int bk = tid >> 4, bc = (tid & 15) * 8;
    const bool bok = (bn + bc + 8) <= N;
    const float* bp = W + (size_t)bk * ldw + bn + bc;
    f32x16 acc[2][2];
#pragma unroll
    for (int i = 0; i < 2; ++i)
#pragma unroll
        for (int j = 0; j < 2; ++j)
#pragma unroll
            for (int r = 0; r < 16; ++r) acc[i][j][r] = 0.f;
    for (int k0 = 0; k0 < K; k0 += 16) {
        float4 a0 = make_float4(0.f, 0.f, 0.f, 0.f), a1 = a0, b0 = a0, b1 = a0;
        if (aok) { a0 = *(const float4*)(ap + k0); a1 = *(const float4*)(ap + k0 + 4); }
        if (bok) { b0 = *(const float4*)(bp + (size_t)k0 * ldw); b1 = *(const float4*)(bp + (size_t)k0 * ldw + 4); }
        __syncthreads();
        As[ar][ak + 0] = a0.x; As[ar][ak + 1] = a0.y; As[ar][ak + 2] = a0.z; As[ar][ak + 3] = a0.w;
        As[ar][ak + 4] = a1.x; As[ar][ak + 5] = a1.y; As[ar][ak + 6] = a1.z; As[ar][ak + 7] = a1.w;
        *(float4*)&Bs[bk][bc] = b0; *(float4*)&Bs[bk][bc + 4] = b1;
        __syncthreads();
#pragma unroll
        for (int kk = 0; kk < 16; kk += 2) {
            float a[2], b[2];
#pragma unroll
            for (int i = 0; i < 2; ++i) a[i] = As[wr * 64 + i * 32 + (lane & 31)][kk + (lane >> 5)];
#pragma unroll
            for (int j = 0; j < 2; ++j) b[j] = Bs[kk + (lane >> 5)][wc * 64 + j * 32 + (lane & 31)];
#pragma unroll
            for (int i = 0; i < 2; ++i)
#pragma unroll
                for (int j = 0; j < 2; ++j) acc[i][j] = __builtin_amdgcn_mfma_f32_32x32x2f32(a[i], b[j], acc[i][j], 0, 0, 0);
        }
    }
#pragma unroll
    for (int i = 0; i < 2; ++i)
#pragma unroll
        for (int j = 0; j < 2; ++j)
#pragma unroll
            for (int r = 0; r < 16; ++r) {
                const int row = bm + wr * 64 + i * 32 + (r & 3) + 8 * (r >> 2) + 4 * (lane >> 5);
                const int col = bn + wc * 64 + j * 32 + (lane & 31);
                if (row < M && col < N) C[(size_t)row * ldc + col] = acc[i][j][r];
            }
}

__global__ void n_glu(const float* __restrict__ t, float* __restrict__ u, int rows) {
    const size_t i = (size_t)blockIdx.x * blockDim.x + threadIdx.x; if (i >= (size_t)rows * DM) return;
    const size_t m = i / DM; const int c = (int)(i % DM);
    u[i] = t[m * 2 * DM + c] * sigmoidf_(t[m * 2 * DM + DM + c]);
}
__global__ __launch_bounds__(256) void n_conf_dw(const float* __restrict__ u, const float* __restrict__ wdw, const float* __restrict__ bdw, const float* __restrict__ g, const float* __restrict__ bb, float* __restrict__ out) {
    __shared__ float red[8];
    const int m = blockIdx.x, t = m % SEQ, c = threadIdx.x * 4;
    float4 acc = *(const float4*)(bdw + c);
    for (int k = 0; k < CONV_K; ++k) { const int tt = t - (CONV_K - 1) + k; if (tt < 0) continue;
        const float4 w = *(const float4*)(wdw + k * DM + c), x = *(const float4*)(u + (size_t)(m - t + tt) * DM + c);
        acc.x += w.x * x.x; acc.y += w.y * x.y; acc.z += w.z * x.z; acc.w += w.w * x.w; }
    const float mean = block_sum256((acc.x + acc.y) + (acc.z + acc.w), red) * (1.0f / DM);
    const float dx = acc.x - mean, dy = acc.y - mean, dz = acc.z - mean, dw = acc.w - mean;
    const float var = block_sum256((dx * dx + dy * dy) + (dz * dz + dw * dw), red) * (1.0f / DM);
    const float rstd = 1.0f / sqrtf(var + LN_EPS);
    const float4 gg = *(const float4*)(g + c), b4 = *(const float4*)(bb + c);
    float4 o; o.x = siluf_(dx * rstd * gg.x + b4.x); o.y = siluf_(dy * rstd * gg.y + b4.y); o.z = siluf_(dz * rstd * gg.z + b4.z); o.w = siluf_(dw * rstd * gg.w + b4.w);
    *(float4*)(out + (size_t)m * DM + c) = o;
}
__global__ __launch_bounds__(256) void n_ln_res(const float* __restrict__ x, const float* __restrict__ mix, const float* __restrict__ g, const float* __restrict__ bb, float* __restrict__ xo) {
    __shared__ float red[8];
    const int m = blockIdx.x, c = threadIdx.x * 4;
    const float4 xv = *(const float4*)(x + (size_t)m * DM + c), mv = *(const float4*)(mix + (size_t)m * DM + c);
    float4 v; v.x = ALPHA_F * xv.x + mv.x; v.y = ALPHA_F * xv.y + mv.y; v.z = ALPHA_F * xv.z + mv.z; v.w = ALPHA_F * xv.w + mv.w;
    const float mean = block_sum256((v.x + v.y) + (v.z + v.w), red) * (1.0f / DM);
    const float dx = v.x - mean, dy = v.y - mean, dz = v.z - mean, dw = v.w - mean;
    const float var = block_sum256((dx * dx + dy * dy) + (dz * dz + dw * dw), red) * (1.0f / DM);
    const float rstd = 1.0f / sqrtf(var + LN_EPS);
    const float4 gg = *(const float4*)(g + c), b4 = *(const float4*)(bb + c);
    float4 o; o.x = dx * rstd * gg.x + b4.x; o.y = dy * rstd * gg.y + b4.y; o.z = dz * rstd * gg.z + b4.z; o.w = dw * rstd * gg.w + b4.w;
    *(float4*)(xo + (size_t)m * DM + c) = o;
}
__global__ void n_swiglu(const float* __restrict__ g, const float* __restrict__ u, float* __restrict__ h, const int* __restrict__ mcount, int rows, int n) {
    if (mcount) { const int mc = *mcount; rows = mc < rows ? mc : rows; }
    const size_t i = (size_t)blockIdx.x * blockDim.x + threadIdx.x; if (i >= (size_t)rows * n) return;
    h[i] = siluf_(g[i]) * u[i];
}
__global__ void n_shortconv(const float* __restrict__ t, const float* __restrict__ w, float* __restrict__ y, int rows) {
    const size_t i = (size_t)blockIdx.x * blockDim.x + threadIdx.x; if (i >= (size_t)rows * DM) return;
    const int m = (int)(i / DM), c = (int)(i % DM), tt = m % SEQ;
    float acc = 0.f;
    for (int k = 0; k < SHORT_K; ++k) { const int ts = tt - (SHORT_K - 1) + k; if (ts < 0) continue;
        const float* r = t + (size_t)(m - tt + ts) * 3 * DM; acc += w[k * DM + c] * (r[DM + c] * r[2 * DM + c]); }
    y[i] = t[(size_t)m * 3 * DM + c] * acc;
}

__global__ __launch_bounds__(128) void n_compress(const float* __restrict__ T, const float* __restrict__ pek, const float* __restrict__ pev, const float* __restrict__ wk1, const float* __restrict__ wk2,
                                                  const float* __restrict__ wv1, const float* __restrict__ wv2, float* __restrict__ cmp) {
    __shared__ float in[CMP_BLOCK * HD]; __shared__ float hid[PHI];
    const int c = blockIdx.x, bh = blockIdx.y, kv = blockIdx.z, b = bh / NKV, hk = bh % NKV, tid = threadIdx.x;
    const float* pe = kv ? pev : pek; const float* w1 = kv ? wv1 : wk1; const float* w2 = kv ? wv2 : wk2;
    const int col0 = NH * HD + kv * NKV * HD + hk * HD;
    for (int i = tid; i < CMP_BLOCK * HD; i += 128) { const int j = i / HD, d = i % HD; in[i] = T[(size_t)(b * SEQ + c * CMP_STRIDE + j) * NSA_COLS + col0 + d] + pe[i]; }
    __syncthreads();
    float a = 0.f;
    for (int i = 0; i < CMP_BLOCK * HD; ++i) a += in[i] * w1[(size_t)i * PHI + tid];
    hid[tid] = gelu_tanh(a);
    __syncthreads();
    if (tid < HD) { float o = 0.f; for (int j = 0; j < PHI; ++j) o += hid[j] * w2[j * HD + tid]; cmp[((size_t)(kv * gridDim.y + bh) * 128 + c) * HD + tid] = o; }
}

#define NATT_TILE 32
__device__ __forceinline__ void natt_load_tile(float (*Kt)[HD], float (*Vt)[HD], const float* kp, const float* vp, size_t stride, int nrows) {
    __syncthreads();
    for (int i = threadIdx.x; i < NATT_TILE * HD / 4; i += 256) { const int r = i / (HD / 4), d4 = (i % (HD / 4)) * 4;
        float4 kx = make_float4(0.f, 0.f, 0.f, 0.f), vx = kx;
        if (r < nrows) { kx = *(const float4*)(kp + (size_t)r * stride + d4); vx = *(const float4*)(vp + (size_t)r * stride + d4); }
        *(float4*)&Kt[r][d4] = kx; *(float4*)&Vt[r][d4] = vx; }
    __syncthreads();
}
__global__ __launch_bounds__(256) void n_nsa_attn(const float* __restrict__ T, const float* __restrict__ cmp, float* __restrict__ O) {
    __shared__ float Kt[NATT_TILE][HD]; __shared__ float Vt[NATT_TILE][HD];
    __shared__ float impS[64][NG][NSLC]; __shared__ float scS[64][NSLC + 1];
    const int qi = blockIdx.x, bh = blockIdx.y, b = bh / NKV, hk = bh % NKV, tid = threadIdx.x, g = tid >> 6, tl = tid & 63, t = qi * 64 + tl;
    const size_t mrow = (size_t)b * SEQ + t; const int hcol = (hk * NG + g) * HD;
    float q[HD];
#pragma unroll
    for (int d = 0; d < HD; ++d) q[d] = T[mrow * NSA_COLS + hcol + d] * 0.125f;
    const float* gp = T + mrow * NSA_COLS + (NH * HD + 6 * NKV * HD) + hk * 12 + g * 3;
    const float g0 = sigmoidf_(gp[0]), g1 = sigmoidf_(gp[1]), g2 = sigmoidf_(gp[2]);
    float acc[HD]; float mx, l;
#define NATT_RESET() do { mx = -1e30f; l = 0.f; _Pragma("unroll") for (int d = 0; d < HD; ++d) acc[d] = 0.f; } while (0)
#define NATT_DOT(s, kk) do { s = 0.f; _Pragma("unroll") for (int d = 0; d < HD; d += 4) { const float4 kx = *(const float4*)&Kt[kk][d]; s += q[d] * kx.x + q[d + 1] * kx.y + q[d + 2] * kx.z + q[d + 3] * kx.w; } } while (0)
#define NATT_UPD(s, kk) do { const float mn = fmaxf(mx, s), sc = expf(mx - mn), p = expf(s - mn); l = l * sc + p; mx = mn; \
        _Pragma("unroll") for (int d = 0; d < HD; d += 4) { const float4 vx = *(const float4*)&Vt[kk][d]; acc[d] = acc[d] * sc + p * vx.x; acc[d + 1] = acc[d + 1] * sc + p * vx.y; acc[d + 2] = acc[d + 2] * sc + p * vx.z; acc[d + 3] = acc[d + 3] * sc + p * vx.w; } } while (0)
    float* op = O + mrow * DM + hcol;
    const float* kc = cmp + (size_t)bh * 128 * HD; const float* vc = cmp + (size_t)(gridDim.y + bh) * 128 * HD;
    NATT_RESET();
    for (int c0 = 0; c0 < NCMP; c0 += NATT_TILE) {
        natt_load_tile(Kt, Vt, kc + (size_t)c0 * HD, vc + (size_t)c0 * HD, HD, NCMP - c0 < NATT_TILE ? NCMP - c0 : NATT_TILE);
        for (int kk = 0; kk < NATT_TILE; ++kk) { const int c = c0 + kk; if (c < NCMP && c * CMP_STRIDE + CMP_BLOCK - 1 <= t) { float s; NATT_DOT(s, kk); NATT_UPD(s, kk); } }
    }
    { const float inv = g0 / fmaxf(l, 1e-30f);
#pragma unroll
      for (int d = 0; d < HD; d += 4) *(float4*)(op + d) = make_float4(acc[d] * inv, acc[d + 1] * inv, acc[d + 2] * inv, acc[d + 3] * inv); }
    { const float invl = 1.0f / fmaxf(l, 1e-30f); float cur = 0.f, nxt = 0.f;
      for (int c0 = 0; c0 < 128; c0 += NATT_TILE) {
        natt_load_tile(Kt, Vt, kc + (size_t)c0 * HD, vc + (size_t)c0 * HD, HD, NCMP - c0 < NATT_TILE ? NCMP - c0 : NATT_TILE);
        for (int kk = 0; kk < NATT_TILE; ++kk) { const int c = c0 + kk; float p = 0.f;
            if (c < NCMP && c * CMP_STRIDE + CMP_BLOCK - 1 <= t) { float s; NATT_DOT(s, kk); p = expf(s - mx) * invl; }
            cur += p; if ((c & 3) == 3) { nxt = p; impS[tl][g][c >> 2] = cur; cur = nxt; } }
      } }
    __syncthreads();
    if (g == 0) { for (int n = 0; n < NSLC; ++n) { const float imp = (impS[tl][0][n] + impS[tl][1][n]) + (impS[tl][2][n] + impS[tl][3][n]);
        const bool forced = (n == 0) || (n == qi) || (n == qi - 1); const bool valid = n <= qi;
        scS[tl][n] = forced ? 1e4f : (valid ? imp : -1e30f); } }
    __syncthreads();
    unsigned selmask = 0u;
    for (int n = 0; n < NSLC; ++n) { const float sn = scS[tl][n]; int rank = 0;
        for (int m2 = 0; m2 < NSLC; ++m2) { const float sm = scS[tl][m2]; rank += (sm > sn || (sm == sn && m2 < n)) ? 1 : 0; }
        if (rank < TOPN) selmask |= (1u << n); }
    NATT_RESET();
    for (int j = 0; j <= qi; ++j)
        for (int hf = 0; hf < 2; ++hf) { const int p0 = j * 64 + hf * 32;
            const float* kp = T + ((size_t)b * SEQ + p0) * NSA_COLS + (NH * HD + 2 * NKV * HD) + hk * HD; const float* vp = kp + NKV * HD;
            natt_load_tile(Kt, Vt, kp, vp, NSA_COLS, NATT_TILE);
            if ((selmask >> j) & 1u) for (int kk = 0; kk < NATT_TILE; ++kk) if (p0 + kk <= t) { float s; NATT_DOT(s, kk); NATT_UPD(s, kk); } }
    { const float inv = g1 / fmaxf(l, 1e-30f);
#pragma unroll
      for (int d = 0; d < HD; d += 4) { float4 o = *(float4*)(op + d); o.x += acc[d] * inv; o.y += acc[d + 1] * inv; o.z += acc[d + 2] * inv; o.w += acc[d + 3] * inv; *(float4*)(op + d) = o; } }
    NATT_RESET();
    for (int j = (qi >= 8 ? qi - 8 : 0); j <= qi; ++j)
        for (int hf = 0; hf < 2; ++hf) { const int p0 = j * 64 + hf * 32;
            const float* kp = T + ((size_t)b * SEQ + p0) * NSA_COLS + (NH * HD + 4 * NKV * HD) + hk * HD; const float* vp = kp + NKV * HD;
            natt_load_tile(Kt, Vt, kp, vp, NSA_COLS, NATT_TILE);
            for (int kk = 0; kk < NATT_TILE; ++kk) { const int df = t - (p0 + kk); if (df >= 0 && df < WINDOW) { float s; NATT_DOT(s, kk); NATT_UPD(s, kk); } } }
    { const float inv = g2 / fmaxf(l, 1e-30f);
#pragma unroll
      for (int d = 0; d < HD; d += 4) { float4 o = *(float4*)(op + d); o.x += acc[d] * inv; o.y += acc[d + 1] * inv; o.z += acc[d + 2] * inv; o.w += acc[d + 3] * inv; *(float4*)(op + d) = o; } }
#undef NATT_RESET
#undef NATT_DOT
#undef NATT_UPD
}

constexpr int MOE_CAP = 6144;
__global__ __launch_bounds__(256) void n_router(const float* __restrict__ x, const float* __restrict__ wr, int* __restrict__ cnt, int* __restrict__ list, int* __restrict__ tsel, float* __restrict__ twt) {
    const int m = blockIdx.x * 4 + (threadIdx.x >> 6), lane = threadIdx.x & 63;
    float lg[NEXP];
#pragma unroll
    for (int e = 0; e < NEXP; ++e) lg[e] = 0.f;
    for (int k = lane; k < DM; k += 64) { const float xv = x[(size_t)m * DM + k];
#pragma unroll
        for (int e = 0; e < NEXP; ++e) lg[e] += xv * wr[k * NEXP + e]; }
#pragma unroll
    for (int e = 0; e < NEXP; ++e) lg[e] = wave_sum(lg[e]);
    if (lane == 0) {
        int e1 = 0; float v1 = lg[0];
#pragma unroll
        for (int e = 1; e < NEXP; ++e) if (lg[e] > v1) { v1 = lg[e]; e1 = e; }
        int e2 = -1; float v2 = -3.4e38f;
#pragma unroll
        for (int e = 0; e < NEXP; ++e) if (e != e1 && lg[e] > v2) { v2 = lg[e]; e2 = e; }
        const float p2 = expf(v2 - v1), w1 = 1.0f / (1.0f + p2), w2 = p2 / (1.0f + p2);
        const int s1 = atomicAdd(cnt + e1, 1), s2 = atomicAdd(cnt + e2, 1);
        if (s1 < MOE_CAP) list[e1 * MOE_CAP + s1] = m;
        if (s2 < MOE_CAP) list[e2 * MOE_CAP + s2] = m;
        tsel[m * 4 + 0] = e1; tsel[m * 4 + 1] = s1; tsel[m * 4 + 2] = e2; tsel[m * 4 + 3] = s2; twt[m * 2] = w1; twt[m * 2 + 1] = w2;
    }
}
__global__ __launch_bounds__(256) void n_moe_scatter(const float* __restrict__ Y, const int* __restrict__ cnt, const int* __restrict__ list, const int* __restrict__ tsel, const float* __restrict__ twt, int e, float* __restrict__ F) {
    const int slot = blockIdx.x; int c = cnt[e]; c = c < MOE_CAP ? c : MOE_CAP; if (slot >= c) return;
    const int m = list[e * MOE_CAP + slot]; const float w = (tsel[m * 4] == e) ? twt[m * 2] : twt[m * 2 + 1];
    const int col = threadIdx.x * 4; const float4 y = *(const float4*)(Y + (size_t)slot * DM + col); float4 f = *(float4*)(F + (size_t)m * DM + col);
    f.x += w * y.x; f.y += w * y.y; f.z += w * y.z; f.w += w * y.w; *(float4*)(F + (size_t)m * DM + col) = f;
}


enum { I_X = 0, I_LMG, I_LMB, I_LFG, I_LFB, I_CWIN, I_CWDW, I_CBDW, I_CLNG, I_CLNB, I_CWOUT, I_SWIN, I_SWCONV, I_SWOUT, I_NWIN, I_NPEK, I_NPEV, I_NWK1, I_NWK2, I_NWV1, I_NWV2, I_NWOUT,
       I_FWG, I_FWU, I_FWD, I_MWR, I_MWG, I_MWU, I_MWD };

#define GAS __attribute__((address_space(1)))
#define LAS __attribute__((address_space(3)))
typedef unsigned short bf16;
typedef unsigned v4u __attribute__((ext_vector_type(4)));
typedef unsigned v2u __attribute__((ext_vector_type(2)));
typedef float f32x4 __attribute__((ext_vector_type(4)));
typedef float f32x2 __attribute__((ext_vector_type(2)));
typedef short bf16x8 __attribute__((ext_vector_type(8)));
typedef short s16x4 __attribute__((ext_vector_type(4)));
typedef GAS unsigned gu32;
#define RLX_AGENT __ATOMIC_RELAXED, __HIP_MEMORY_SCOPE_AGENT
#define LDS_WAIT() asm volatile("s_waitcnt lgkmcnt(0)" ::: "memory")
#define VM_WAIT() asm volatile("s_waitcnt vmcnt(0)" ::: "memory")
constexpr int NWAVES = 8, NTHR = NWAVES * 64;
__device__ __forceinline__ unsigned f2bf(float f) { unsigned u = __builtin_bit_cast(unsigned, f); return (u + 0x7fffu + ((u >> 16) & 1u)) >> 16; }
__device__ __forceinline__ unsigned pk2(float lo, float hi) { return f2bf(lo) | (f2bf(hi) << 16); }
typedef __bf16 bf16x2_t __attribute__((ext_vector_type(2)));
__device__ __forceinline__ unsigned cvt_pk_bf16(float lo, float hi) { f32x2 v = {lo, hi}; bf16x2_t b = __builtin_convertvector(v, bf16x2_t); return __builtin_bit_cast(unsigned, b); }
__device__ __forceinline__ float bf_lo(unsigned u) { return __builtin_bit_cast(float, u << 16); }
__device__ __forceinline__ float bf_hi(unsigned u) { return __builtin_bit_cast(float, u & 0xffff0000u); }
__device__ __forceinline__ float fast_sigmoid(float x) { return __builtin_amdgcn_rcpf(1.0f + __builtin_amdgcn_exp2f(-1.4426950408889634f * x)); }
__device__ __forceinline__ float fast_silu(float x) { return x * fast_sigmoid(x); }

#define XB_TMO      128
#define XB_XCNT(j)  (256  + 64 * (j))
#define XB_XSUB(j)  (1280 + 64 * (j))
#define XB_XGEN(j)  (2304 + 64 * (j))
#define XB_TOP      3328
#define XB_TOPGEN   3392
#define XCD_BAR_WORDS 3456
#define XB_SPIN_CAP (1u << 18)
__device__ __forceinline__ unsigned xb_ld(unsigned* p)              { return __hip_atomic_load(p, __ATOMIC_RELAXED, __HIP_MEMORY_SCOPE_AGENT); }
__device__ __forceinline__ unsigned xb_add(unsigned* p, unsigned v) { return __hip_atomic_fetch_add(p, v, __ATOMIC_RELAXED, __HIP_MEMORY_SCOPE_AGENT); }
__device__ __forceinline__ unsigned xb_xcc_id() { return (unsigned)__builtin_amdgcn_s_getreg((3 << 11) | 20) & 0xFu; }
#define XB_SPIN(cond, bar) do { unsigned _sp = 0; while (cond) { __builtin_amdgcn_s_sleep(1); \
    if ((++_sp & 255u) == 0u) { if (xb_ld(&(bar)[XB_TMO])) break; if (_sp > XB_SPIN_CAP) { atomicAdd(&(bar)[XB_TMO], 1u); break; } } } } while (0)
struct XcdBarrier { unsigned* bar; unsigned x; volatile LAS unsigned* st; };
__device__ __forceinline__ XcdBarrier xcd_barrier_post(unsigned* bar, volatile LAS unsigned* st) {
    XcdBarrier b; b.bar = bar; b.x = xb_xcc_id(); b.st = st;
    if (threadIdx.x == 0) (void)xb_add(&bar[XB_XCNT(b.x)], 1u);
    return b;
}
__device__ __forceinline__ void xcd_barrier_complete(unsigned* bar, unsigned x, unsigned& nloc, unsigned& nx) {
    const unsigned G = gridDim.x * gridDim.y * gridDim.z;
    unsigned sum, cnt, mine, sp = 0u;
    for (;;) {
        sum = 0u; cnt = 0u; mine = 0u;
#pragma unroll
        for (unsigned j = 0; j < 16; ++j) { const unsigned c = xb_ld(&bar[XB_XCNT(j)]); sum += c; cnt += (c > 0u) ? 1u : 0u; mine = (j == x) ? c : mine; }
        if (sum == G) break;
        __builtin_amdgcn_s_sleep(1);
        if ((++sp & 255u) == 0u) { if (xb_ld(&bar[XB_TMO])) break; if (sp > XB_SPIN_CAP) { atomicAdd(&bar[XB_TMO], 1u); break; } }
    }
    nloc = mine > 0u ? mine : 1u; nx = cnt > 0u ? cnt : 1u;
}
__device__ __forceinline__ void xcd_barrier(const XcdBarrier& b) {
    asm volatile("s_waitcnt vmcnt(0)" ::: "memory");
    __syncthreads();
    if (threadIdx.x == 0) {
        unsigned* bar = b.bar;
        __builtin_amdgcn_s_waitcnt(0);
        unsigned nloc = b.st[0], nx = b.st[1];
        if (nloc == 0u) { xcd_barrier_complete(bar, b.x, nloc, nx); b.st[0] = nloc; b.st[1] = nx; }
        const unsigned old = xb_add(&bar[XB_XSUB(b.x)], 1u);
        const unsigned gen = old / nloc;
        if (old + 1u == (gen + 1u) * nloc) {
            __builtin_amdgcn_fence(__ATOMIC_RELEASE, "agent");
            asm volatile("s_waitcnt vmcnt(0)" ::: "memory");
            const unsigned og = xb_add(&bar[XB_TOP], 1u);
            const unsigned tg = og / nx;
            if (og + 1u == (tg + 1u) * nx) xb_add(&bar[XB_TOPGEN], 1u);
            else XB_SPIN(xb_ld(&bar[XB_TOPGEN]) == tg, bar);
            __builtin_amdgcn_fence(__ATOMIC_ACQUIRE, "agent");
            xb_add(&bar[XB_XGEN(b.x)], 1u);
            asm volatile("s_waitcnt vmcnt(0)" ::: "memory");
        } else {
            XB_SPIN(xb_ld(&bar[XB_XGEN(b.x)]) == gen, bar);
            __builtin_amdgcn_fence(__ATOMIC_ACQUIRE, "agent");
            asm volatile("s_waitcnt vmcnt(0)" ::: "memory");
        }
    }
    __syncthreads();
}

namespace pg8 {
#define PG8_LAS __attribute__((address_space(3)))
typedef unsigned short bf16_t;
constexpr int BM = 256, BK = 64, HALF = 128, HTB = HALF * BK * 2  , STAGE_BYTES = 8 * HTB, NXCD = 8, WGM = 8;
__host__ __device__ __forceinline__ int lds_byte(int r, int c) { const int st = (r >> 4) * 2 + (c >> 5), rr = r & 15, cc = c & 31, ob = rr * 64 + cc * 2; return st * 1024 + (ob ^ (((ob >> 9) & 1) << 5)); }
__host__ __device__ __forceinline__ void stage_rc(int b, int& R, int& C) { const int st = b / 1024, sb = b % 1024, swz = sb ^ (((sb >> 9) & 1) << 5); R = (st >> 1) * 16 + swz / 64; C = (st & 1) * 32 + (swz % 64) / 2; }
__host__ __device__ __forceinline__ int perm32(int rho) { const int n = rho >> 4, i = rho & 15; return 8 * (i >> 2) + 4 * n + (i & 3); }

struct Unit { int pm, pn, eb; };
struct Gemm { const bf16_t* A; const bf16_t* Bt; int lda, K; size_t bexp; };

struct StaticOrder {
    int nM, nN, nwg, G, c;
    __host__ __device__ void init(int nM_, int nN_, int G_, int c_) { nM = nM_; nN = nN_; nwg = nM * nN; G = G_; c = c_; }
    __host__ __device__ bool next(int i, Unit& u) const {
        const long L = (long)i * G + c; if (L >= nwg) return false;
        int wgid = (int)L; { const int q = nwg / NXCD, r = nwg % NXCD, xcd = wgid % NXCD, off = wgid / NXCD; wgid = (xcd < r ? xcd * (q + 1) : r * (q + 1) + (xcd - r) * q) + off; }
        const int nig = WGM * nN, gid = wgid / nig, fm = gid * WGM, gsz = (nM - fm) < WGM ? (nM - fm) : WGM;
        u.pm = fm + ((wgid % nig) % gsz); u.pn = (wgid % nig) / gsz; u.eb = 0; return true;
    }
    __device__ __forceinline__ void a_ready(const Unit&) const {}
    __device__ __forceinline__ void done(const Unit&) const {}
};
struct GroupedOrder : StaticOrder {
    int pb[9];
    __device__ __forceinline__ bool next(int i, Unit& u) const {
        if (!StaticOrder::next(i, u)) return false;
        int e = 0;
#pragma unroll
        for (int k = 1; k < 8; ++k) e += (u.pm >= pb[k]) ? 1 : 0;
        u.eb = e; return true;
    }
};

template <class Epi, class Sched, bool ALIGN_EPI = false, bool SP2 = false>
__device__ __forceinline__ void gemm_phase(PG8_LAS unsigned char* lds, const Gemm g, const Sched& S, const Epi& E) {
    const int tid = threadIdx.x, wid = __builtin_amdgcn_readfirstlane(tid >> 6), lane = tid & 63, wr = wid >> 2, wc = wid & 3, fr = lane & 15, fq = lane >> 4;
    const int K = g.K, nt = K / BK;
    unsigned voffA[2], voffB[2];
#pragma unroll
    for (int i = 0; i < 2; ++i) { int R, C; stage_rc(tid * 16 + i * 8192, R, C); const int Rb = Epi::PERM ? ((R & ~31) + perm32(R & 31)) : R;
        voffA[i] = (unsigned)(R * g.lda + C) * 2u; voffB[i] = (unsigned)(Rb * K + C) * 2u; }
    const size_t kstep = (size_t)(BK * 2);
    const size_t hstepA = (size_t)HALF * g.lda * 2, hstepB = (size_t)HALF * K * 2;
    const size_t tstepA = 2 * hstepA, tstepB = 2 * hstepB;
    const unsigned ldsw = (unsigned)wid * 1024u;
    const int aoff = lds_byte(wr * 64 + fr, fq * 8), boff = lds_byte(wc * 32 + fr, fq * 8);
#define PG8_SA(b, h) (((b) * 2 + (h)) * HTB)
#define PG8_SB(b, h) ((4 + (b) * 2 + (h)) * HTB)
#define PG8_STAGE(bufoff, gbase, voff) do { _Pragma("unroll") for (int _i = 0; _i < 2; ++_i) \
        __builtin_amdgcn_global_load_lds((const unsigned*)((const char*)(gbase) + (voff)[_i]), (PG8_LAS unsigned*)(lds + (bufoff) + ldsw + _i * 8192), 16, 0, 0); } while (0)
#define PG8_LDA(dst, b, h) do { _Pragma("unroll") for (int m = 0; m < 4; ++m) _Pragma("unroll") for (int k = 0; k < 2; ++k) dst[m][k] = *(const PG8_LAS bf16x8*)(lds + PG8_SA(b, h) + aoff + m * 2048 + k * 1024); } while (0)
#define PG8_LDB(dst, b, h) do { _Pragma("unroll") for (int n = 0; n < 2; ++n) _Pragma("unroll") for (int k = 0; k < 2; ++k) dst[n][k] = *(const PG8_LAS bf16x8*)(lds + PG8_SB(b, h) + boff + n * 2048 + k * 1024); } while (0)
#define PG8_MMA(ai, bj, At, Bt) do { __builtin_amdgcn_s_setprio(1); _Pragma("unroll") for (int m = 0; m < 4; ++m) _Pragma("unroll") for (int n = 0; n < 2; ++n) _Pragma("unroll") for (int k = 0; k < 2; ++k) \
        acc[ai][bj][m][n] = __builtin_amdgcn_mfma_f32_16x16x32_bf16(Bt[n][k], At[m][k], acc[ai][bj][m][n], 0, 0, 0); __builtin_amdgcn_s_setprio(0); } while (0)
#define PG8_WAIT_V(n) asm volatile("s_waitcnt vmcnt(" #n ")" ::: "memory")
#define PG8_WAIT_L(n) asm volatile("s_waitcnt lgkmcnt(" #n ")" ::: "memory")
#define PG8_BAR __builtin_amdgcn_s_barrier()
#define PG8_SCHED __builtin_amdgcn_sched_barrier(0)
    Unit cur, nxt; int ui = 0;
    if (!S.next(0, cur)) return;
    f32x4 acc[2][2][4][2];
#pragma unroll
    for (int a = 0; a < 2; ++a)
#pragma unroll
        for (int b = 0; b < 2; ++b)
#pragma unroll
            for (int m = 0; m < 4; ++m)
#pragma unroll
                for (int n = 0; n < 2; ++n) acc[a][b][m][n] = (f32x4){0.f, 0.f, 0.f, 0.f};
    bf16x8 At[4][2], B0[2][2], B1[2][2];
    const char* cA = (const char*)g.A + (size_t)cur.pm * tstepA; const char* cB = (const char*)g.Bt + (size_t)cur.eb * g.bexp + (size_t)cur.pn * tstepB;
    S.a_ready(cur);
    if constexpr (SP2) {
        PG8_STAGE(PG8_SB(0, 0), cB, voffB); PG8_STAGE(PG8_SB(0, 1), cB + hstepB, voffB); PG8_STAGE(PG8_SA(0, 0), cA, voffA); PG8_STAGE(PG8_SA(0, 1), cA + hstepA, voffA);
        if (wr == 1) PG8_BAR;
        PG8_WAIT_V(2); PG8_BAR;
        PG8_STAGE(PG8_SB(1, 0), cB + kstep, voffB); PG8_STAGE(PG8_SA(1, 0), cA + kstep, voffA); PG8_STAGE(PG8_SB(1, 1), cB + hstepB + kstep, voffB);
        PG8_WAIT_V(6); PG8_BAR;
    } else {
        PG8_STAGE(PG8_SB(0, 0), cB, voffB); PG8_STAGE(PG8_SA(0, 0), cA, voffA); PG8_STAGE(PG8_SB(0, 1), cB + hstepB, voffB); PG8_STAGE(PG8_SA(0, 1), cA + hstepA, voffA);
        if (wr == 1) PG8_BAR;
        PG8_WAIT_V(4); PG8_BAR;
        PG8_STAGE(PG8_SB(1, 0), cB + kstep, voffB); PG8_STAGE(PG8_SA(1, 0), cA + kstep, voffA); PG8_STAGE(PG8_SB(1, 1), cB + hstepB + kstep, voffB);
        PG8_WAIT_V(6); PG8_BAR;
    }
    for (;;) {
        const bool has_next = S.next(ui + 1, nxt);
        const char* nA = has_next ? (const char*)g.A + (size_t)nxt.pm * tstepA : cA; const char* nB = has_next ? (const char*)g.Bt + (size_t)nxt.eb * g.bexp + (size_t)nxt.pn * tstepB : cB;
        for (int t = 0; t < nt; t += 2) {
            const bool last = (t == nt - 2);
            const char* a1 = cA + (size_t)(t + 1) * kstep;
            const char* a2 = last ? nA : cA + (size_t)(t + 2) * kstep; const char* b2 = last ? nB : cB + (size_t)(t + 2) * kstep;
            const char* a3 = a2 + kstep; const char* b3 = b2 + kstep;
            if (last && has_next) S.a_ready(nxt);
            if constexpr (SP2) {
            PG8_LDB(B0, 0, 0); PG8_LDB(B1, 0, 1); PG8_SCHED; PG8_LDA(At, 0, 0); PG8_STAGE(PG8_SA(1, 1), a1 + hstepA, voffA);
            PG8_WAIT_V(8); PG8_WAIT_L(0); PG8_BAR; PG8_MMA(0, 0, At, B0); PG8_MMA(0, 1, At, B1); PG8_BAR; PG8_SCHED;
            PG8_LDA(At, 0, 1); PG8_STAGE(PG8_SB(0, 0), b2, voffB); PG8_STAGE(PG8_SB(0, 1), b2 + hstepB, voffB); PG8_STAGE(PG8_SA(0, 0), a2, voffA);
            PG8_WAIT_V(8); PG8_WAIT_L(0); PG8_BAR; PG8_MMA(1, 0, At, B0); PG8_MMA(1, 1, At, B1); PG8_BAR; PG8_SCHED;
            PG8_LDB(B0, 1, 0); PG8_LDB(B1, 1, 1); PG8_SCHED; PG8_LDA(At, 1, 0); PG8_STAGE(PG8_SA(0, 1), a2 + hstepA, voffA);
            PG8_WAIT_V(8); PG8_WAIT_L(0); PG8_BAR; PG8_MMA(0, 0, At, B0); PG8_MMA(0, 1, At, B1); PG8_BAR; PG8_SCHED;
            PG8_LDA(At, 1, 1); PG8_STAGE(PG8_SB(1, 0), b3, voffB); PG8_STAGE(PG8_SB(1, 1), b3 + hstepB, voffB); PG8_STAGE(PG8_SA(1, 0), a3, voffA);
            PG8_WAIT_V(8); PG8_WAIT_L(0); PG8_BAR; PG8_MMA(1, 0, At, B0); PG8_MMA(1, 1, At, B1); PG8_BAR; PG8_SCHED;
            } else {
            PG8_LDB(B0, 0, 0); PG8_SCHED; PG8_LDA(At, 0, 0); PG8_STAGE(PG8_SA(1, 1), a1 + hstepA, voffA);
            PG8_WAIT_L(8); PG8_BAR; PG8_WAIT_L(0); PG8_MMA(0, 0, At, B0); PG8_BAR; PG8_SCHED;
            PG8_LDB(B1, 0, 1); PG8_STAGE(PG8_SB(0, 0), b2, voffB);
            PG8_BAR; PG8_WAIT_L(0); PG8_MMA(0, 1, At, B1); PG8_BAR;
            PG8_LDA(At, 0, 1); PG8_STAGE(PG8_SA(0, 0), a2, voffA);
            PG8_BAR; PG8_WAIT_L(0); PG8_MMA(1, 0, At, B0); PG8_BAR; PG8_SCHED;
            PG8_STAGE(PG8_SB(0, 1), b2 + hstepB, voffB);
            PG8_WAIT_V(6); PG8_BAR; PG8_MMA(1, 1, At, B1); PG8_BAR;
            PG8_LDB(B0, 1, 0); PG8_SCHED; PG8_LDA(At, 1, 0); PG8_STAGE(PG8_SA(0, 1), a2 + hstepA, voffA);
            PG8_WAIT_L(8); PG8_BAR; PG8_WAIT_L(0); PG8_MMA(0, 0, At, B0); PG8_BAR; PG8_SCHED;
            PG8_LDB(B1, 1, 1); PG8_STAGE(PG8_SB(1, 0), b3, voffB);
            PG8_BAR; PG8_WAIT_L(0); PG8_MMA(0, 1, At, B1); PG8_BAR;
            PG8_LDA(At, 1, 1); PG8_STAGE(PG8_SA(1, 0), a3, voffA);
            PG8_BAR; PG8_WAIT_L(0); PG8_MMA(1, 0, At, B0); PG8_BAR; PG8_SCHED;
            PG8_STAGE(PG8_SB(1, 1), b3 + hstepB, voffB);
            PG8_WAIT_V(6); PG8_BAR; PG8_MMA(1, 1, At, B1); PG8_BAR;
            }
        }
        if constexpr (ALIGN_EPI) { if (wr == 0) PG8_BAR; }
        E(acc, cur, wr, wc, fr, fq); S.done(cur);
        if (!has_next) break;
#pragma unroll
        for (int a = 0; a < 2; ++a)
#pragma unroll
            for (int b = 0; b < 2; ++b)
#pragma unroll
                for (int m = 0; m < 4; ++m)
#pragma unroll
                    for (int n = 0; n < 2; ++n) acc[a][b][m][n] = (f32x4){0.f, 0.f, 0.f, 0.f};
        cur = nxt; cA = nA; cB = nB; ++ui;
        if constexpr (ALIGN_EPI) { if (wr == 1) PG8_BAR; }
    }
    PG8_WAIT_V(0);
    if constexpr (!ALIGN_EPI) { if (wr == 0) PG8_BAR; }
    PG8_BAR;
#undef PG8_SA
#undef PG8_SB
#undef PG8_STAGE
#undef PG8_LDA
#undef PG8_LDB
#undef PG8_MMA
#undef PG8_WAIT_V
#undef PG8_WAIT_L
#undef PG8_BAR
#undef PG8_SCHED
}

template <int MODE> struct EpiPair {
    static constexpr bool PERM = true;
    bf16_t* O; int ldc;
    __device__ __forceinline__ void operator()(const f32x4 (&acc)[2][2][4][2], const Unit& u, int wr, int wc, int fr, int fq) const {
        const int row0 = u.pm * BM + wr * 64 + fr, col0 = u.pn * HALF + wc * 32 + 8 * fq;
#pragma unroll
        for (int ai = 0; ai < 2; ++ai)
#pragma unroll
            for (int m = 0; m < 4; ++m) { bf16_t* p = O + (size_t)(row0 + ai * HALF + m * 16) * ldc + col0; float r[8];
#pragma unroll
                for (int n = 0; n < 2; ++n)
#pragma unroll
                    for (int j = 0; j < 4; ++j) { const float x0 = acc[ai][0][m][n][j], x1 = acc[ai][1][m][n][j];
                        r[n * 4 + j] = MODE == 0 ? x0 * fast_sigmoid(x1) : (MODE == 1 ? fast_silu(x0) * x1 : x0 * x1); }
                v4u w; w.x = cvt_pk_bf16(r[0], r[1]); w.y = cvt_pk_bf16(r[2], r[3]); w.z = cvt_pk_bf16(r[4], r[5]); w.w = cvt_pk_bf16(r[6], r[7]);
                *(v4u*)p = w; }
    }
};
struct EpiBf16 {
    static constexpr bool PERM = true;
    bf16_t* O; int ldc; float scale;
    __device__ __forceinline__ void operator()(const f32x4 (&acc)[2][2][4][2], const Unit& u, int wr, int wc, int fr, int fq) const {
        const int row0 = u.pm * BM + wr * 64 + fr, col0 = u.pn * BM + wc * 32 + 8 * fq;
#pragma unroll
        for (int ai = 0; ai < 2; ++ai)
#pragma unroll
            for (int m = 0; m < 4; ++m) { bf16_t* rowp = O + (size_t)(row0 + ai * HALF + m * 16) * ldc + col0;
#pragma unroll
                for (int bj = 0; bj < 2; ++bj) { const f32x4 v0 = acc[ai][bj][m][0] * scale, v1 = acc[ai][bj][m][1] * scale;
                    v4u w; w.x = cvt_pk_bf16(v0[0], v0[1]); w.y = cvt_pk_bf16(v0[2], v0[3]); w.z = cvt_pk_bf16(v1[0], v1[1]); w.w = cvt_pk_bf16(v1[2], v1[3]);
                    *(v4u*)(rowp + bj * HALF) = w; } }
    }
};
struct EpiResid {
    static constexpr bool PERM = false;
    const float* res; float* out; int ldc;
    __device__ __forceinline__ void operator()(const f32x4 (&acc)[2][2][4][2], const Unit& u, int wr, int wc, int fr, int fq) const {
        const int row0 = u.pm * BM + wr * 64 + fr, col0 = u.pn * BM + wc * 32 + 4 * fq;
#pragma unroll
        for (int ai = 0; ai < 2; ++ai)
#pragma unroll
            for (int m = 0; m < 4; ++m) { const size_t off = (size_t)(row0 + ai * HALF + m * 16) * ldc + col0;
#pragma unroll
                for (int bj = 0; bj < 2; ++bj)
#pragma unroll
                    for (int n = 0; n < 2; ++n) { const f32x4 r = *(const f32x4*)(res + off + bj * HALF + n * 16); *(f32x4*)(out + off + bj * HALF + n * 16) = r * ALPHA_F + acc[ai][bj][m][n]; } }
    }
};
}
namespace pg8 {
struct EpiSC {
    static constexpr bool PERM = true;
    bf16_t* CH; bf16_t* BG;
    __device__ __forceinline__ void operator()(const f32x4 (&acc)[2][2][4][2], const Unit& u, int wr, int wc, int fr, int fq) const {
        if (u.pn < 8) { EpiPair<2> e{CH, DM}; e(acc, u, wr, wc, fr, fq); }
        else { Unit u2 = u; u2.pn = u.pn - 8; EpiBf16 e{BG, DM, 1.0f}; e(acc, u2, wr, wc, fr, fq); }
    }
};
}
namespace pg8 {
struct EpiNSA {
    static constexpr bool PERM = true;
    bf16_t* Q; bf16_t* KV; float* GATE;
    __device__ __forceinline__ void operator()(const f32x4 (&acc)[2][2][4][2], const Unit& u, int wr, int wc, int fr, int fq) const {
        const int b = u.pm >> 3, tb = (u.pm & 7) * 256 + wr * 64 + fr, d0 = 32 * (wc & 1) + 8 * fq;
        if (u.pn < 4) {
            const float sc = 0.125f * 1.4426950408889634f;
#pragma unroll
            for (int ai = 0; ai < 2; ++ai)
#pragma unroll
                for (int m = 0; m < 4; ++m) { const int t = tb + ai * HALF + m * 16;
#pragma unroll
                    for (int bj = 0; bj < 2; ++bj) { const int h = u.pn * 4 + 2 * bj + (wc >> 1); const f32x4 v0 = acc[ai][bj][m][0] * sc, v1 = acc[ai][bj][m][1] * sc;
                        v4u w; w.x = cvt_pk_bf16(v0[0], v0[1]); w.y = cvt_pk_bf16(v0[2], v0[3]); w.z = cvt_pk_bf16(v1[0], v1[1]); w.w = cvt_pk_bf16(v1[2], v1[3]);
                        *(v4u*)(Q + (((size_t)(b * NH + h) * SEQ + t) * HD + d0)) = w; } }
        } else if (u.pn < 10) {
            const int ti = u.pn - 4; bf16_t* base = KV + (size_t)ti * (4u << 20);
            const bool tr = (ti == 3) || (ti == 5);
#pragma unroll
            for (int ai = 0; ai < 2; ++ai)
#pragma unroll
                for (int m = 0; m < 4; ++m) { const int t = tb + ai * HALF + m * 16;
#pragma unroll
                    for (int bj = 0; bj < 2; ++bj) { const int hk = 2 * bj + (wc >> 1); const f32x4 v0 = acc[ai][bj][m][0], v1 = acc[ai][bj][m][1];
                        if (!tr) { v4u w; w.x = cvt_pk_bf16(v0[0], v0[1]); w.y = cvt_pk_bf16(v0[2], v0[3]); w.z = cvt_pk_bf16(v1[0], v1[1]); w.w = cvt_pk_bf16(v1[2], v1[3]);
                            *(v4u*)(base + (((size_t)(b * NKV + hk) * SEQ + t) * HD + d0)) = w; }
                        else { bf16_t* p = base + ((size_t)(b * NKV + hk) * HD + d0) * SEQ + t;
#pragma unroll
                            for (int j = 0; j < 4; ++j) { p[(size_t)j * SEQ] = (bf16_t)f2bf(v0[j]); p[(size_t)(4 + j) * SEQ] = (bf16_t)f2bf(v1[j]); } } } }
        } else {
            if (wc < 2 && (wc == 0 || fq < 2)) {
#pragma unroll
                for (int ai = 0; ai < 2; ++ai)
#pragma unroll
                    for (int m = 0; m < 4; ++m) { const size_t row = (size_t)u.pm * BM + wr * 64 + fr + ai * HALF + m * 16; float* p = GATE + row * 48 + 32 * wc + 8 * fq;
                        const f32x4 v0 = acc[ai][0][m][0], v1 = acc[ai][0][m][1];
                        *(f32x4*)p = (f32x4){fast_sigmoid(v0[0]), fast_sigmoid(v0[1]), fast_sigmoid(v0[2]), fast_sigmoid(v0[3])};
                        *(f32x4*)(p + 4) = (f32x4){fast_sigmoid(v1[0]), fast_sigmoid(v1[1]), fast_sigmoid(v1[2]), fast_sigmoid(v1[3])}; }
            }
        }
    }
};
}

constexpr size_t MiB = 1u << 20;
constexpr size_t WS_CTL = 0, CTL_ZERO_BYTES = 1 * MiB;
constexpr size_t WS_X = 1 * MiB;
constexpr size_t WS_XBF = 65 * MiB;
constexpr size_t WS_ACT = 97 * MiB;
constexpr size_t WS_H = 225 * MiB;
constexpr size_t WS_MISC = 463 * MiB;
constexpr size_t WS_W = 467 * MiB;
constexpr size_t W_CONF_IN = WS_W, W_CONF_OUT = W_CONF_IN + 8 * MiB, W_SC_IN = W_CONF_OUT + 4 * MiB, W_SC_OUT = W_SC_IN + 6 * MiB;
constexpr size_t W_NSA_IN = W_SC_OUT + 2 * MiB, W_NSA_OUT = W_NSA_IN + 6 * MiB, W_CMP1 = W_NSA_OUT + 2 * MiB;
constexpr size_t W_FFN_GU = W_CMP1 + 1 * MiB, W_FFN_D = W_FFN_GU + 22 * MiB, W_MOE_GU = W_FFN_D + 11 * MiB, W_MOE_D = W_MOE_GU + 224 * MiB, WS_END = W_MOE_D + 112 * MiB;
static_assert(WS_END <= 896 * MiB, "workspace map");
constexpr size_t A_U = WS_ACT, A_V = WS_ACT + 32 * MiB;
constexpr size_t A_CH = WS_ACT, A_BG = WS_ACT + 32 * MiB, A_YSC = WS_ACT + 64 * MiB;
constexpr size_t A_Q = WS_ACT, A_KC = WS_ACT + 32 * MiB, A_VCT = A_KC + 8 * MiB, A_KS = A_VCT + 8 * MiB, A_VST = A_KS + 8 * MiB, A_KW = A_VST + 8 * MiB, A_VWT = A_KW + 8 * MiB;
constexpr size_t A_O = A_VWT + 8 * MiB, A_GATE = A_O + 32 * MiB, A_KCMP = A_GATE + 4 * MiB, A_VCMPT = A_KCMP + 1 * MiB;
constexpr size_t A_PERM = WS_ACT;
static_assert(A_VCMPT + 1 * MiB <= WS_ACT + 128 * MiB, "ACT map");
constexpr int MOE_ROWS_MAX = 2 * MTOK + NEXP * 256;
static_assert((size_t)MOE_ROWS_MAX * DFFE * 2 <= 238 * MiB && (size_t)MOE_ROWS_MAX * DM * 2 <= 128 * MiB, "MoE buffers");
constexpr size_t MS_LIST = WS_MISC, MS_TSEL = MS_LIST + (size_t)NEXP * MTOK * 4, MS_TWT = MS_TSEL + (size_t)MTOK * 16, MS_END = MS_TWT + (size_t)MTOK * 8;
static_assert(MS_END <= WS_MISC + 4 * MiB, "MISC map");
constexpr int CW_BAR = 4096;
constexpr int CW_MOE = 16384;
constexpr int RING_BYTES = 131072, LDSCTL_OFF = RING_BYTES, LDS_BYTES = 147456;

struct CvtGroup { int in_idx, nmat; size_t src_stride; int ld, col0, K, ncols; size_t dst; size_t dst_stride; int rs, off; };
constexpr int NGROUPS = 17;
__device__ constexpr CvtGroup kGroups[NGROUPS] = {
    {I_CWIN, 2, (size_t)DM * 2 * DM, 2 * DM, 0, DM, DM, W_CONF_IN, 4 * MiB, 256, 0},
    {I_CWIN, 2, (size_t)DM * 2 * DM, 2 * DM, DM, DM, DM, W_CONF_IN, 4 * MiB, 256, 128},
    {I_CWOUT, 2, (size_t)DM * DM, DM, 0, DM, DM, W_CONF_OUT, 2 * MiB, 128, 0},
    {I_SWIN, 1, 0, 3 * DM, 0, DM, DM, W_SC_IN, 0, 128, 2048},
    {I_SWIN, 1, 0, 3 * DM, DM, DM, DM, W_SC_IN, 0, 256, 0},
    {I_SWIN, 1, 0, 3 * DM, 2 * DM, DM, DM, W_SC_IN, 0, 256, 128},
    {I_SWOUT, 1, 0, DM, 0, DM, DM, W_SC_OUT, 0, 128, 0},
    {I_NWIN, 1, 0, NSA_COLS, 0, DM, NSA_COLS, W_NSA_IN, 0, 128, 0},
    {I_NWOUT, 1, 0, DM, 0, DM, DM, W_NSA_OUT, 0, 128, 0},
    {I_NWK1, 1, 0, PHI, 0, CMP_BLOCK * HD, PHI, W_CMP1, 0, 128, 0},
    {I_NWV1, 1, 0, PHI, 0, CMP_BLOCK * HD, PHI, W_CMP1, 0, 128, 128},
    {I_FWG, 2, (size_t)DM * DFF, DFF, 0, DM, DFF, W_FFN_GU, 11 * MiB, 256, 0},
    {I_FWU, 2, (size_t)DM * DFF, DFF, 0, DM, DFF, W_FFN_GU, 11 * MiB, 256, 128},
    {I_FWD, 2, (size_t)DFF * DM, DM, 0, DFF, DM, W_FFN_D, (size_t)DM * DFF * 2, 128, 0},
    {I_MWG, 16, (size_t)DM * DFFE, DFFE, 0, DM, DFFE, W_MOE_GU, (size_t)2 * DFFE * DM * 2, 256, 0},
    {I_MWU, 16, (size_t)DM * DFFE, DFFE, 0, DM, DFFE, W_MOE_GU, (size_t)2 * DFFE * DM * 2, 256, 128},
    {I_MWD, 16, (size_t)DFFE * DM, DM, 0, DFFE, DM, W_MOE_D, (size_t)DM * DFFE * 2, 128, 0},
};
__host__ __device__ constexpr int grp_items_per_mat(int gi) { return (kGroups[gi].K / 64) * ((kGroups[gi].ncols + 31) / 32); }
__host__ __device__ constexpr int grp_items(int gi) { return kGroups[gi].nmat * grp_items_per_mat(gi); }
__host__ __device__ constexpr int grp_total() { int s = 0; for (int i = 0; i < NGROUPS; ++i) s += grp_items(i); return s; }
static_assert(W_FFN_GU + 2 * 11 * MiB == W_FFN_D && (size_t)2 * DFF * DM * 2 == 11 * MiB && (size_t)2 * DFFE * DM * 2 * 16 == 224 * MiB && (size_t)DM * DFFE * 2 * 16 == 112 * MiB, "weight map");

__device__ __forceinline__ void cvt_item(const float* src, int ld, int nvalid, bf16* dst, int Kd, int k0, LAS float* scr, int lane) {
#pragma unroll 8
    for (int i = 0; i < 32; ++i) { const int kk = 2 * i + (lane >> 5), cc = lane & 31; scr[kk * 33 + cc] = (cc < nvalid) ? src[(size_t)kk * ld + cc] : 0.f; }
    LDS_WAIT(); asm volatile("" ::: "memory");
    const int c = lane & 7;
#pragma unroll
    for (int j = 0; j < 4; ++j) { const int n = (lane >> 3) + 8 * j; const LAS float* s = scr + (8 * c) * 33 + n;
        v4u o; o.x = pk2(s[0 * 33], s[1 * 33]); o.y = pk2(s[2 * 33], s[3 * 33]); o.z = pk2(s[4 * 33], s[5 * 33]); o.w = pk2(s[6 * 33], s[7 * 33]);
        *(GAS v4u*)(dst + (size_t)n * Kd + k0 + 8 * c) = o; }
    LDS_WAIT(); asm volatile("" ::: "memory");
}
struct FArgs { const float* in[29]; float* out; unsigned char* ws; int ph_lo, ph_hi; };

__device__ __forceinline__ void phase_prologue(const FArgs& a, LAS unsigned char* lds, int gw, int NGW, int wave, int lane) {
    LAS float* scr = (LAS float*)(lds + wave * 16384);
    constexpr int NITEMS = grp_total();
    for (int it = gw; it < NITEMS; it += NGW) {
        int r = it, gi = 0;
#pragma unroll 1
        for (; gi < NGROUPS - 1; ++gi) { const int n = grp_items(gi); if (r < n) break; r -= n; }
        const CvtGroup G = kGroups[gi];
        const int ipm = (G.K / 64) * ((G.ncols + 31) / 32), mat = r / ipm, r2 = r % ipm, nblk = (G.ncols + 31) / 32, kb = r2 / nblk, nb = r2 % nblk;
        const int c0 = nb * 32, k0 = kb * 64, drow = (c0 / 128) * G.rs + (c0 % 128) + G.off;
        const float* src = a.in[G.in_idx] + (size_t)mat * G.src_stride + (size_t)k0 * G.ld + G.col0 + c0;
        bf16* dst = (bf16*)(a.ws + G.dst + (size_t)mat * G.dst_stride) + (size_t)drow * G.K;
        const int nvalid = (G.ncols - c0) < 32 ? (G.ncols - c0) : 32;
        cvt_item(src, G.ld, nvalid, dst, G.K, k0, scr, lane);
    }
    { const float* x = a.in[I_X]; bf16* xb = (bf16*)(a.ws + WS_XBF);
      for (size_t i = (size_t)gw * 64 + lane; i < (size_t)MTOK * DM / 8; i += (size_t)NGW * 64) {
        const f32x4 v0 = *(const GAS f32x4*)(x + i * 8), v1 = *(const GAS f32x4*)(x + i * 8 + 4);
        v4u o; o.x = pk2(v0.x, v0.y); o.y = pk2(v0.z, v0.w); o.z = pk2(v1.x, v1.y); o.w = pk2(v1.z, v1.w); *(GAS v4u*)(xb + i * 8) = o; } }
}

__device__ __forceinline__ void phase_ln(const float* Y, const float* gam, const float* bet, float* XO, bf16* XB, int gw, int NGW, int lane) {
    f32x4 gg[4], bb[4];
#pragma unroll
    for (int j = 0; j < 4; ++j) { gg[j] = *(const GAS f32x4*)(gam + 4 * lane + 256 * j); bb[j] = *(const GAS f32x4*)(bet + 4 * lane + 256 * j); }
    for (int m = gw; m < MTOK; m += NGW) {
        const GAS f32x4* yr = (const GAS f32x4*)(Y + (size_t)m * DM) + lane;
        f32x4 v[4]; float s = 0.f;
#pragma unroll
        for (int j = 0; j < 4; ++j) { v[j] = yr[64 * j]; s += (v[j].x + v[j].y) + (v[j].z + v[j].w); }
        const float mean = wave_sum(s) * (1.f / DM); float s2 = 0.f;
#pragma unroll
        for (int j = 0; j < 4; ++j) { v[j] = v[j] - mean; s2 += (v[j].x * v[j].x + v[j].y * v[j].y) + (v[j].z * v[j].z + v[j].w * v[j].w); }
        const float rstd = 1.f / sqrtf(wave_sum(s2) * (1.f / DM) + LN_EPS);
        GAS f32x4* xo = (GAS f32x4*)(XO + (size_t)m * DM) + lane;
#pragma unroll
        for (int j = 0; j < 4; ++j) { v[j] = v[j] * rstd * gg[j] + bb[j]; xo[64 * j] = v[j]; }
        if (XB) { GAS v2u* o8 = (GAS v2u*)(XB + (size_t)m * DM) + lane;
#pragma unroll
            for (int j = 0; j < 4; ++j) { v2u w; w.x = pk2(v[j].x, v[j].y); w.y = pk2(v[j].z, v[j].w); o8[64 * j] = w; } }
    }
}

constexpr int DWR = 8;
__device__ __forceinline__ void phase_conf_dw(const bf16* U, const float* wdw, const float* bdw, const float* gam, const float* bet, bf16* V, LAS unsigned char* lds, int tid, int wave, int lane) {
    LAS float* redA = (LAS float*)lds; LAS float* redB = redA + 64;
    LAS f32x2* wl = (LAS f32x2*)(lds + 1024);
    const unsigned loff = (unsigned)tid * 4u;
#pragma unroll 1
    for (int k = 0; k < CONV_K; ++k) wl[k * 512 + tid] = *(const GAS f32x2*)(wdw + k * DM + 2 * tid);
    const f32x2 bd = *(const GAS f32x2*)(bdw + 2 * tid), gg = *(const GAS f32x2*)(gam + 2 * tid), bb = *(const GAS f32x2*)(bet + 2 * tid);
    for (int chunk = blockIdx.x; chunk < MTOK / 64; chunk += gridDim.x) {
        const int r0 = chunk * 64, t0 = r0 % SEQ;
        f32x2 a[30 + DWR];
#pragma unroll
        for (int j = 0; j < 30; ++j) { unsigned u = 0u; if (t0 - 30 + j >= 0) u = *(const GAS unsigned*)((const GAS char*)U + (size_t)(r0 - 30 + j) * (DM * 2) + loff); a[j] = (f32x2){bf_lo(u), bf_hi(u)}; }
#pragma unroll 1
        for (int blk = 0; blk < 64 / DWR; ++blk) {
            const int rb = r0 + blk * DWR;
#pragma unroll
            for (int i = 0; i < DWR; ++i) { const unsigned u = *(const GAS unsigned*)((const GAS char*)U + (size_t)(rb + i) * (DM * 2) + loff); a[30 + i] = (f32x2){bf_lo(u), bf_hi(u)}; }
            f32x2 o[DWR]; float s[DWR];
#pragma unroll
            for (int i = 0; i < DWR; ++i) o[i] = bd;
#pragma unroll
            for (int k = 0; k < CONV_K; ++k) { const f32x2 w = wl[k * 512 + tid];
#pragma unroll
                for (int i = 0; i < DWR; ++i) o[i] += w * a[i + k]; }
#pragma unroll
            for (int i = 0; i < DWR; ++i) s[i] = wave_sum(o[i].x + o[i].y);
            if (lane == 0) {
#pragma unroll
                for (int i = 0; i < DWR; ++i) redA[wave * DWR + i] = s[i]; }
            __syncthreads();
#pragma unroll
            for (int i = 0; i < DWR; ++i) { float t = 0.f;
#pragma unroll
                for (int w = 0; w < 8; ++w) t += redA[w * DWR + i];
                const float mean = t * (1.f / DM); o[i] = o[i] - mean; s[i] = wave_sum(o[i].x * o[i].x + o[i].y * o[i].y); }
            if (lane == 0) {
#pragma unroll
                for (int i = 0; i < DWR; ++i) redB[wave * DWR + i] = s[i]; }
            __syncthreads();
#pragma unroll
            for (int i = 0; i < DWR; ++i) { float t = 0.f;
#pragma unroll
                for (int w = 0; w < 8; ++w) t += redB[w * DWR + i];
                const float rstd = 1.f / sqrtf(t * (1.f / DM) + LN_EPS);
                const f32x2 y = o[i] * rstd * gg + bb;
                *(GAS unsigned*)((GAS char*)V + (size_t)(rb + i) * (DM * 2) + loff) = pk2(fast_silu(y.x), fast_silu(y.y)); }
#pragma unroll
            for (int j = 0; j < 30; ++j) a[j] = a[j + DWR];
        }
    }
}

__device__ __forceinline__ void phase_shortconv(const bf16* CH, const bf16* BG, const float* wc, bf16* Y, int tid) {
    const unsigned loff = (unsigned)tid * 4u;
    const f32x2 w0 = *(const GAS f32x2*)(wc + 0 * DM + 2 * tid), w1 = *(const GAS f32x2*)(wc + 1 * DM + 2 * tid), w2 = *(const GAS f32x2*)(wc + 2 * DM + 2 * tid);
    for (int chunk = blockIdx.x; chunk < MTOK / 64; chunk += gridDim.x) {
        const int r0 = chunk * 64, t0 = r0 % SEQ;
        f32x2 p2 = (f32x2){0.f, 0.f}, p1 = p2;
        if (t0 > 0) { const unsigned ua = *(const GAS unsigned*)((const GAS char*)CH + (size_t)(r0 - 2) * (DM * 2) + loff), ub = *(const GAS unsigned*)((const GAS char*)CH + (size_t)(r0 - 1) * (DM * 2) + loff);
            p2 = (f32x2){bf_lo(ua), bf_hi(ua)}; p1 = (f32x2){bf_lo(ub), bf_hi(ub)}; }
#pragma unroll 8
        for (int i = 0; i < 64; ++i) {
            const unsigned uc = *(const GAS unsigned*)((const GAS char*)CH + (size_t)(r0 + i) * (DM * 2) + loff), ug = *(const GAS unsigned*)((const GAS char*)BG + (size_t)(r0 + i) * (DM * 2) + loff);
            const f32x2 c = (f32x2){bf_lo(uc), bf_hi(uc)}, g = (f32x2){bf_lo(ug), bf_hi(ug)};
            const f32x2 y = g * (w0 * p2 + w1 * p1 + w2 * c);
            *(GAS unsigned*)((GAS char*)Y + (size_t)(r0 + i) * (DM * 2) + loff) = pk2(y.x, y.y);
            p2 = p1; p1 = c; }
    }
}

__device__ __forceinline__ void phase_ln_router(const float* Y, const float* gam, const float* bet, float* XO, bf16* XB, const float* wr, unsigned* cnt, int* list, int* tsel, float* twt,
                                                LAS unsigned char* lds, int gw, int NGW, int tid, int lane) {
    LAS f32x4* wl = (LAS f32x4*)lds;
    for (int i = tid; i < DM * NEXP / 4; i += NTHR) wl[i] = *(const GAS f32x4*)(wr + 4 * i);
    __syncthreads();
    f32x4 gg[4], bb[4];
#pragma unroll
    for (int j = 0; j < 4; ++j) { gg[j] = *(const GAS f32x4*)(gam + 4 * lane + 256 * j); bb[j] = *(const GAS f32x4*)(bet + 4 * lane + 256 * j); }
    for (int m = gw; m < MTOK; m += NGW) {
        const GAS f32x4* yr = (const GAS f32x4*)(Y + (size_t)m * DM) + lane;
        f32x4 v[4]; float s = 0.f;
#pragma unroll
        for (int j = 0; j < 4; ++j) { v[j] = yr[64 * j]; s += (v[j].x + v[j].y) + (v[j].z + v[j].w); }
        const float mean = wave_sum(s) * (1.f / DM); float s2 = 0.f;
#pragma unroll
        for (int j = 0; j < 4; ++j) { v[j] = v[j] - mean; s2 += (v[j].x * v[j].x + v[j].y * v[j].y) + (v[j].z * v[j].z + v[j].w * v[j].w); }
        const float rstd = 1.f / sqrtf(wave_sum(s2) * (1.f / DM) + LN_EPS);
        GAS f32x4* xo = (GAS f32x4*)(XO + (size_t)m * DM) + lane;
        GAS v2u* o8 = (GAS v2u*)(XB + (size_t)m * DM) + lane;
        f32x4 la = (f32x4){0.f, 0.f, 0.f, 0.f}, lb = la;
#pragma unroll
        for (int j = 0; j < 4; ++j) { v[j] = v[j] * rstd * gg[j] + bb[j]; xo[64 * j] = v[j];
            v2u w; w.x = pk2(v[j].x, v[j].y); w.y = pk2(v[j].z, v[j].w); o8[64 * j] = w;
#pragma unroll
            for (int i = 0; i < 4; ++i) { const int c = 4 * lane + 256 * j + i; const f32x4 wa = wl[2 * c], wb = wl[2 * c + 1]; la += wa * v[j][i]; lb += wb * v[j][i]; } }
        float lg[NEXP];
#pragma unroll
        for (int e = 0; e < 4; ++e) { lg[e] = wave_sum(la[e]); lg[4 + e] = wave_sum(lb[e]); }
        if (lane == 0) {
            int e1 = 0; float v1 = lg[0];
#pragma unroll
            for (int e = 1; e < NEXP; ++e) if (lg[e] > v1) { v1 = lg[e]; e1 = e; }
            int e2 = -1; float v2 = -3.4e38f;
#pragma unroll
            for (int e = 0; e < NEXP; ++e) if (e != e1 && lg[e] > v2) { v2 = lg[e]; e2 = e; }
            const float p2 = expf(v2 - v1), w1 = 1.0f / (1.0f + p2), w2 = p2 / (1.0f + p2);
            const int s1 = (int)__hip_atomic_fetch_add(cnt + e1, 1u, RLX_AGENT), sl2 = (int)__hip_atomic_fetch_add(cnt + e2, 1u, RLX_AGENT);
            list[e1 * MTOK + s1] = m; list[e2 * MTOK + sl2] = m;
            *(int4*)(tsel + 4 * m) = make_int4(e1, s1, e2, sl2); *(float2*)(twt + 2 * m) = make_float2(w1, w2);
        }
    }
}
__device__ __forceinline__ void moe_panels(const unsigned* cnt, int (&pb)[9]) {
    int acc = 0;
#pragma unroll
    for (int e = 0; e < NEXP; ++e) { pb[e] = acc; const int c = (int)__builtin_amdgcn_readfirstlane((int)cnt[e]); acc += (c + 255) >> 8; }
    pb[NEXP] = acc;
}
__device__ __forceinline__ void phase_moe_permute(const bf16* XB, const unsigned* cnt, const int* list, bf16* AP, int gw, int NGW, int lane) {
    int pb[9]; moe_panels(cnt, pb);
    const int total = pb[NEXP] * 256;
    for (int r = gw; r < total; r += NGW) {
        const int pm = r >> 8; int e = 0;
#pragma unroll
        for (int k = 1; k < NEXP; ++k) e += (pm >= pb[k]) ? 1 : 0;
        const int c = (int)cnt[e]; int slot = r - pb[e] * 256; slot = slot < c ? slot : c - 1;
        const int m = list[e * MTOK + slot];
        const GAS v4u* src = (const GAS v4u*)(XB + (size_t)m * DM) + lane; GAS v4u* dst = (GAS v4u*)(AP + (size_t)r * DM) + lane;
        const v4u a = src[0], b = src[64]; dst[0] = a; dst[64] = b;
    }
}
__device__ __forceinline__ void phase_ln_moe(const float* X, const bf16* YM, const unsigned* cnt, const int* tsel, const float* twt, const float* gam, const float* bet, float* XO, bf16* XB, int gw, int NGW, int lane) {
    int pb[9]; moe_panels(cnt, pb);
    f32x4 gg[4], bb[4];
#pragma unroll
    for (int j = 0; j < 4; ++j) { gg[j] = *(const GAS f32x4*)(gam + 4 * lane + 256 * j); bb[j] = *(const GAS f32x4*)(bet + 4 * lane + 256 * j); }
    for (int m = gw; m < MTOK; m += NGW) {
        const int4 ts = *(const int4*)(tsel + 4 * m); const float2 tw = *(const float2*)(twt + 2 * m);
        int b1 = 0, b2 = 0;
#pragma unroll
        for (int e = 0; e < NEXP; ++e) { b1 = (ts.x == e) ? pb[e] : b1; b2 = (ts.z == e) ? pb[e] : b2; }
        const GAS v2u* y1 = (const GAS v2u*)(YM + (size_t)(b1 * 256 + ts.y) * DM) + lane; const GAS v2u* y2 = (const GAS v2u*)(YM + (size_t)(b2 * 256 + ts.w) * DM) + lane;
        const GAS f32x4* xr = (const GAS f32x4*)(X + (size_t)m * DM) + lane;
        f32x4 v[4]; float s = 0.f;
#pragma unroll
        for (int j = 0; j < 4; ++j) { const v2u p = y1[64 * j], q = y2[64 * j];
            const f32x4 a = (f32x4){bf_lo(p.x), bf_hi(p.x), bf_lo(p.y), bf_hi(p.y)}, b = (f32x4){bf_lo(q.x), bf_hi(q.x), bf_lo(q.y), bf_hi(q.y)};
            v[j] = xr[64 * j] * ALPHA_F + a * tw.x + b * tw.y; s += (v[j].x + v[j].y) + (v[j].z + v[j].w); }
        const float mean = wave_sum(s) * (1.f / DM); float s2 = 0.f;
#pragma unroll
        for (int j = 0; j < 4; ++j) { v[j] = v[j] - mean; s2 += (v[j].x * v[j].x + v[j].y * v[j].y) + (v[j].z * v[j].z + v[j].w * v[j].w); }
        const float rstd = 1.f / sqrtf(wave_sum(s2) * (1.f / DM) + LN_EPS);
        GAS f32x4* xo = (GAS f32x4*)(XO + (size_t)m * DM) + lane;
#pragma unroll
        for (int j = 0; j < 4; ++j) { v[j] = v[j] * rstd * gg[j] + bb[j]; xo[64 * j] = v[j]; }
        if (XB) { GAS v2u* o8 = (GAS v2u*)(XB + (size_t)m * DM) + lane;
#pragma unroll
            for (int j = 0; j < 4; ++j) { v2u w; w.x = pk2(v[j].x, v[j].y); w.y = pk2(v[j].z, v[j].w); o8[64 * j] = w; } }
    }
}

typedef float f32x16_t __attribute__((ext_vector_type(16)));
__device__ __forceinline__ float gelu_tanh_fast(float x) { const float u = 0.7978845608028654f * (x + 0.044715f * x * x * x); const float e = __builtin_amdgcn_exp2f(2.0f * 1.4426950408889634f * u); return x * (1.0f - __builtin_amdgcn_rcpf(1.0f + e)); }
__device__ __forceinline__ int crow(int r, int hi) { return (r & 3) + 8 * (r >> 2) + 4 * hi; }
__device__ __forceinline__ void phase_compress(const bf16* KC, const bf16* VC, const bf16* W1T, const float* pek, const float* pev, const float* wk2, const float* wv2, bf16* KCMP, bf16* VCMPT,
                                               LAS unsigned char* lds, int tid, int wave, int lane) {
    LAS float* P = (LAS float*)lds;
    const int r32 = lane & 31, hi = lane >> 5;
    for (int unit = blockIdx.x; unit < 2 * BATCH * NKV * 4; unit += gridDim.x) {
        const int kv = unit >> 7, bh = (unit >> 2) & 31, rg = unit & 3;
        const bf16* src = (kv ? VC : KC) + ((size_t)bh * SEQ + 16 * (32 * rg + r32)) * HD;
        const float* pe = kv ? pev : pek;
        const bf16* wb = W1T + (size_t)(kv * PHI + r32) * (CMP_BLOCK * HD);
        f32x16_t acc[4];
#pragma unroll
        for (int nb = 0; nb < 4; ++nb)
#pragma unroll
            for (int q = 0; q < 16; ++q) acc[nb][q] = 0.f;
#pragma unroll 2
        for (int s = 0; s < 16; ++s) {
            const int k0 = (wave * 16 + s) * 16 + 8 * hi;
            const v4u araw = *(const GAS v4u*)(src + k0);
            const f32x4 p0 = *(const GAS f32x4*)(pe + k0), p1 = *(const GAS f32x4*)(pe + k0 + 4);
            v4u af; af.x = pk2(bf_lo(araw.x) + p0.x, bf_hi(araw.x) + p0.y); af.y = pk2(bf_lo(araw.y) + p0.z, bf_hi(araw.y) + p0.w);
            af.z = pk2(bf_lo(araw.z) + p1.x, bf_hi(araw.z) + p1.y); af.w = pk2(bf_lo(araw.w) + p1.z, bf_hi(araw.w) + p1.w);
            const bf16x8 a8 = __builtin_bit_cast(bf16x8, af);
#pragma unroll
            for (int nb = 0; nb < 4; ++nb) { const bf16x8 b8 = __builtin_bit_cast(bf16x8, *(const GAS v4u*)(wb + (size_t)nb * 32 * (CMP_BLOCK * HD) + k0));
                acc[nb] = __builtin_amdgcn_mfma_f32_32x32x16_bf16(a8, b8, acc[nb], 0, 0, 0); }
        }
        __syncthreads();
#pragma unroll
        for (int nb = 0; nb < 4; ++nb)
#pragma unroll
            for (int q = 0; q < 16; ++q) P[(wave * 32 + crow(q, hi)) * 128 + nb * 32 + r32] = acc[nb][q];
        __syncthreads();
#pragma unroll
        for (int i = 0; i < 8; ++i) { const int e = tid + NTHR * i; float t = 0.f;
#pragma unroll
            for (int w = 0; w < 8; ++w) t += P[w * 4096 + e];
            P[e] = gelu_tanh_fast(t); }
        __syncthreads();
        { const int r = tid >> 4, dg = (tid & 15) * 4; const float* w2 = (kv ? wv2 : wk2) + dg; f32x4 o = (f32x4){0.f, 0.f, 0.f, 0.f};
#pragma unroll 8
          for (int jj = 0; jj < PHI; ++jj) o += *(const GAS f32x4*)(w2 + jj * HD) * P[r * 128 + jj];
          const int c = 32 * rg + r;
          if (c == NCMP) o = (f32x4){0.f, 0.f, 0.f, 0.f};
          if (kv == 0) { v2u w; w.x = pk2(o.x, o.y); w.y = pk2(o.z, o.w); *(GAS v2u*)(KCMP + ((size_t)bh * 128 + c) * HD + dg) = w; }
          else {
#pragma unroll
              for (int j = 0; j < 4; ++j) VCMPT[((size_t)bh * HD + dg + j) * 128 + c] = (bf16)f2bf(o[j]); } }
    }
    __syncthreads();
}

#ifndef ATT_LEVEL
#define ATT_LEVEL 4
#endif
constexpr int AT_KP = 144, AT_VP = 136;
constexpr int AT_K = 0, AT_V = 2 * 64 * AT_KP, AT_IMP = AT_V + 2 * 64 * AT_VP, AT_SC = AT_IMP + 4 * 2 * 64 * 33 * 4, AT_SEL = AT_SC + 64 * 33 * 4, AT_WSF = AT_SEL + 512, AT_END = AT_WSF + 8 * 64 * 4;
static_assert(AT_END <= RING_BYTES, "attention LDS map");
struct AttTensors { const bf16 *Q, *KC, *KS, *VST, *KW, *VWT, *KCMP, *VCMPT; const float* GATE; bf16* O; };
__device__ __forceinline__ float swap_max(float v) { auto rr = __builtin_amdgcn_permlane32_swap(__float_as_uint(v), __float_as_uint(v), false, false); return fmaxf(__uint_as_float(rr[0]), __uint_as_float(rr[1])); }
__device__ __forceinline__ float swap_add(float v) { auto rr = __builtin_amdgcn_permlane32_swap(__float_as_uint(v), __float_as_uint(v), false, false); return __uint_as_float(rr[0]) + __uint_as_float(rr[1]); }

__device__ __forceinline__ void phase_nsa_attn(const AttTensors T, LAS unsigned char* lds, int tid, int wave, int lane) {
    const int r32 = lane & 31, hi = lane >> 5, g = wave >> 1, th = wave & 1, tl = 32 * th + r32;
    LAS float* wsf = (LAS float*)(lds + AT_WSF) + wave * 64;
    LAS float* IMP = (LAS float*)(lds + AT_IMP); LAS float* SC = (LAS float*)(lds + AT_SC); LAS unsigned* SEL = (LAS unsigned*)(lds + AT_SEL);
    const int ldrow = tid >> 3, ldch = tid & 7;
    const float NEG = -INFINITY;
    const int vcu = (gridDim.x % 8 == 0) ? (int)((blockIdx.x % 8) * (gridDim.x / 8) + blockIdx.x / 8) : (int)blockIdx.x;
    for (int ui = 0; ; ++ui) {
        int bh, qi;
        if (gridDim.x == 256) { if (ui >= 4) break; const int s = vcu & 7; bh = vcu >> 3; qi = (ui == 0) ? s : (ui == 1) ? 31 - s : (ui == 2) ? 8 + s : 23 - s; }
        else { const int u = blockIdx.x + ui * gridDim.x; if (u >= BATCH * NKV * NSLC) break; bh = u >> 5; qi = u & 31; }
        const int b = bh >> 2, hk = bh & 3, t = qi * 64 + tl;
        const size_t mrow = (size_t)b * SEQ + t;
        bf16x8 qf[4];
        { const bf16* qp = T.Q + (((size_t)(b * NH + hk * NG + g) * SEQ + t) * HD + 8 * hi);
#pragma unroll
          for (int s = 0; s < 4; ++s) qf[s] = __builtin_bit_cast(bf16x8, *(const GAS v4u*)(qp + 16 * s)); }
        const float* gp = T.GATE + mrow * 48 + hk * 12 + g * 3;
        const float g0 = gp[0], g1 = gp[1], g2 = gp[2];
        if (tid < 65) SEL[tid] = 0u;
        f32x16_t ot0, ot1;
#define AT_LOADK(dst, kptr) dst = *(const GAS v4u*)((kptr) + (size_t)ldrow * HD + ldch * 8)
#define AT_LOADV(dst, vptr, vstride) dst = *(const GAS v4u*)((vptr) + (size_t)ldrow * (vstride) + ldch * 8)
#define AT_STORE(buf, kreg, vreg) do { *(LAS v4u*)(lds + AT_K + (buf) * 64 * AT_KP + ldrow * AT_KP + ldch * 16) = kreg; \
        LAS v2u* vd_ = (LAS v2u*)(lds + AT_V + (buf) * 64 * AT_VP + ldrow * AT_VP + ldch * 16); vd_[0] = (v2u){vreg.x, vreg.y}; vd_[1] = (v2u){vreg.z, vreg.w}; } while (0)
#define AT_QK(buf, s0, s1) do { const LAS unsigned char* kb_ = lds + AT_K + (buf) * 64 * AT_KP + r32 * AT_KP + 16 * hi; \
        _Pragma("unroll") for (int r_ = 0; r_ < 16; ++r_) { s0[r_] = 0.f; s1[r_] = 0.f; } \
        _Pragma("unroll") for (int s_ = 0; s_ < 4; ++s_) { const bf16x8 k0_ = *(const LAS bf16x8*)(kb_ + 32 * s_), k1_ = *(const LAS bf16x8*)(kb_ + 32 * AT_KP + 32 * s_); \
            s0 = __builtin_amdgcn_mfma_f32_32x32x16_bf16(k0_, qf[s_], s0, 0, 0, 0); s1 = __builtin_amdgcn_mfma_f32_32x32x16_bf16(k1_, qf[s_], s1, 0, 0, 0); } } while (0)
#define AT_PV(buf, p0, p1, o0, o1) do { \
        v4u pa_[4]; \
        pa_[0] = (v4u){cvt_pk_bf16(p0[0], p0[1]), cvt_pk_bf16(p0[2], p0[3]), cvt_pk_bf16(p0[4], p0[5]), cvt_pk_bf16(p0[6], p0[7])}; \
        pa_[1] = (v4u){cvt_pk_bf16(p0[8], p0[9]), cvt_pk_bf16(p0[10], p0[11]), cvt_pk_bf16(p0[12], p0[13]), cvt_pk_bf16(p0[14], p0[15])}; \
        pa_[2] = (v4u){cvt_pk_bf16(p1[0], p1[1]), cvt_pk_bf16(p1[2], p1[3]), cvt_pk_bf16(p1[4], p1[5]), cvt_pk_bf16(p1[6], p1[7])}; \
        pa_[3] = (v4u){cvt_pk_bf16(p1[8], p1[9]), cvt_pk_bf16(p1[10], p1[11]), cvt_pk_bf16(p1[12], p1[13]), cvt_pk_bf16(p1[14], p1[15])}; \
        const LAS unsigned char* vb_ = lds + AT_V + (buf) * 64 * AT_VP + r32 * AT_VP + 8 * hi; \
        _Pragma("unroll") for (int ks_ = 0; ks_ < 4; ++ks_) { \
            const v2u a0_ = *(const LAS v2u*)(vb_ + 32 * ks_), a1_ = *(const LAS v2u*)(vb_ + 32 * ks_ + 16); \
            const v2u b0_ = *(const LAS v2u*)(vb_ + 32 * AT_VP + 32 * ks_), b1_ = *(const LAS v2u*)(vb_ + 32 * AT_VP + 32 * ks_ + 16); \
            const bf16x8 pf_ = __builtin_bit_cast(bf16x8, pa_[ks_]); \
            o0 = __builtin_amdgcn_mfma_f32_32x32x16_bf16(pf_, __builtin_bit_cast(bf16x8, ((v4u){a0_.x, a0_.y, a1_.x, a1_.y})), o0, 0, 0, 0); \
            o1 = __builtin_amdgcn_mfma_f32_32x32x16_bf16(pf_, __builtin_bit_cast(bf16x8, ((v4u){b0_.x, b0_.y, b1_.x, b1_.y})), o1, 0, 0, 0); } } while (0)
#define AT_ROWSCALE_LOAD(f) do { if (hi == 0) wsf[r32] = (f); asm volatile("s_waitcnt lgkmcnt(0)" ::: "memory"); } while (0)
#define AT_ROWF(r_) wsf[crow(r_, hi)]

        { v4u k0, v0, k1, v1;
          const bf16* kc = T.KCMP + (size_t)bh * 128 * HD; const bf16* vc = T.VCMPT + (size_t)bh * HD * 128;
          AT_LOADK(k0, kc); AT_LOADV(v0, vc, 128); AT_LOADK(k1, kc + 64 * HD); AT_LOADV(v1, vc + 64, 128);
          __syncthreads();
          AT_STORE(0, k0, v0); AT_STORE(1, k1, v1);
          __syncthreads(); }
        {
          f32x16_t s0, s1, s2, s3;
          AT_QK(0, s0, s1); AT_QK(1, s2, s3);
          float mx = NEG;
#pragma unroll
          for (int r = 0; r < 16; ++r) { const int c = crow(r, hi);
              s0[r] = (16 * c + 31 <= t) ? s0[r] : NEG; s1[r] = (16 * (c + 32) + 31 <= t) ? s1[r] : NEG; s2[r] = (16 * (c + 64) + 31 <= t) ? s2[r] : NEG; s3[r] = (16 * (c + 96) + 31 <= t) ? s3[r] : NEG;
              mx = fmaxf(fmaxf(mx, s0[r]), fmaxf(fmaxf(s1[r], s2[r]), s3[r])); }
          mx = fmaxf(swap_max(mx), -1e30f);
          float l = 0.f;
#pragma unroll
          for (int r = 0; r < 16; ++r) { s0[r] = __builtin_amdgcn_exp2f(s0[r] - mx); s1[r] = __builtin_amdgcn_exp2f(s1[r] - mx); s2[r] = __builtin_amdgcn_exp2f(s2[r] - mx); s3[r] = __builtin_amdgcn_exp2f(s3[r] - mx);
              l += (s0[r] + s1[r]) + (s2[r] + s3[r]); }
          l = swap_add(l);
          const float inv = 1.0f / fmaxf(l, 1e-30f);
#pragma unroll
          for (int r = 0; r < 16; ++r) { s0[r] *= inv; s1[r] *= inv; s2[r] *= inv; s3[r] *= inv; }
          { LAS float* I0 = IMP + ((g * 2 + 0) * 64 + tl) * 33; LAS float* I1 = IMP + ((g * 2 + 1) * 64 + tl) * 33;
#pragma unroll
            for (int a = 0; a < 4; ++a) { const int n = 2 * a + hi;
                I0[n] = (s0[4 * a] + s0[4 * a + 1]) + (s0[4 * a + 2] + s0[4 * a + 3]); I1[n + 1] = s0[4 * a + 3];
                I0[n + 8] = (s1[4 * a] + s1[4 * a + 1]) + (s1[4 * a + 2] + s1[4 * a + 3]); I1[n + 9] = s1[4 * a + 3];
                I0[n + 16] = (s2[4 * a] + s2[4 * a + 1]) + (s2[4 * a + 2] + s2[4 * a + 3]); I1[n + 17] = s2[4 * a + 3];
                I0[n + 24] = (s3[4 * a] + s3[4 * a + 1]) + (s3[4 * a + 2] + s3[4 * a + 3]); if (n + 25 < 33) I1[n + 25] = s3[4 * a + 3]; } }
          f32x16_t o0, o1;
#pragma unroll
          for (int r = 0; r < 16; ++r) { o0[r] = 0.f; o1[r] = 0.f; }
          AT_PV(0, s0, s1, o0, o1); AT_PV(1, s2, s3, o0, o1);
          AT_ROWSCALE_LOAD(g0);
#pragma unroll
          for (int r = 0; r < 16; ++r) { const float f = AT_ROWF(r); ot0[r] = o0[r] * f; ot1[r] = o1[r] * f; }
        }
        __syncthreads();
        { const int st = tid >> 3, grp = tid & 7;
#pragma unroll
          for (int i = 0; i < 4; ++i) { const int n = 4 * grp + i; float imp = 0.f;
#pragma unroll
              for (int gg = 0; gg < 4; ++gg) { imp += IMP[((gg * 2 + 0) * 64 + st) * 33 + n]; if (n > 0) imp += IMP[((gg * 2 + 1) * 64 + st) * 33 + n]; }
              const bool forced = (n == 0) || (n == qi) || (n == qi - 1);
              SC[st * 33 + n] = forced ? 1e4f : ((n <= qi) ? imp : -1e30f); }
          __syncthreads();
          unsigned bits = 0u;
#pragma unroll
          for (int i = 0; i < 4; ++i) { const int n = 4 * grp + i; const float sn = SC[st * 33 + n]; int rank = 0;
#pragma unroll 8
              for (int m2 = 0; m2 < NSLC; ++m2) { const float sm = SC[st * 33 + m2]; rank += (sm > sn || (sm == sn && m2 < n)) ? 1 : 0; }
              if (rank < TOPN && n <= qi) bits |= 1u << n; }
          if (bits) { __hip_atomic_fetch_or(SEL + st, bits, __ATOMIC_RELAXED, __HIP_MEMORY_SCOPE_WORKGROUP); __hip_atomic_fetch_or(SEL + 64, bits, __ATOMIC_RELAXED, __HIP_MEMORY_SCOPE_WORKGROUP); }
          __syncthreads(); }
        const unsigned selmask = SEL[tl]; const unsigned selunion = SEL[64];
#pragma unroll 1
        for (int mode = 0; mode < (ATT_LEVEL >= 4 ? 2 : (ATT_LEVEL == 3 ? 1 : 0)); ++mode) {
            const bf16* Kb = (mode == 0 ? T.KS : T.KW) + (size_t)bh * SEQ * HD; const bf16* Vb = (mode == 0 ? T.VST : T.VWT) + (size_t)bh * HD * SEQ;
            const int jlo = qi >= 8 ? qi - 8 : 0;
            unsigned todo = (mode == 0) ? selunion : (((2u << qi) - 1u) & ~((1u << jlo) - 1u));
            float m = -1e30f, l = 0.f; f32x16_t o0, o1;
#pragma unroll
            for (int r = 0; r < 16; ++r) { o0[r] = 0.f; o1[r] = 0.f; }
            int cur = 0;
            { const int j = __builtin_ctz(todo); v4u kr, vr; AT_LOADK(kr, Kb + (size_t)j * 64 * HD); AT_LOADV(vr, Vb + j * 64, SEQ); AT_STORE(0, kr, vr); }
            __syncthreads();
#pragma unroll 1
            while (todo) {
                const int j = __builtin_ctz(todo); todo &= todo - 1u;
                v4u kr, vr;
                if (todo) { const int jn = __builtin_ctz(todo); AT_LOADK(kr, Kb + (size_t)jn * 64 * HD); AT_LOADV(vr, Vb + jn * 64, SEQ); }
                const bool mine = (mode == 0) ? ((selmask >> j) & 1u) != 0u : true;
                if (__any(mine)) {
                    f32x16_t s0, s1;
                    AT_QK(cur, s0, s1);
                    float mx = NEG;
                    const bool diag = (j == qi), tail = (mode == 1 && j == qi - 8);
#pragma unroll
                    for (int r = 0; r < 16; ++r) { const int k0 = crow(r, hi), k1 = k0 + 32;
                        bool v0 = mine, v1 = mine;
                        if (diag) { v0 = v0 && (k0 <= tl); v1 = v1 && (k1 <= tl); }
                        if (tail) { v0 = v0 && (k0 > tl); v1 = v1 && (k1 > tl); }
                        s0[r] = v0 ? s0[r] : NEG; s1[r] = v1 ? s1[r] : NEG; mx = fmaxf(mx, fmaxf(s0[r], s1[r])); }
                    mx = swap_max(mx);
                    const float mn = fmaxf(m, mx);
                    if (__any(mn > m)) { const float f = __builtin_amdgcn_exp2f(m - mn); l *= f; m = mn; AT_ROWSCALE_LOAD(f);
#pragma unroll
                        for (int r = 0; r < 16; ++r) { const float fr_ = AT_ROWF(r); o0[r] *= fr_; o1[r] *= fr_; } }
                    float ls = 0.f;
#pragma unroll
                    for (int r = 0; r < 16; ++r) { s0[r] = __builtin_amdgcn_exp2f(s0[r] - m); s1[r] = __builtin_amdgcn_exp2f(s1[r] - m); ls += s0[r] + s1[r]; }
                    l += ls;
                    AT_PV(cur, s0, s1, o0, o1);
                }
                if (todo) AT_STORE(cur ^ 1, kr, vr);
                __syncthreads();
                cur ^= 1;
            }
            l = swap_add(l);
            AT_ROWSCALE_LOAD((mode == 0 ? g1 : g2) / fmaxf(l, 1e-30f));
#pragma unroll
            for (int r = 0; r < 16; ++r) { const float f = AT_ROWF(r); ot0[r] += o0[r] * f; ot1[r] += o1[r] * f; }
        }
        { bf16* ob = T.O + ((size_t)b * SEQ + qi * 64 + 32 * th) * DM + (hk * NG + g) * HD + r32;
#pragma unroll
          for (int r = 0; r < 16; ++r) { bf16* p = ob + (size_t)crow(r, hi) * DM; if (ATT_LEVEL < 2) { ot0[r] = 0.f; ot1[r] = 0.f; } p[0] = (bf16)f2bf(ot0[r]); p[32] = (bf16)f2bf(ot1[r]); } }
#undef AT_LOADK
#undef AT_LOADV
#undef AT_STORE
#undef AT_QK
#undef AT_PV
#undef AT_ROWSCALE_LOAD
#undef AT_ROWF
    }
    __syncthreads();
}

enum { PH_PRO = 0,
       PH0_WIN, PH0_DW, PH0_WOUT, PH0_LN1, PH0_GU, PH0_DOWN, PH0_LN2,
       PH1_WIN, PH1_CONV, PH1_WOUT, PH1_LN1, PH1_PERM, PH1_MGU, PH1_MDOWN, PH1_LN2,
       PH2_WIN, PH2_CMP, PH2_ATT, PH2_WOUT, PH2_LN1, PH2_GU, PH2_DOWN, PH2_LN2,
       PH3_WIN, PH3_DW, PH3_WOUT, PH3_LN1, PH3_PERM, PH3_MGU, PH3_MDOWN, PH3_LN2, PH_END };

#ifndef FAST_PREFIX
#define FAST_PREFIX 2
#endif
#ifndef ONE_LAUNCH
#define ONE_LAUNCH 0
#endif
constexpr int kSubEnd[8] = {PH0_LN1, PH0_LN2, PH1_LN1, PH1_LN2, PH2_LN1, PH2_LN2, PH3_LN1, PH3_LN2};
constexpr int FAST_END = FAST_PREFIX == 0 ? 0 : kSubEnd[FAST_PREFIX - 1] + 1;

struct Ctx { LAS unsigned char* lds; int tid, lane, wave, G, bx, gw, NGW, lo, hi; XcdBarrier bar; };
#define IN(k) (c.lo <= (k) && (k) < c.hi)
#define SEAM(k) do { if (IN(k) && IN((k) + 1)) xcd_barrier(c.bar); } while (0)
#define WSP(T, off) ((T*)(a.ws + (off)))

template <int L, int PH, bool FFN_SIDE> __device__ __forceinline__ void ln_plain(const FArgs& a, const Ctx& c) {
    if (IN(PH)) { const float* g = a.in[FFN_SIDE ? I_LFG : I_LMG] + L * DM; const float* b = a.in[FFN_SIDE ? I_LFB : I_LMB] + L * DM;
        constexpr bool LAST = FFN_SIDE && L == DEPTH - 1;
        phase_ln(WSP(float, WS_X), g, b, LAST ? a.out : WSP(float, WS_X), LAST ? (bf16*)nullptr : WSP(bf16, WS_XBF), c.gw, c.NGW, c.lane); }
    SEAM(PH);
}
template <int L, int PH> __device__ __forceinline__ void ln_router(const FArgs& a, const Ctx& c) {
    constexpr int f = L / 2;
    if (IN(PH)) phase_ln_router(WSP(float, WS_X), a.in[I_LMG] + L * DM, a.in[I_LMB] + L * DM, WSP(float, WS_X), WSP(bf16, WS_XBF), a.in[I_MWR] + (size_t)f * DM * NEXP,
                                (unsigned*)WSP(unsigned, WS_CTL) + CW_MOE + 64 * f, WSP(int, MS_LIST), WSP(int, MS_TSEL), WSP(float, MS_TWT), c.lds, c.gw, c.NGW, c.tid, c.lane);
    SEAM(PH);
}
template <int L, int PH> __device__ __forceinline__ void conformer_mixer(const FArgs& a, const Ctx& c) {
    constexpr int j = L / 3;
    bf16* U = WSP(bf16, A_U); bf16* V = WSP(bf16, A_V); float* X = WSP(float, WS_X);
    if (IN(PH)) { pg8::Gemm g{WSP(bf16, WS_XBF), WSP(bf16, W_CONF_IN + (size_t)j * 4 * MiB), DM, DM, 0}; pg8::StaticOrder S; S.init(MTOK / 256, 8, c.G, c.bx);
        pg8::EpiPair<0> E{U, DM}; pg8::gemm_phase<pg8::EpiPair<0>, pg8::StaticOrder, true, true>(c.lds, g, S, E); } SEAM(PH);
    if (IN(PH + 1)) phase_conf_dw(U, a.in[I_CWDW] + (size_t)j * CONV_K * DM, a.in[I_CBDW] + j * DM, a.in[I_CLNG] + j * DM, a.in[I_CLNB] + j * DM, V, c.lds, c.tid, c.wave, c.lane);
    SEAM(PH + 1);
    if (IN(PH + 2)) { pg8::Gemm g{V, WSP(bf16, W_CONF_OUT + (size_t)j * 2 * MiB), DM, DM, 0}; pg8::StaticOrder S; S.init(MTOK / 256, 4, c.G, c.bx);
        pg8::EpiResid E{L == 0 ? a.in[I_X] : X, X, DM}; pg8::gemm_phase<pg8::EpiResid, pg8::StaticOrder, false, true>(c.lds, g, S, E); } SEAM(PH + 2);
}
template <int L, int PH> __device__ __forceinline__ void sc_mixer(const FArgs& a, const Ctx& c) {
    constexpr int j = L / 3;
    bf16* CH = WSP(bf16, A_CH); bf16* BG = WSP(bf16, A_BG); bf16* YS = WSP(bf16, A_YSC); float* X = WSP(float, WS_X);
    if (IN(PH)) { pg8::Gemm g{WSP(bf16, WS_XBF), WSP(bf16, W_SC_IN), DM, DM, 0}; pg8::StaticOrder S; S.init(MTOK / 256, 12, c.G, c.bx);
        pg8::EpiSC E{CH, BG}; pg8::gemm_phase<pg8::EpiSC, pg8::StaticOrder, true, true>(c.lds, g, S, E); } SEAM(PH);
    if (IN(PH + 1)) phase_shortconv(CH, BG, a.in[I_SWCONV] + (size_t)j * SHORT_K * DM, YS, c.tid);
    SEAM(PH + 1);
    if (IN(PH + 2)) { pg8::Gemm g{YS, WSP(bf16, W_SC_OUT), DM, DM, 0}; pg8::StaticOrder S; S.init(MTOK / 256, 4, c.G, c.bx);
        pg8::EpiResid E{X, X, DM}; pg8::gemm_phase<pg8::EpiResid, pg8::StaticOrder, false, true>(c.lds, g, S, E); } SEAM(PH + 2);
}
template <int L, int PH> __device__ __forceinline__ void dense_ffn(const FArgs& a, const Ctx& c) {
    constexpr int f = L / 2;
    bf16* HB = WSP(bf16, WS_H); float* X = WSP(float, WS_X);
    if (IN(PH)) { pg8::Gemm g{WSP(bf16, WS_XBF), WSP(bf16, W_FFN_GU + (size_t)f * 11 * MiB), DM, DM, 0}; pg8::StaticOrder S; S.init(MTOK / 256, DFF / 128, c.G, c.bx);
        pg8::EpiPair<1> E{HB, DFF}; pg8::gemm_phase<pg8::EpiPair<1>, pg8::StaticOrder, true, true>(c.lds, g, S, E); } SEAM(PH);
    if (IN(PH + 1)) { pg8::Gemm g{HB, WSP(bf16, W_FFN_D + (size_t)f * DM * DFF * 2), DFF, DFF, 0}; pg8::StaticOrder S; S.init(MTOK / 256, 4, c.G, c.bx);
        pg8::EpiResid E{X, X, DM}; pg8::gemm_phase<pg8::EpiResid, pg8::StaticOrder, false, true>(c.lds, g, S, E); } SEAM(PH + 1);
}
template <int L, int PH> __device__ __forceinline__ void moe_ffn(const FArgs& a, const Ctx& c) {
    constexpr int f = L / 2;
    const unsigned* cnt = (const unsigned*)WSP(unsigned, WS_CTL) + CW_MOE + 64 * f;
    bf16* AP = WSP(bf16, A_PERM); bf16* HB = WSP(bf16, WS_H);
    if (IN(PH)) phase_moe_permute(WSP(bf16, WS_XBF), cnt, WSP(int, MS_LIST), AP, c.gw, c.NGW, c.lane);
    SEAM(PH);
    if (IN(PH + 1)) { pg8::Gemm g{AP, WSP(bf16, W_MOE_GU + (size_t)f * 112 * MiB), DM, DM, (size_t)14 * MiB}; pg8::GroupedOrder S; moe_panels(cnt, S.pb); S.init(S.pb[NEXP], DFFE / 128, c.G, c.bx);
        pg8::EpiPair<1> E{HB, DFFE}; pg8::gemm_phase<pg8::EpiPair<1>, pg8::GroupedOrder, true, true>(c.lds, g, S, E); } SEAM(PH + 1);
    if (IN(PH + 2)) { pg8::Gemm g{HB, WSP(bf16, W_MOE_D + (size_t)f * 56 * MiB), DFFE, DFFE, (size_t)7 * MiB}; pg8::GroupedOrder S; moe_panels(cnt, S.pb); S.init(S.pb[NEXP], 4, c.G, c.bx);
        pg8::EpiBf16 E{AP, DM, 1.0f}; pg8::gemm_phase<pg8::EpiBf16, pg8::GroupedOrder, true, true>(c.lds, g, S, E); } SEAM(PH + 2);
    if (IN(PH + 3)) { constexpr bool LAST = L == DEPTH - 1;
        phase_ln_moe(WSP(float, WS_X), AP, cnt, WSP(int, MS_TSEL), WSP(float, MS_TWT), a.in[I_LFG] + L * DM, a.in[I_LFB] + L * DM, LAST ? a.out : WSP(float, WS_X), LAST ? (bf16*)nullptr : WSP(bf16, WS_XBF), c.gw, c.NGW, c.lane); }
    SEAM(PH + 3);
}

template <int L, int PH> __device__ __forceinline__ void nsa_mixer(const FArgs& a, const Ctx& c) {
    float* X = WSP(float, WS_X);
    if (IN(PH)) { pg8::Gemm g{WSP(bf16, WS_XBF), WSP(bf16, W_NSA_IN), DM, DM, 0}; pg8::StaticOrder S; S.init(MTOK / 256, 11, c.G, c.bx);
        pg8::EpiNSA E{WSP(bf16, A_Q), WSP(bf16, A_KC), WSP(float, A_GATE)}; pg8::gemm_phase<pg8::EpiNSA, pg8::StaticOrder, true, true>(c.lds, g, S, E); } SEAM(PH);
    if (IN(PH + 1)) phase_compress(WSP(bf16, A_KC), WSP(bf16, A_VCT), WSP(bf16, W_CMP1), a.in[I_NPEK], a.in[I_NPEV], a.in[I_NWK2], a.in[I_NWV2], WSP(bf16, A_KCMP), WSP(bf16, A_VCMPT), c.lds, c.tid, c.wave, c.lane);
    SEAM(PH + 1);
    if (IN(PH + 2)) { AttTensors T{WSP(bf16, A_Q), WSP(bf16, A_KC), WSP(bf16, A_KS), WSP(bf16, A_VST), WSP(bf16, A_KW), WSP(bf16, A_VWT), WSP(bf16, A_KCMP), WSP(bf16, A_VCMPT), WSP(float, A_GATE), WSP(bf16, A_O)};
        phase_nsa_attn(T, c.lds, c.tid, c.wave, c.lane); }
    SEAM(PH + 2);
    if (IN(PH + 3)) { pg8::Gemm g{WSP(bf16, A_O), WSP(bf16, W_NSA_OUT), DM, DM, 0}; pg8::StaticOrder S; S.init(MTOK / 256, 4, c.G, c.bx);
        pg8::EpiResid E{X, X, DM}; pg8::gemm_phase<pg8::EpiResid, pg8::StaticOrder, false, true>(c.lds, g, S, E); } SEAM(PH + 3);
}

__global__ void __launch_bounds__(NTHR, 2) mega(FArgs a) {
    extern __shared__ __attribute__((aligned(16))) unsigned char lds_raw[];
    Ctx c; c.lds = (LAS unsigned char*)lds_raw;
    c.tid = threadIdx.x; c.lane = c.tid & 63; c.wave = __builtin_amdgcn_readfirstlane(c.tid >> 6);
    c.G = gridDim.x; c.bx = blockIdx.x; const int vcu = (c.G % 8 == 0) ? (c.bx % 8) * (c.G / 8) + c.bx / 8 : c.bx;
    c.gw = vcu * NWAVES + c.wave; c.NGW = c.G * NWAVES; c.lo = a.ph_lo; c.hi = a.ph_hi;
    for (int u = c.tid; u < (LDS_BYTES - LDSCTL_OFF) / 4; u += NTHR) ((LAS unsigned*)(c.lds + LDSCTL_OFF))[u] = 0u;
    __syncthreads();
    c.bar = xcd_barrier_post((unsigned*)(a.ws + WS_CTL) + CW_BAR, (volatile LAS unsigned*)(c.lds + LDSCTL_OFF + 32));

    if (IN(PH_PRO)) phase_prologue(a, c.lds, c.gw, c.NGW, c.wave, c.lane);
    SEAM(PH_PRO);
    conformer_mixer<0, PH0_WIN>(a, c); ln_plain<0, PH0_LN1, false>(a, c); dense_ffn<0, PH0_GU>(a, c); ln_plain<0, PH0_LN2, true>(a, c);
#if FAST_PREFIX > 2
    sc_mixer<1, PH1_WIN>(a, c); ln_router<1, PH1_LN1>(a, c); moe_ffn<1, PH1_PERM>(a, c);
#endif
#if FAST_PREFIX > 4
    nsa_mixer<2, PH2_WIN>(a, c); ln_plain<2, PH2_LN1, false>(a, c); dense_ffn<2, PH2_GU>(a, c); ln_plain<2, PH2_LN2, true>(a, c);
#endif
#if FAST_PREFIX > 6
    conformer_mixer<3, PH3_WIN>(a, c); ln_router<3, PH3_LN1>(a, c); moe_ffn<3, PH3_PERM>(a, c);
#endif
}
#undef IN
#undef SEAM
#undef WSP


#ifndef DEBUG_MODE
#define DEBUG_MODE 0
#endif
__global__ void dbg_sqdiff(const float* a, const float* b, size_t n, float* acc2) {
    float d = 0.f, r = 0.f;
    for (size_t i = (size_t)blockIdx.x * blockDim.x + threadIdx.x; i < n; i += (size_t)gridDim.x * blockDim.x) { const float x = a[i], y = b[i]; const float t = x - y; d += (t == t) ? t * t : 1e6f; r += y * y; }
    d = wave_sum(d); r = wave_sum(r);
    if ((threadIdx.x & 63) == 0) { atomicAdd(acc2, d); atomicAdd(acc2 + 1, r); }
}
__global__ void dbg_scale(float* out, size_t n, const float* acc2) {
    float e = sqrtf(acc2[0] / fmaxf(acc2[1], 1e-30f)); e = e < 10.f ? e : 10.f;
    for (size_t i = (size_t)blockIdx.x * blockDim.x + threadIdx.x; i < n; i += (size_t)gridDim.x * blockDim.x) out[i] *= (1.0f + e);
}

static void gemm(hipStream_t st, const float* A, int lda, const int* gather, const int* mcount, int M, const float* W, int ldw, int N, int K, float* C, int ldc) {
    hipLaunchKernelGGL(ngemm, dim3((N + 127) / 128, (M + 127) / 128), dim3(256), 0, st, A, lda, gather, mcount, M, W, ldw, N, K, C, ldc);
}
struct NaiveBufs { float *BA, *BB, *BC, *BD; int *cnt, *list, *tsel; float *twt, *cmp; };
static void naive_sublayer(hipStream_t stream, const float* const* in, int s, const float* x, float* xo, const NaiveBufs& nb) {
    const int i = s / 2, kind = i % 3, j = i / 3, f = i / 2, EW = 256;
    constexpr int CR = MTOK / 2, CB = BATCH / 2;
    float *BA = nb.BA, *BB = nb.BB, *BC = nb.BC, *BD = nb.BD;
    for (int c = 0; c < 2; ++c) {
        const float* xc = x + (size_t)c * CR * DM; float* xoc = xo + (size_t)c * CR * DM;
        if ((s & 1) == 0) {
            if (kind == 0) {
                gemm(stream, xc, DM, nullptr, nullptr, CR, in[I_CWIN] + (size_t)j * DM * 2 * DM, 2 * DM, 2 * DM, DM, BA, 2 * DM);
                hipLaunchKernelGGL(n_glu, dim3(CR * DM / EW), dim3(EW), 0, stream, BA, BB, CR);
                hipLaunchKernelGGL(n_conf_dw, dim3(CR), dim3(256), 0, stream, BB, in[I_CWDW] + (size_t)j * CONV_K * DM, in[I_CBDW] + j * DM, in[I_CLNG] + j * DM, in[I_CLNB] + j * DM, BD);
                gemm(stream, BD, DM, nullptr, nullptr, CR, in[I_CWOUT] + (size_t)j * DM * DM, DM, DM, DM, BC, DM);
            } else if (kind == 1) {
                gemm(stream, xc, DM, nullptr, nullptr, CR, in[I_SWIN] + (size_t)j * DM * 3 * DM, 3 * DM, 3 * DM, DM, BA, 3 * DM);
                hipLaunchKernelGGL(n_shortconv, dim3(CR * DM / EW), dim3(EW), 0, stream, BA, in[I_SWCONV] + (size_t)j * SHORT_K * DM, BD, CR);
                gemm(stream, BD, DM, nullptr, nullptr, CR, in[I_SWOUT] + (size_t)j * DM * DM, DM, DM, DM, BC, DM);
            } else {
                gemm(stream, xc, DM, nullptr, nullptr, CR, in[I_NWIN] + (size_t)j * DM * NSA_COLS, NSA_COLS, NSA_COLS, DM, BA, NSA_COLS);
                hipLaunchKernelGGL(n_compress, dim3(NCMP, CB * NKV, 2), dim3(128), 0, stream, BA, in[I_NPEK] + j * CMP_BLOCK * HD, in[I_NPEV] + j * CMP_BLOCK * HD,
                                   in[I_NWK1] + (size_t)j * CMP_BLOCK * HD * PHI, in[I_NWK2] + j * PHI * HD, in[I_NWV1] + (size_t)j * CMP_BLOCK * HD * PHI, in[I_NWV2] + j * PHI * HD, nb.cmp);
                hipLaunchKernelGGL(n_nsa_attn, dim3(SEQ / 64, CB * NKV), dim3(256), 0, stream, BA, nb.cmp, BD);
                gemm(stream, BD, DM, nullptr, nullptr, CR, in[I_NWOUT] + (size_t)j * DM * DM, DM, DM, DM, BC, DM);
            }
            hipLaunchKernelGGL(n_ln_res, dim3(CR), dim3(256), 0, stream, xc, BC, in[I_LMG] + i * DM, in[I_LMB] + i * DM, xoc);
        } else {
            if (i % 2 == 0) {
                gemm(stream, xc, DM, nullptr, nullptr, CR, in[I_FWG] + (size_t)f * DM * DFF, DFF, DFF, DM, BA, DFF);
                gemm(stream, xc, DM, nullptr, nullptr, CR, in[I_FWU] + (size_t)f * DM * DFF, DFF, DFF, DM, BB, DFF);
                hipLaunchKernelGGL(n_swiglu, dim3((unsigned)(((size_t)CR * DFF + EW - 1) / EW)), dim3(EW), 0, stream, BA, BB, BA, (const int*)nullptr, CR, DFF);
                gemm(stream, BA, DFF, nullptr, nullptr, CR, in[I_FWD] + (size_t)f * DFF * DM, DM, DM, DFF, BC, DM);
            } else {
                (void)hipMemsetAsync(nb.cnt, 0, 256, stream);
                (void)hipMemsetAsync(BC, 0, (size_t)CR * DM * 4, stream);
                hipLaunchKernelGGL(n_router, dim3(CR / 4), dim3(256), 0, stream, xc, in[I_MWR] + (size_t)f * DM * NEXP, nb.cnt, nb.list, nb.tsel, nb.twt);
                for (int e = 0; e < NEXP; ++e) {
                    const size_t wo = ((size_t)f * NEXP + e) * DM * DFFE;
                    gemm(stream, xc, DM, nb.list + e * MOE_CAP, nb.cnt + e, MOE_CAP, in[I_MWG] + wo, DFFE, DFFE, DM, BA, DFFE);
                    gemm(stream, xc, DM, nb.list + e * MOE_CAP, nb.cnt + e, MOE_CAP, in[I_MWU] + wo, DFFE, DFFE, DM, BB, DFFE);
                    hipLaunchKernelGGL(n_swiglu, dim3((unsigned)(((size_t)MOE_CAP * DFFE + EW - 1) / EW)), dim3(EW), 0, stream, BA, BB, BA, (const int*)(nb.cnt + e), MOE_CAP, DFFE);
                    gemm(stream, BA, DFFE, nullptr, nb.cnt + e, MOE_CAP, in[I_MWD] + wo, DM, DM, DFFE, BD, DM);
                    hipLaunchKernelGGL(n_moe_scatter, dim3(MOE_CAP), dim3(256), 0, stream, BD, nb.cnt, nb.list, nb.tsel, nb.twt, e, BC);
                }
            }
            hipLaunchKernelGGL(n_ln_res, dim3(CR), dim3(256), 0, stream, xc, BC, in[I_LFG] + i * DM, in[I_LFB] + i * DM, xoc);
        }
    }
}

extern "C" void kernel_launch(void* const* d_in, const int* in_sizes, int n_in, void* d_out, int out_size, void* d_ws, size_t ws_size, hipStream_t stream) {
    (void)in_sizes; (void)out_size;
    static int grid = 0;
    if (grid == 0) {
        if (n_in != 29 || ws_size < WS_END) { fprintf(stderr, "kernel_launch: unexpected n_in %d / ws_size %zu (need %zu)\n", n_in, ws_size, (size_t)WS_END); grid = -1; return; }
        int dev = 0, cus = 0, per_cu = 0;
        if (hipGetDevice(&dev) != hipSuccess || hipDeviceGetAttribute(&cus, hipDeviceAttributeMultiprocessorCount, dev) != hipSuccess) { grid = -1; return; }
        if (hipFuncSetAttribute((const void*)mega, hipFuncAttributeMaxDynamicSharedMemorySize, LDS_BYTES) != hipSuccess) { fprintf(stderr, "kernel_launch: hipFuncSetAttribute failed\n"); grid = -1; return; }
        if (hipOccupancyMaxActiveBlocksPerMultiprocessor(&per_cu, (const void*)mega, NTHR, LDS_BYTES) != hipSuccess || per_cu < 1) { fprintf(stderr, "kernel_launch: occupancy query says %d\n", per_cu); }
        (void)hipGetLastError();
        grid = cus;
    }
    if (grid < 0) return;
    unsigned char* ws = (unsigned char*)d_ws;
    const float* in[29]; for (int i = 0; i < 29; ++i) in[i] = (const float*)d_in[i];
    auto run_fast = [&]() {
        (void)hipMemsetAsync(ws + WS_CTL, 0, CTL_ZERO_BYTES, stream);
        FArgs a{}; for (int i = 0; i < 29; ++i) a.in[i] = in[i];
        a.out = (float*)d_out; a.ws = ws;
        if (ONE_LAUNCH) { a.ph_lo = 0; a.ph_hi = FAST_END; hipLaunchKernelGGL(mega, dim3(grid), dim3(NTHR), LDS_BYTES, stream, a); }
        else for (int p = 0; p < FAST_END; ++p) { a.ph_lo = p; a.ph_hi = p + 1; hipLaunchKernelGGL(mega, dim3(grid), dim3(NTHR), LDS_BYTES, stream, a); }
    };
    NaiveBufs nb; unsigned char* nbase = ws + WS_ACT;
    nb.BA = (float*)nbase; nb.BB = (float*)(nbase + 96 * MiB); nb.BC = (float*)(nbase + 192 * MiB); nb.BD = (float*)(nbase + 224 * MiB);
    unsigned char* sm = nbase + 256 * MiB; nb.cnt = (int*)sm; nb.list = nb.cnt + 64; nb.tsel = nb.list + NEXP * MOE_CAP; nb.twt = (float*)(nb.tsel + (MTOK / 2) * 4); nb.cmp = (float*)(sm + 2 * MiB);
    float* X = (float*)(ws + WS_X);
#if DEBUG_MODE
    static_assert(FAST_PREFIX >= 1 && FAST_PREFIX <= 6 && !ONE_LAUNCH, "debug builds compare a fast prefix that leaves its result in X");
    float* XF1 = (float*)(ws + W_MOE_GU + 112 * MiB);
    float* acc2 = (float*)(sm + 1 * MiB);
    run_fast();
    (void)hipMemcpyAsync(XF1, X, (size_t)MTOK * DM * 4, hipMemcpyDeviceToDevice, stream);
    (void)hipMemsetAsync(acc2, 0, 64, stream);
    if (DEBUG_MODE == 2) { run_fast(); hipLaunchKernelGGL(dbg_sqdiff, dim3(2048), dim3(256), 0, stream, (const float*)X, (const float*)XF1, (size_t)MTOK * DM, acc2); }
    { const float* x = in[I_X];
      for (int s = 0; s < 8; ++s) { float* xo = (s == 7) ? (float*)d_out : X; naive_sublayer(stream, in, s, x, xo, nb); x = xo;
          if (DEBUG_MODE == 1 && s == FAST_PREFIX - 1) hipLaunchKernelGGL(dbg_sqdiff, dim3(2048), dim3(256), 0, stream, (const float*)XF1, (const float*)X, (size_t)MTOK * DM, acc2); } }
    hipLaunchKernelGGL(dbg_scale, dim3(2048), dim3(256), 0, stream, (float*)d_out, (size_t)MTOK * DM, (const float*)acc2);
#else
    if (FAST_END > 0) run_fast();
    if (FAST_PREFIX < 8) {
        const float* x = FAST_PREFIX == 0 ? in[I_X] : (const float*)X;
        for (int s = FAST_PREFIX; s < 8; ++s) { float* xo = (s == 7) ? (float*)d_out : X; naive_sublayer(stream, in, s, x, xo, nb); x = xo; }
    }
#endif
}
```

```cpp
#define FAST_PREFIX 8
#define ONE_LAUNCH 1
#include <hip/hip_runtime.h>
#include <cstdio>
#include <cstdint>

constexpr int BATCH = 8, SEQ = 2048, DM = 1024, MTOK = BATCH * SEQ, DEPTH = 4;
constexpr int CONV_K = 31, SHORT_K = 3;
constexpr int NH = 16, NKV = 4, NG = 4, HD = 64;
constexpr int CMP_BLOCK = 32, CMP_STRIDE = 16, NCMP = (SEQ - CMP_BLOCK) / CMP_STRIDE + 1;
constexpr int SLC_BLOCK = 64, NSLC = SEQ / SLC_BLOCK, TOPN = 16, WINDOW = 512, PHI = 128;
constexpr int NSA_COLS = NH * HD + 6 * NKV * HD + 3 * NH;
constexpr int DFF = 2816, NEXP = 8, DFFE = 3584;
constexpr float LN_EPS = 1e-5f;
#define ALPHA_F 1.681792830507429f

typedef float f32x16 __attribute__((ext_vector_type(16)));

__device__ __forceinline__ float wave_sum(float v) {
#pragma unroll
    for (int o = 1; o < 64; o <<= 1) v += __shfl_xor(v, o);
    return v;
}
__device__ __forceinline__ float block_sum256(float v, float* red) {
    v = wave_sum(v);
    __syncthreads();
    if ((threadIdx.x & 63) == 0) red[threadIdx.x >> 6] = v;
    __syncthreads();
    return (red[0] + red[1]) + (red[2] + red[3]);
}
__device__ __forceinline__ float sigmoidf_(float x) { return 1.0f / (1.0f + expf(-x)); }
__device__ __forceinline__ float siluf_(float x) { return x / (1.0f + expf(-x)); }
__device__ __forceinline__ float gelu_tanh(float x) { return 0.5f * x * (1.0f + tanhf(0.7978845608028654f * (x + 0.044715f * x * x * x))); }

__global__ __launch_bounds__(256) void ngemm(const float* __restrict__ A, int lda, const int* __restrict__ gather, const int* __restrict__ mcount, int M,
                                             const float* __restrict__ W, int ldw, int N, int K, float* __restrict__ C, int ldc) {
    __shared__ float As[128][17];
    __shared__ float Bs[16][132];
    if (mcount) { const int mc = *mcount; M = mc < M ? mc : M; }
    const int bm = blockIdx.y * 128, bn = blockIdx.x * 128;
    if (bm >= M) return;
    const int tid = threadIdx.x, lane = tid & 63, w = tid >> 6, wr = w >> 1, wc = w & 1;
    const int ar = tid >> 1, ak = (tid & 1) * 8;
    const int arow = bm + ar; const bool aok = arow < M;
    const int asrc = aok ? (gather ? gather[arow] : arow) : 0;
    const float* ap = A + (size_t)asrc * lda + ak;
    const int bk = tid >> 4, bc = (tid & 15) * 8;
    const bool bok = (bn + bc + 8) <= N;
    const float* bp = W + (size_t)bk * ldw + bn + bc;
    f32x16 acc[2][2];
#pragma unroll
    for (int i = 0; i < 2; ++i)
#pragma unroll
        for (int j = 0; j < 2; ++j)
#pragma unroll
            for (int r = 0; r < 16; ++r) acc[i][j][r] = 0.f;
    for (int k0 = 0; k0 < K; k0 += 16) {
        float4 a0 = make_float4(0.f, 0.f, 0.f, 0.f), a1 = a0, b0 = a0, b1 = a0;
        if (aok) { a0 = *(const float4*)(ap + k0); a1 = *(const float4*)(ap + k0 + 4); }
        if (bok) { b0 = *(const float4*)(bp + (size_t)k0 * ldw); b1 = *(const float4*)(bp + (size_t)k0 * ldw + 4); }
        __syncthreads();
        As[ar][ak + 0] = a0.x; As[ar][ak + 1] = a0.y; As[ar][ak + 2] = a0.z; As[ar][ak + 3] = a0.w;
        As[ar][ak + 4] = a1.x; As[ar][ak + 5] = a1.y; As[ar][ak + 6] = a1.z; As[ar][ak + 7] = a1.w;
        *(float4*)&Bs[bk][bc] = b0; *(float4*)&Bs[bk][bc + 4] = b1;
        __syncthreads();
#pragma unroll
        for (int kk = 0; kk < 16; kk += 2) {
            float a[2], b[2];
#pragma unroll
            for (int i = 0; i < 2; ++i) a[i] = As[wr * 64 + i * 32 + (lane & 31)][kk + (lane >> 5)];
#pragma unroll
            for (int j = 0; j < 2; ++j) b[j] = Bs[kk + (lane >> 5)][wc * 64 + j * 32 + (lane & 31)];
#pragma unroll
            for (int i = 0; i < 2; ++i)
#pragma unroll
                for (int j = 0; j < 2; ++j) acc[i][j] = __builtin_amdgcn_mfma_f32_32x32x2f32(a[i], b[j], acc[i][j], 0, 0, 0);
        }
    }
#pragma unroll
    for (int i = 0; i < 2; ++i)
#pragma unroll
        for (int j = 0; j < 2; ++j)
#pragma unroll
            for (int r = 0; r < 16; ++r) {
                const int row = bm + wr * 64 + i * 32 + (r & 3) + 8 * (r >> 2) + 4 * (lane >> 5);
                const int col = bn + wc * 64 + j * 32 + (lane & 31);
                if (row < M && col < N) C[(size_t)row * ldc + col] = acc[i][j][r];
            }
}

__global__ void n_glu(const float* __restrict__ t, float* __restrict__ u, int rows) {
    const size_t i = (size_t)blockIdx.x * blockDim.x + threadIdx.x; if (i >= (size_t)rows * DM) return;
    const size_t m = i / DM; const int c = (int)(i % DM);
    u[i] = t[m * 2 * DM + c] * sigmoidf_(t[m * 2 * DM + DM + c]);
}
__global__ __launch_bounds__(256) void n_conf_dw(const float* __restrict__ u, const float* __restrict__ wdw, const float* __restrict__ bdw, const float* __restrict__ g, const float* __restrict__ bb, float* __restrict__ out) {
    __shared__ float red[8];
    const int m = blockIdx.x, t = m % SEQ, c = threadIdx.x * 4;
    float4 acc = *(const float4*)(bdw + c);
    for (int k = 0; k < CONV_K; ++k) { const int tt = t - (CONV_K - 1) + k; if (tt < 0) continue;
        const float4 w = *(const float4*)(wdw + k * DM + c), x = *(const float4*)(u + (size_t)(m - t + tt) * DM + c);
        acc.x += w.x * x.x; acc.y += w.y * x.y; acc.z += w.z * x.z; acc.w += w.w * x.w; }
    const float mean = block_sum256((acc.x + acc.y) + (acc.z + acc.w), red) * (1.0f / DM);
    const float dx = acc.x - mean, dy = acc.y - mean, dz = acc.z - mean, dw = acc.w - mean;
    const float var = block_sum256((dx * dx + dy * dy) + (dz * dz + dw * dw), red) * (1.0f / DM);
    const float rstd = 1.0f / sqrtf(var + LN_EPS);
    const float4 gg = *(const float4*)(g + c), b4 = *(const float4*)(bb + c);
    float4 o; o.x = siluf_(dx * rstd * gg.x + b4.x); o.y = siluf_(dy * rstd * gg.y + b4.y); o.z = siluf_(dz * rstd * gg.z + b4.z); o.w = siluf_(dw * rstd * gg.w + b4.w);
    *(float4*)(out + (size_t)m * DM + c) = o;
}
__global__ __launch_bounds__(256) void n_ln_res(const float* __restrict__ x, const float* __restrict__ mix, const float* __restrict__ g, const float* __restrict__ bb, float* __restrict__ xo) {
    __shared__ float red[8];
    const int m = blockIdx.x, c = threadIdx.x * 4;
    const float4 xv = *(const float4*)(x + (size_t)m * DM + c), mv = *(const float4*)(mix + (size_t)m * DM + c);
    float4 v; v.x = ALPHA_F * xv.x + mv.x; v.y = ALPHA_F * xv.y + mv.y; v.z = ALPHA_F * xv.z + mv.z; v.w = ALPHA_F * xv.w + mv.w;
    const float mean = block_sum256((v.x + v.y) + (v.z + v.w), red) * (1.0f / DM);
    const float dx = v.x - mean, dy = v.y - mean, dz = v.z - mean, dw = v.w - mean;
    const float var = block_sum256((dx * dx + dy * dy) + (dz * dz + dw * dw), red) * (1.0f / DM);
    const float rstd = 1.0f / sqrtf(var + LN_EPS);
    const float4 gg = *(const float4*)(g + c), b4 = *(const float4*)(bb + c);
    float4 o; o.x = dx * rstd * gg.x + b4.x; o.y = dy * rstd * gg.y + b4.y; o.z = dz * rstd * gg.z + b4.z; o.w = dw * rstd * gg.w + b4.w;
    *(float4*)(xo + (size_t)m * DM + c) = o;
}
__global__ void n_swiglu(const float* __restrict__ g, const float* __restrict__ u, float* __restrict__ h, const int* __restrict__ mcount, int rows, int n) {
    if (mcount) { const int mc = *mcount; rows = mc < rows ? mc : rows; }
    const size_t i = (size_t)blockIdx.x * blockDim.x + threadIdx.x; if (i >= (size_t)rows * n) return;
    h[i] = siluf_(g[i]) * u[i];
}
__global__ void n_shortconv(const float* __restrict__ t, const float* __restrict__ w, float* __restrict__ y, int rows) {
    const size_t i = (size_t)blockIdx.x * blockDim.x + threadIdx.x; if (i >= (size_t)rows * DM) return;
    const int m = (int)(i / DM), c = (int)(i % DM), tt = m % SEQ;
    float acc = 0.f;
    for (int k = 0; k < SHORT_K; ++k) { const int ts = tt - (SHORT_K - 1) + k; if (ts < 0) continue;
        const float* r = t + (size_t)(m - tt + ts) * 3 * DM; acc += w[k * DM + c] * (r[DM + c] * r[2 * DM + c]); }
    y[i] = t[(size_t)m * 3 * DM + c] * acc;
}

__global__ __launch_bounds__(128) void n_compress(const float* __restrict__ T, const float* __restrict__ pek, const float* __restrict__ pev, const float* __restrict__ wk1, const float* __restrict__ wk2,
                                                  const float* __restrict__ wv1, const float* __restrict__ wv2, float* __restrict__ cmp) {
    __shared__ float in[CMP_BLOCK * HD]; __shared__ float hid[PHI];
    const int c = blockIdx.x, bh = blockIdx.y, kv = blockIdx.z, b = bh / NKV, hk = bh % NKV, tid = threadIdx.x;
    const float* pe = kv ? pev : pek; const float* w1 = kv ? wv1 : wk1; const float* w2 = kv ? wv2 : wk2;
    const int col0 = NH * HD + kv * NKV * HD + hk * HD;
    for (int i = tid; i < CMP_BLOCK * HD; i += 128) { const int j = i / HD, d = i % HD; in[i] = T[(size_t)(b * SEQ + c * CMP_STRIDE + j) * NSA_COLS + col0 + d] + pe[i]; }
    __syncthreads();
    float a = 0.f;
    for (int i = 0; i < CMP_BLOCK * HD; ++i) a += in[i] * w1[(size_t)i * PHI + tid];
    hid[tid] = gelu_tanh(a);
    __syncthreads();
    if (tid < HD) { float o = 0.f; for (int j = 0; j < PHI; ++j) o += hid[j] * w2[j * HD + tid]; cmp[((size_t)(kv * gridDim.y + bh) * 128 + c) * HD + tid] = o; }
}

#define NATT_TILE 32
__device__ __forceinline__ void natt_load_tile(float (*Kt)[HD], float (*Vt)[HD], const float* kp, const float* vp, size_t stride, int nrows) {
    __syncthreads();
    for (int i = threadIdx.x; i < NATT_TILE * HD / 4; i += 256) { const int r = i / (HD / 4), d4 = (i % (HD / 4)) * 4;
        float4 kx = make_float4(0.f, 0.f, 0.f, 0.f), vx = kx;
        if (r < nrows) { kx = *(const float4*)(kp + (size_t)r * stride + d4); vx = *(const float4*)(vp + (size_t)r * stride + d4); }
        *(float4*)&Kt[r][d4] = kx; *(float4*)&Vt[r][d4] = vx; }
    __syncthreads();
}
__global__ __launch_bounds__(256) void n_nsa_attn(const float* __restrict__ T, const float* __restrict__ cmp, float* __restrict__ O) {
    __shared__ float Kt[NATT_TILE][HD]; __shared__ float Vt[NATT_TILE][HD];
    __shared__ float impS[64][NG][NSLC]; __shared__ float scS[64][NSLC + 1];
    const int qi = blockIdx.x, bh = blockIdx.y, b = bh / NKV, hk = bh % NKV, tid = threadIdx.x, g = tid >> 6, tl = tid & 63, t = qi * 64 + tl;
    const size_t mrow = (size_t)b * SEQ + t; const int hcol = (hk * NG + g) * HD;
    float q[HD];
#pragma unroll
    for (int d = 0; d < HD; ++d) q[d] = T[mrow * NSA_COLS + hcol + d] * 0.125f;
    const float* gp = T + mrow * NSA_COLS + (NH * HD + 6 * NKV * HD) + hk * 12 + g * 3;
    const float g0 = sigmoidf_(gp[0]), g1 = sigmoidf_(gp[1]), g2 = sigmoidf_(gp[2]);
    float acc[HD]; float mx, l;
#define NATT_RESET() do { mx = -1e30f; l = 0.f; _Pragma("unroll") for (int d = 0; d < HD; ++d) acc[d] = 0.f; } while (0)
#define NATT_DOT(s, kk) do { s = 0.f; _Pragma("unroll") for (int d = 0; d < HD; d += 4) { const float4 kx = *(const float4*)&Kt[kk][d]; s += q[d] * kx.x + q[d + 1] * kx.y + q[d + 2] * kx.z + q[d + 3] * kx.w; } } while (0)
#define NATT_UPD(s, kk) do { const float mn = fmaxf(mx, s), sc = expf(mx - mn), p = expf(s - mn); l = l * sc + p; mx = mn; \
        _Pragma("unroll") for (int d = 0; d < HD; d += 4) { const float4 vx = *(const float4*)&Vt[kk][d]; acc[d] = acc[d] * sc + p * vx.x; acc[d + 1] = acc[d + 1] * sc + p * vx.y; acc[d + 2] = acc[d + 2] * sc + p * vx.z; acc[d + 3] = acc[d + 3] * sc + p * vx.w; } } while (0)
    float* op = O + mrow * DM + hcol;
    const float* kc = cmp + (size_t)bh * 128 * HD; const float* vc = cmp + (size_t)(gridDim.y + bh) * 128 * HD;
    NATT_RESET();
    for (int c0 = 0; c0 < NCMP; c0 += NATT_TILE) {
        natt_load_tile(Kt, Vt, kc + (size_t)c0 * HD, vc + (size_t)c0 * HD, HD, NCMP - c0 < NATT_TILE ? NCMP - c0 : NATT_TILE);
        for (int kk = 0; kk < NATT_TILE; ++kk) { const int c = c0 + kk; if (c < NCMP && c * CMP_STRIDE + CMP_BLOCK - 1 <= t) { float s; NATT_DOT(s, kk); NATT_UPD(s, kk); } }
    }
    { const float inv = g0 / fmaxf(l, 1e-30f);
#pragma unroll
      for (int d = 0; d < HD; d += 4) *(float4*)(op + d) = make_float4(acc[d] * inv, acc[d + 1] * inv, acc[d + 2] * inv, acc[d + 3] * inv); }
    { const float invl = 1.0f / fmaxf(l, 1e-30f); float cur = 0.f, nxt = 0.f;
      for (int c0 = 0; c0 < 128; c0 += NATT_TILE) {
        natt_load_tile(Kt, Vt, kc + (size_t)c0 * HD, vc + (size_t)c0 * HD, HD, NCMP - c0 < NATT_TILE ? NCMP - c0 : NATT_TILE);
        for (int kk = 0; kk < NATT_TILE; ++kk) { const int c = c0 + kk; float p = 0.f;
            if (c < NCMP && c * CMP_STRIDE + CMP_BLOCK - 1 <= t) { float s; NATT_DOT(s, kk); p = expf(s - mx) * invl; }
            cur += p; if ((c & 3) == 3) { nxt = p; impS[tl][g][c >> 2] = cur; cur = nxt; } }
      } }
    __syncthreads();
    if (g == 0) { for (int n = 0; n < NSLC; ++n) { const float imp = (impS[tl][0][n] + impS[tl][1][n]) + (impS[tl][2][n] + impS[tl][3][n]);
        const bool forced = (n == 0) || (n == qi) || (n == qi - 1); const bool valid = n <= qi;
        scS[tl][n] = forced ? 1e4f : (valid ? imp : -1e30f); } }
    __syncthreads();
    unsigned selmask = 0u;
    for (int n = 0; n < NSLC; ++n) { const float sn = scS[tl][n]; int rank = 0;
        for (int m2 = 0; m2 < NSLC; ++m2) { const float sm = scS[tl][m2]; rank += (sm > sn || (sm == sn && m2 < n)) ? 1 : 0; }
        if (rank < TOPN) selmask |= (1u << n); }
    NATT_RESET();
    for (int j = 0; j <= qi; ++j)
        for (int hf = 0; hf < 2; ++hf) { const int p0 = j * 64 + hf * 32;
            const float* kp = T + ((size_t)b * SEQ + p0) * NSA_COLS + (NH * HD + 2 * NKV * HD) + hk * HD; const float* vp = kp + NKV * HD;
            natt_load_tile(Kt, Vt, kp, vp, NSA_COLS, NATT_TILE);
            if ((selmask >> j) & 1u) for (int kk = 0; kk < NATT_TILE; ++kk) if (p0 + kk <= t) { float s; NATT_DOT(s, kk); NATT_UPD(s, kk); } }
    { const float inv = g1 / fmaxf(l, 1e-30f);
#pragma unroll
      for (int d = 0; d < HD; d += 4) { float4 o = *(float4*)(op + d); o.x += acc[d] * inv; o.y += acc[d + 1] * inv; o.z += acc[d + 2] * inv; o.w += acc[d + 3] * inv; *(float4*)(op + d) = o; } }
    NATT_RESET();
    for (int j = (qi >= 8 ? qi - 8 : 0); j <= qi; ++j)
        for (int hf = 0; hf < 2; ++hf) { const int p0 = j * 64 + hf * 32;
            const float* kp = T + ((size_t)b * SEQ + p0) * NSA_COLS + (NH * HD + 4 * NKV * HD) + hk * HD; const float* vp = kp + NKV * HD;
            natt_load_tile(Kt, Vt, kp, vp, NSA_COLS, NATT_TILE);
            for (int kk = 0; kk < NATT_TILE; ++kk) { const int df = t - (p0 + kk); if (df >= 0 && df < WINDOW) { float s; NATT_DOT(s, kk); NATT_UPD(s, kk); } } }
    { const float inv = g2 / fmaxf(l, 1e-30f);
#pragma unroll
      for (int d = 0; d < HD; d += 4) { float4 o = *(float4*)(op + d); o.x += acc[d] * inv; o.y += acc[d + 1] * inv; o.z += acc[d + 2] * inv; o.w += acc[d + 3] * inv; *(float4*)(op + d) = o; } }
#undef NATT_RESET
#undef NATT_DOT
#undef NATT_UPD
}

constexpr int MOE_CAP = 6144;
__global__ __launch_bounds__(256) void n_router(const float* __restrict__ x, const float* __restrict__ wr, int* __restrict__ cnt, int* __restrict__ list, int* __restrict__ tsel, float* __restrict__ twt) {
    const int m = blockIdx.x * 4 + (threadIdx.x >> 6), lane = threadIdx.x & 63;
    float lg[NEXP];
#pragma unroll
    for (int e = 0; e < NEXP; ++e) lg[e] = 0.f;
    for (int k = lane; k < DM; k += 64) { const float xv = x[(size_t)m * DM + k];
#pragma unroll
        for (int e = 0; e < NEXP; ++e) lg[e] += xv * wr[k * NEXP + e]; }
#pragma unroll
    for (int e = 0; e < NEXP; ++e) lg[e] = wave_sum(lg[e]);
    if (lane == 0) {
        int e1 = 0; float v1 = lg[0];
#pragma unroll
        for (int e = 1; e < NEXP; ++e) if (lg[e] > v1) { v1 = lg[e]; e1 = e; }
        int e2 = -1; float v2 = -3.4e38f;
#pragma unroll
        for (int e = 0; e < NEXP; ++e) if (e != e1 && lg[e] > v2) { v2 = lg[e]; e2 = e; }
        const float p2 = expf(v2 - v1), w1 = 1.0f / (1.0f + p2), w2 = p2 / (1.0f + p2);
        const int s1 = atomicAdd(cnt + e1, 1), s2 = atomicAdd(cnt + e2, 1);
        if (s1 < MOE_CAP) list[e1 * MOE_CAP + s1] = m;
        if (s2 < MOE_CAP) list[e2 * MOE_CAP + s2] = m;
        tsel[m * 4 + 0] = e1; tsel[m * 4 + 1] = s1; tsel[m * 4 + 2] = e2; tsel[m * 4 + 3] = s2; twt[m * 2] = w1; twt[m * 2 + 1] = w2;
    }
}
__global__ __launch_bounds__(256) void n_moe_scatter(const float* __restrict__ Y, const int* __restrict__ cnt, const int* __restrict__ list, const int* __restrict__ tsel, const float* __restrict__ twt, int e, float* __restrict__ F) {
    const int slot = blockIdx.x; int c = cnt[e]; c = c < MOE_CAP ? c : MOE_CAP; if (slot >= c) return;
    const int m = list[e * MOE_CAP + slot]; const float w = (tsel[m * 4] == e) ? twt[m * 2] : twt[m * 2 + 1];
    const int col = threadIdx.x * 4; const float4 y = *(const float4*)(Y + (size_t)slot * DM + col); float4 f = *(float4*)(F + (size_t)m * DM + col);
    f.x += w * y.x; f.y += w * y.y; f.z += w * y.z; f.w += w * y.w; *(float4*)(F + (size_t)m * DM + col) = f;
}


enum { I_X = 0, I_LMG, I_LMB, I_LFG, I_LFB, I_CWIN, I_CWDW, I_CBDW, I_CLNG, I_CLNB, I_CWOUT, I_SWIN, I_SWCONV, I_SWOUT, I_NWIN, I_NPEK, I_NPEV, I_NWK1, I_NWK2, I_NWV1, I_NWV2, I_NWOUT,
       I_FWG, I_FWU, I_FWD, I_MWR, I_MWG, I_MWU, I_MWD };

#define GAS __attribute__((address_space(1)))
#define LAS __attribute__((address_space(3)))
typedef unsigned short bf16;
typedef unsigned v4u __attribute__((ext_vector_type(4)));
typedef unsigned v2u __attribute__((ext_vector_type(2)));
typedef float f32x4 __attribute__((ext_vector_type(4)));
typedef float f32x2 __attribute__((ext_vector_type(2)));
typedef short bf16x8 __attribute__((ext_vector_type(8)));
typedef short s16x4 __attribute__((ext_vector_type(4)));
typedef GAS unsigned gu32;
#define RLX_AGENT __ATOMIC_RELAXED, __HIP_MEMORY_SCOPE_AGENT
#define LDS_WAIT() asm volatile("s_waitcnt lgkmcnt(0)" ::: "memory")
#define VM_WAIT() asm volatile("s_waitcnt vmcnt(0)" ::: "memory")
constexpr int NWAVES = 8, NTHR = NWAVES * 64;
__device__ __forceinline__ unsigned f2bf(float f) { unsigned u = __builtin_bit_cast(unsigned, f); return (u + 0x7fffu + ((u >> 16) & 1u)) >> 16; }
__device__ __forceinline__ unsigned pk2(float lo, float hi) { return f2bf(lo) | (f2bf(hi) << 16); }
typedef __bf16 bf16x2_t __attribute__((ext_vector_type(2)));
__device__ __forceinline__ unsigned cvt_pk_bf16(float lo, float hi) { f32x2 v = {lo, hi}; bf16x2_t b = __builtin_convertvector(v, bf16x2_t); return __builtin_bit_cast(unsigned, b); }
__device__ __forceinline__ float bf_lo(unsigned u) { return __builtin_bit_cast(float, u << 16); }
__device__ __forceinline__ float bf_hi(unsigned u) { return __builtin_bit_cast(float, u & 0xffff0000u); }
__device__ __forceinline__ float fast_sigmoid(float x) { return __builtin_amdgcn_rcpf(1.0f + __builtin_amdgcn_exp2f(-1.4426950408889634f * x)); }
__device__ __forceinline__ float fast_silu(float x) { return x * fast_sigmoid(x); }

#define XB_TMO      128
#define XB_XCNT(j)  (256  + 64 * (j))
#define XB_XSUB(j)  (1280 + 64 * (j))
#define XB_XGEN(j)  (2304 + 64 * (j))
#define XB_TOP      3328
#define XB_TOPGEN   3392
#define XCD_BAR_WORDS 3456
#define XB_SPIN_CAP (1u << 18)
__device__ __forceinline__ unsigned xb_ld(unsigned* p)              { return __hip_atomic_load(p, __ATOMIC_RELAXED, __HIP_MEMORY_SCOPE_AGENT); }
__device__ __forceinline__ unsigned xb_add(unsigned* p, unsigned v) { return __hip_atomic_fetch_add(p, v, __ATOMIC_RELAXED, __HIP_MEMORY_SCOPE_AGENT); }
__device__ __forceinline__ unsigned xb_xcc_id() { return (unsigned)__builtin_amdgcn_s_getreg((3 << 11) | 20) & 0xFu; }
#define XB_SPIN(cond, bar) do { unsigned _sp = 0; while (cond) { __builtin_amdgcn_s_sleep(1); \
    if ((++_sp & 255u) == 0u) { if (xb_ld(&(bar)[XB_TMO])) break; if (_sp > XB_SPIN_CAP) { atomicAdd(&(bar)[XB_TMO], 1u); break; } } } } while (0)
struct XcdBarrier { unsigned* bar; unsigned x; volatile LAS unsigned* st; };
__device__ __forceinline__ XcdBarrier xcd_barrier_post(unsigned* bar, volatile LAS unsigned* st) {
    XcdBarrier b; b.bar = bar; b.x = xb_xcc_id(); b.st = st;
    if (threadIdx.x == 0) (void)xb_add(&bar[XB_XCNT(b.x)], 1u);
    return b;
}
__device__ __forceinline__ void xcd_barrier_complete(unsigned* bar, unsigned x, unsigned& nloc, unsigned& nx) {
    const unsigned G = gridDim.x * gridDim.y * gridDim.z;
    unsigned sum, cnt, mine, sp = 0u;
    for (;;) {
        sum = 0u; cnt = 0u; mine = 0u;
#pragma unroll
        for (unsigned j = 0; j < 16; ++j) { const unsigned c = xb_ld(&bar[XB_XCNT(j)]); sum += c; cnt += (c > 0u) ? 1u : 0u; mine = (j == x) ? c : mine; }
        if (sum == G) break;
        __builtin_amdgcn_s_sleep(1);
        if ((++sp & 255u) == 0u) { if (xb_ld(&bar[XB_TMO])) break; if (sp > XB_SPIN_CAP) { atomicAdd(&bar[XB_TMO], 1u); break; } }
    }
    nloc = mine > 0u ? mine : 1u; nx = cnt > 0u ? cnt : 1u;
}
__device__ __forceinline__ void xcd_barrier(const XcdBarrier& b) {
    asm volatile("s_waitcnt vmcnt(0)" ::: "memory");
    __syncthreads();
    if (threadIdx.x == 0) {
        unsigned* bar = b.bar;
        __builtin_amdgcn_s_waitcnt(0);
        unsigned nloc = b.st[0], nx = b.st[1];
        if (nloc == 0u) { xcd_barrier_complete(bar, b.x, nloc, nx); b.st[0] = nloc; b.st[1] = nx; }
        const unsigned old = xb_add(&bar[XB_XSUB(b.x)], 1u);
        const unsigned gen = old / nloc;
        if (old + 1u == (gen + 1u) * nloc) {
            __builtin_amdgcn_fence(__ATOMIC_RELEASE, "agent");
            asm volatile("s_waitcnt vmcnt(0)" ::: "memory");
            const unsigned og = xb_add(&bar[XB_TOP], 1u);
            const unsigned tg = og / nx;
            if (og + 1u == (tg + 1u) * nx) xb_add(&bar[XB_TOPGEN], 1u);
            else XB_SPIN(xb_ld(&bar[XB_TOPGEN]) == tg, bar);
            __builtin_amdgcn_fence(__ATOMIC_ACQUIRE, "agent");
            xb_add(&bar[XB_XGEN(b.x)], 1u);
            asm volatile("s_waitcnt vmcnt(0)" ::: "memory");
        } else {
            XB_SPIN(xb_ld(&bar[XB_XGEN(b.x)]) == gen, bar);
            __builtin_amdgcn_fence(__ATOMIC_ACQUIRE, "agent");
            asm volatile("s_waitcnt vmcnt(0)" ::: "memory");
        }
    }
    __syncthreads();
}

namespace pg8 {
#define PG8_LAS __attribute__((address_space(3)))
typedef unsigned short bf16_t;
constexpr int BM = 256, BK = 64, HALF = 128, HTB = HALF * BK * 2  , STAGE_BYTES = 8 * HTB, NXCD = 8, WGM = 8;
__host__ __device__ __forceinline__ int lds_byte(int r, int c) { const int st = (r >> 4) * 2 + (c >> 5), rr = r & 15, cc = c & 31, ob = rr * 64 + cc * 2; return st * 1024 + (ob ^ (((ob >> 9) & 1) << 5)); }
__host__ __device__ __forceinline__ void stage_rc(int b, int& R, int& C) { const int st = b / 1024, sb = b % 1024, swz = sb ^ (((sb >> 9) & 1) << 5); R = (st >> 1) * 16 + swz / 64; C = (st & 1) * 32 + (swz % 64) / 2; }
__host__ __device__ __forceinline__ int perm32(int rho) { const int n = rho >> 4, i = rho & 15; return 8 * (i >> 2) + 4 * n + (i & 3); }

struct Unit { int pm, pn, eb; };
struct Gemm { const bf16_t* A; const bf16_t* Bt; int lda, K; size_t bexp; };

struct StaticOrder {
    int nM, nN, nwg, G, c;
    __host__ __device__ void init(int nM_, int nN_, int G_, int c_) { nM = nM_; nN = nN_; nwg = nM * nN; G = G_; c = c_; }
    __host__ __device__ bool next(int i, Unit& u) const {
        const long L = (long)i * G + c; if (L >= nwg) return false;
        int wgid = (int)L; { const int q = nwg / NXCD, r = nwg % NXCD, xcd = wgid % NXCD, off = wgid / NXCD; wgid = (xcd < r ? xcd * (q + 1) : r * (q + 1) + (xcd - r) * q) + off; }
        const int nig = WGM * nN, gid = wgid / nig, fm = gid * WGM, gsz = (nM - fm) < WGM ? (nM - fm) : WGM;
        u.pm = fm + ((wgid % nig) % gsz); u.pn = (wgid % nig) / gsz; u.eb = 0; return true;
    }
    __device__ __forceinline__ void a_ready(const Unit&) const {}
    __device__ __forceinline__ void done(const Unit&) const {}
};
struct GroupedOrder : StaticOrder {
    int pb[9];
    __device__ __forceinline__ bool next(int i, Unit& u) const {
        if (!StaticOrder::next(i, u)) return false;
        int e = 0;
#pragma unroll
        for (int k = 1; k < 8; ++k) e += (u.pm >= pb[k]) ? 1 : 0;
        u.eb = e; return true;
    }
};

template <class Epi, class Sched, bool ALIGN_EPI = false, bool SP2 = false>
__device__ __forceinline__ void gemm_phase(PG8_LAS unsigned char* lds, const Gemm g, const Sched& S, const Epi& E) {
    const int tid = threadIdx.x, wid = __builtin_amdgcn_readfirstlane(tid >> 6), lane = tid & 63, wr = wid >> 2, wc = wid & 3, fr = lane & 15, fq = lane >> 4;
    const int K = g.K, nt = K / BK;
    unsigned voffA[2], voffB[2];
#pragma unroll
    for (int i = 0; i < 2; ++i) { int R, C; stage_rc(tid * 16 + i * 8192, R, C); const int Rb = Epi::PERM ? ((R & ~31) + perm32(R & 31)) : R;
        voffA[i] = (unsigned)(R * g.lda + C) * 2u; voffB[i] = (unsigned)(Rb * K + C) * 2u; }
    const size_t kstep = (size_t)(BK * 2);
    const size_t hstepA = (size_t)HALF * g.lda * 2, hstepB = (size_t)HALF * K * 2;
    const size_t tstepA = 2 * hstepA, tstepB = 2 * hstepB;
    const unsigned ldsw = (unsigned)wid * 1024u;
    const int aoff = lds_byte(wr * 64 + fr, fq * 8), boff = lds_byte(wc * 32 + fr, fq * 8);
#define PG8_SA(b, h) (((b) * 2 + (h)) * HTB)
#define PG8_SB(b, h) ((4 + (b) * 2 + (h)) * HTB)
#define PG8_STAGE(bufoff, gbase, voff) do { _Pragma("unroll") for (int _i = 0; _i < 2; ++_i) \
        __builtin_amdgcn_global_load_lds((const unsigned*)((const char*)(gbase) + (voff)[_i]), (PG8_LAS unsigned*)(lds + (bufoff) + ldsw + _i * 8192), 16, 0, 0); } while (0)
#define PG8_LDA(dst, b, h) do { _Pragma("unroll") for (int m = 0; m < 4; ++m) _Pragma("unroll") for (int k = 0; k < 2; ++k) dst[m][k] = *(const PG8_LAS bf16x8*)(lds + PG8_SA(b, h) + aoff + m * 2048 + k * 1024); } while (0)
#define PG8_LDB(dst, b, h) do { _Pragma("unroll") for (int n = 0; n < 2; ++n) _Pragma("unroll") for (int k = 0; k < 2; ++k) dst[n][k] = *(const PG8_LAS bf16x8*)(lds + PG8_SB(b, h) + boff + n * 2048 + k * 1024); } while (0)
#define PG8_MMA(ai, bj, At, Bt) do { __builtin_amdgcn_s_setprio(1); _Pragma("unroll") for (int m = 0; m < 4; ++m) _Pragma("unroll") for (int n = 0; n < 2; ++n) _Pragma("unroll") for (int k = 0; k < 2; ++k) \
        acc[ai][bj][m][n] = __builtin_amdgcn_mfma_f32_16x16x32_bf16(Bt[n][k], At[m][k], acc[ai][bj][m][n], 0, 0, 0); __builtin_amdgcn_s_setprio(0); } while (0)
#define PG8_WAIT_V(n) asm volatile("s_waitcnt vmcnt(" #n ")" ::: "memory")
#define PG8_WAIT_L(n) asm volatile("s_waitcnt lgkmcnt(" #n ")" ::: "memory")
#define PG8_BAR __builtin_amdgcn_s_barrier()
#define PG8_SCHED __builtin_amdgcn_sched_barrier(0)
    Unit cur, nxt; int ui = 0;
    if (!S.next(0, cur)) return;
    f32x4 acc[2][2][4][2];
#pragma unroll
    for (int a = 0; a < 2; ++a)
#pragma unroll
        for (int b = 0; b < 2; ++b)
#pragma unroll
            for (int m = 0; m < 4; ++m)
#pragma unroll
                for (int n = 0; n < 2; ++n) acc[a][b][m][n] = (f32x4){0.f, 0.f, 0.f, 0.f};
    bf16x8 At[4][2], B0[2][2], B1[2][2];
    const char* cA = (const char*)g.A + (size_t)cur.pm * tstepA; const char* cB = (const char*)g.Bt + (size_t)cur.eb * g.bexp + (size_t)cur.pn * tstepB;
    S.a_ready(cur);
    if constexpr (SP2) {
        PG8_STAGE(PG8_SB(0, 0), cB, voffB); PG8_STAGE(PG8_SB(0, 1), cB + hstepB, voffB); PG8_STAGE(PG8_SA(0, 0), cA, voffA); PG8_STAGE(PG8_SA(0, 1), cA + hstepA, voffA);
        if (wr == 1) PG8_BAR;
        PG8_WAIT_V(2); PG8_BAR;
        PG8_STAGE(PG8_SB(1, 0), cB + kstep, voffB); PG8_STAGE(PG8_SA(1, 0), cA + kstep, voffA); PG8_STAGE(PG8_SB(1, 1), cB + hstepB + kstep, voffB);
        PG8_WAIT_V(6); PG8_BAR;
    } else {
        PG8_STAGE(PG8_SB(0, 0), cB, voffB); PG8_STAGE(PG8_SA(0, 0), cA, voffA); PG8_STAGE(PG8_SB(0, 1), cB + hstepB, voffB); PG8_STAGE(PG8_SA(0, 1), cA + hstepA, voffA);
        if (wr == 1) PG8_BAR;
        PG8_WAIT_V(4); PG8_BAR;
        PG8_STAGE(PG8_SB(1, 0), cB + kstep, voffB); PG8_STAGE(PG8_SA(1, 0), cA + kstep, voffA); PG8_STAGE(PG8_SB(1, 1), cB + hstepB + kstep, voffB);
        PG8_WAIT_V(6); PG8_BAR;
    }
    for (;;) {
        const bool has_next = S.next(ui + 1, nxt);
        const char* nA = has_next ? (const char*)g.A + (size_t)nxt.pm * tstepA : cA; const char* nB = has_next ? (const char*)g.Bt + (size_t)nxt.eb * g.bexp + (size_t)nxt.pn * tstepB : cB;
        for (int t = 0; t < nt; t += 2) {
            const bool last = (t == nt - 2);
            const char* a1 = cA + (size_t)(t + 1) * kstep;
            const char* a2 = last ? nA : cA + (size_t)(t + 2) * kstep; const char* b2 = last ? nB : cB + (size_t)(t + 2) * kstep;
            const char* a3 = a2 + kstep; const char* b3 = b2 + kstep;
            if (last && has_next) S.a_ready(nxt);
            if constexpr (SP2) {
            PG8_LDB(B0, 0, 0); PG8_LDB(B1, 0, 1); PG8_SCHED; PG8_LDA(At, 0, 0); PG8_STAGE(PG8_SA(1, 1), a1 + hstepA, voffA);
            PG8_WAIT_V(8); PG8_WAIT_L(0); PG8_BAR; PG8_MMA(0, 0, At, B0); PG8_MMA(0, 1, At, B1); PG8_BAR; PG8_SCHED;
            PG8_LDA(At, 0, 1); PG8_STAGE(PG8_SB(0, 0), b2, voffB); PG8_STAGE(PG8_SB(0, 1), b2 + hstepB, voffB); PG8_STAGE(PG8_SA(0, 0), a2, voffA);
            PG8_WAIT_V(8); PG8_WAIT_L(0); PG8_BAR; PG8_MMA(1, 0, At, B0); PG8_MMA(1, 1, At, B1); PG8_BAR; PG8_SCHED;
            PG8_LDB(B0, 1, 0); PG8_LDB(B1, 1, 1); PG8_SCHED; PG8_LDA(At, 1, 0); PG8_STAGE(PG8_SA(0, 1), a2 + hstepA, voffA);
            PG8_WAIT_V(8); PG8_WAIT_L(0); PG8_BAR; PG8_MMA(0, 0, At, B0); PG8_MMA(0, 1, At, B1); PG8_BAR; PG8_SCHED;
            PG8_LDA(At, 1, 1); PG8_STAGE(PG8_SB(1, 0), b3, voffB); PG8_STAGE(PG8_SB(1, 1), b3 + hstepB, voffB); PG8_STAGE(PG8_SA(1, 0), a3, voffA);
            PG8_WAIT_V(8); PG8_WAIT_L(0); PG8_BAR; PG8_MMA(1, 0, At, B0); PG8_MMA(1, 1, At, B1); PG8_BAR; PG8_SCHED;
            } else {
            PG8_LDB(B0, 0, 0); PG8_SCHED; PG8_LDA(At, 0, 0); PG8_STAGE(PG8_SA(1, 1), a1 + hstepA, voffA);
            PG8_WAIT_L(8); PG8_BAR; PG8_WAIT_L(0); PG8_MMA(0, 0, At, B0); PG8_BAR; PG8_SCHED;
            PG8_LDB(B1, 0, 1); PG8_STAGE(PG8_SB(0, 0), b2, voffB);
            PG8_BAR; PG8_WAIT_L(0); PG8_MMA(0, 1, At, B1); PG8_BAR;
            PG8_LDA(At, 0, 1); PG8_STAGE(PG8_SA(0, 0), a2, voffA);
            PG8_BAR; PG8_WAIT_L(0); PG8_MMA(1, 0, At, B0); PG8_BAR; PG8_SCHED;
            PG8_STAGE(PG8_SB(0, 1), b2 + hstepB, voffB);
            PG8_WAIT_V(6); PG8_BAR; PG8_MMA(1, 1, At, B1); PG8_BAR;
            PG8_LDB(B0, 1, 0); PG8_SCHED; PG8_LDA(At, 1, 0); PG8_STAGE(PG8_SA(0, 1), a2 + hstepA, voffA);
            PG8_WAIT_L(8); PG8_BAR; PG8_WAIT_L(0); PG8_MMA(0, 0, At, B0); PG8_BAR; PG8_SCHED;
            PG8_LDB(B1, 1, 1); PG8_STAGE(PG8_SB(1, 0), b3, voffB);
            PG8_BAR; PG8_WAIT_L(0); PG8_MMA(0, 1, At, B1); PG8_BAR;
            PG8_LDA(At, 1, 1); PG8_STAGE(PG8_SA(1, 0), a3, voffA);
            PG8_BAR; PG8_WAIT_L(0); PG8_MMA(1, 0, At, B0); PG8_BAR; PG8_SCHED;
            PG8_STAGE(PG8_SB(1, 1), b3 + hstepB, voffB);
            PG8_WAIT_V(6); PG8_BAR; PG8_MMA(1, 1, At, B1); PG8_BAR;
            }
        }
        if constexpr (ALIGN_EPI) { if (wr == 0) PG8_BAR; }
        E(acc, cur, wr, wc, fr, fq); S.done(cur);
        if (!has_next) break;
#pragma unroll
        for (int a = 0; a < 2; ++a)
#pragma unroll
            for (int b = 0; b < 2; ++b)
#pragma unroll
                for (int m = 0; m < 4; ++m)
#pragma unroll
                    for (int n = 0; n < 2; ++n) acc[a][b][m][n] = (f32x4){0.f, 0.f, 0.f, 0.f};
        cur = nxt; cA = nA; cB = nB; ++ui;
        if constexpr (ALIGN_EPI) { if (wr == 1) PG8_BAR; }
    }
    PG8_WAIT_V(0);
    if constexpr (!ALIGN_EPI) { if (wr == 0) PG8_BAR; }
    PG8_BAR;
#undef PG8_SA
#undef PG8_SB
#undef PG8_STAGE
#undef PG8_LDA
#undef PG8_LDB
#undef PG8_MMA
#undef PG8_WAIT_V
#undef PG8_WAIT_L
#undef PG8_BAR
#undef PG8_SCHED
}

template <int MODE> struct EpiPair {
    static constexpr bool PERM = true;
    bf16_t* O; int ldc;
    __device__ __forceinline__ void operator()(const f32x4 (&acc)[2][2][4][2], const Unit& u, int wr, int wc, int fr, int fq) const {
        const int row0 = u.pm * BM + wr * 64 + fr, col0 = u.pn * HALF + wc * 32 + 8 * fq;
#pragma unroll
        for (int ai = 0; ai < 2; ++ai)
#pragma unroll
            for (int m = 0; m < 4; ++m) { bf16_t* p = O + (size_t)(row0 + ai * HALF + m * 16) * ldc + col0; float r[8];
#pragma unroll
                for (int n = 0; n < 2; ++n)
#pragma unroll
                    for (int j = 0; j < 4; ++j) { const float x0 = acc[ai][0][m][n][j], x1 = acc[ai][1][m][n][j];
                        r[n * 4 + j] = MODE == 0 ? x0 * fast_sigmoid(x1) : (MODE == 1 ? fast_silu(x0) * x1 : x0 * x1); }
                v4u w; w.x = cvt_pk_bf16(r[0], r[1]); w.y = cvt_pk_bf16(r[2], r[3]); w.z = cvt_pk_bf16(r[4], r[5]); w.w = cvt_pk_bf16(r[6], r[7]);
                *(v4u*)p = w; }
    }
};
struct EpiBf16 {
    static constexpr bool PERM = true;
    bf16_t* O; int ldc; float scale;
    __device__ __forceinline__ void operator()(const f32x4 (&acc)[2][2][4][2], const Unit& u, int wr, int wc, int fr, int fq) const {
        const int row0 = u.pm * BM + wr * 64 + fr, col0 = u.pn * BM + wc * 32 + 8 * fq;
#pragma unroll
        for (int ai = 0; ai < 2; ++ai)
#pragma unroll
            for (int m = 0; m < 4; ++m) { bf16_t* rowp = O + (size_t)(row0 + ai * HALF + m * 16) * ldc + col0;
#pragma unroll
                for (int bj = 0; bj < 2; ++bj) { const f32x4 v0 = acc[ai][bj][m][0] * scale, v1 = acc[ai][bj][m][1] * scale;
                    v4u w; w.x = cvt_pk_bf16(v0[0], v0[1]); w.y = cvt_pk_bf16(v0[2], v0[3]); w.z = cvt_pk_bf16(v1[0], v1[1]); w.w = cvt_pk_bf16(v1[2], v1[3]);
                    *(v4u*)(rowp + bj * HALF) = w; } }
    }
};
struct EpiResid {
    static constexpr bool PERM = false;
    const float* res; float* out; int ldc;
    __device__ __forceinline__ void operator()(const f32x4 (&acc)[2][2][4][2], const Unit& u, int wr, int wc, int fr, int fq) const {
        const int row0 = u.pm * BM + wr * 64 + fr, col0 = u.pn * BM + wc * 32 + 4 * fq;
#pragma unroll
        for (int ai = 0; ai < 2; ++ai)
#pragma unroll
            for (int m = 0; m < 4; ++m) { const size_t off = (size_t)(row0 + ai * HALF + m * 16) * ldc + col0;
#pragma unroll
                for (int bj = 0; bj < 2; ++bj)
#pragma unroll
                    for (int n = 0; n < 2; ++n) { const f32x4 r = *(const f32x4*)(res + off + bj * HALF + n * 16); *(f32x4*)(out + off + bj * HALF + n * 16) = r * ALPHA_F + acc[ai][bj][m][n]; } }
    }
};
}
namespace pg8 {
struct EpiSC {
    static constexpr bool PERM = true;
    bf16_t* CH; bf16_t* BG;
    __device__ __forceinline__ void operator()(const f32x4 (&acc)[2][2][4][2], const Unit& u, int wr, int wc, int fr, int fq) const {
        if (u.pn < 8) { EpiPair<2> e{CH, DM}; e(acc, u, wr, wc, fr, fq); }
        else { Unit u2 = u; u2.pn = u.pn - 8; EpiBf16 e{BG, DM, 1.0f}; e(acc, u2, wr, wc, fr, fq); }
    }
};
}
namespace pg8 {
struct EpiNSA {
    static constexpr bool PERM = true;
    bf16_t* Q; bf16_t* KV; float* GATE;
    __device__ __forceinline__ void operator()(const f32x4 (&acc)[2][2][4][2], const Unit& u, int wr, int wc, int fr, int fq) const {
        const int b = u.pm >> 3, tb = (u.pm & 7) * 256 + wr * 64 + fr, d0 = 32 * (wc & 1) + 8 * fq;
        if (u.pn < 4) {
            const float sc = 0.125f * 1.4426950408889634f;
#pragma unroll
            for (int ai = 0; ai < 2; ++ai)
#pragma unroll
                for (int m = 0; m < 4; ++m) { const int t = tb + ai * HALF + m * 16;
#pragma unroll
                    for (int bj = 0; bj < 2; ++bj) { const int h = u.pn * 4 + 2 * bj + (wc >> 1); const f32x4 v0 = acc[ai][bj][m][0] * sc, v1 = acc[ai][bj][m][1] * sc;
                        v4u w; w.x = cvt_pk_bf16(v0[0], v0[1]); w.y = cvt_pk_bf16(v0[2], v0[3]); w.z = cvt_pk_bf16(v1[0], v1[1]); w.w = cvt_pk_bf16(v1[2], v1[3]);
                        *(v4u*)(Q + (((size_t)(b * NH + h) * SEQ + t) * HD + d0)) = w; } }
        } else if (u.pn < 10) {
            const int ti = u.pn - 4; bf16_t* base = KV + (size_t)ti * (4u << 20);
            const bool tr = (ti == 3) || (ti == 5);
#pragma unroll
            for (int ai = 0; ai < 2; ++ai)
#pragma unroll
                for (int m = 0; m < 4; ++m) { const int t = tb + ai * HALF + m * 16;
#pragma unroll
                    for (int bj = 0; bj < 2; ++bj) { const int hk = 2 * bj + (wc >> 1); const f32x4 v0 = acc[ai][bj][m][0], v1 = acc[ai][bj][m][1];
                        if (!tr) { v4u w; w.x = cvt_pk_bf16(v0[0], v0[1]); w.y = cvt_pk_bf16(v0[2], v0[3]); w.z = cvt_pk_bf16(v1[0], v1[1]); w.w = cvt_pk_bf16(v1[2], v1[3]);
                            *(v4u*)(base + (((size_t)(b * NKV + hk) * SEQ + t) * HD + d0)) = w; }
                        else { bf16_t* p = base + ((size_t)(b * NKV + hk) * HD + d0) * SEQ + t;
#pragma unroll
                            for (int j = 0; j < 4; ++j) { p[(size_t)j * SEQ] = (bf16_t)f2bf(v0[j]); p[(size_t)(4 + j) * SEQ] = (bf16_t)f2bf(v1[j]); } } } }
        } else {
            if (wc < 2 && (wc == 0 || fq < 2)) {
#pragma unroll
                for (int ai = 0; ai < 2; ++ai)
#pragma unroll
                    for (int m = 0; m < 4; ++m) { const size_t row = (size_t)u.pm * BM + wr * 64 + fr + ai * HALF + m * 16; float* p = GATE + row * 48 + 32 * wc + 8 * fq;
                        const f32x4 v0 = acc[ai][0][m][0], v1 = acc[ai][0][m][1];
                        *(f32x4*)p = (f32x4){fast_sigmoid(v0[0]), fast_sigmoid(v0[1]), fast_sigmoid(v0[2]), fast_sigmoid(v0[3])};
                        *(f32x4*)(p + 4) = (f32x4){fast_sigmoid(v1[0]), fast_sigmoid(v1[1]), fast_sigmoid(v1[2]), fast_sigmoid(v1[3])}; }
            }
        }
    }
};
}

constexpr size_t MiB = 1u << 20;
constexpr size_t WS_CTL = 0, CTL_ZERO_BYTES = 1 * MiB;
constexpr size_t WS_X = 1 * MiB;
constexpr size_t WS_XBF = 65 * MiB;
constexpr size_t WS_ACT = 97 * MiB;
constexpr size_t WS_H = 225 * MiB;
constexpr size_t WS_MISC = 463 * MiB;
constexpr size_t WS_W = 467 * MiB;
constexpr size_t W_CONF_IN = WS_W, W_CONF_OUT = W_CONF_IN + 8 * MiB, W_SC_IN = W_CONF_OUT + 4 * MiB, W_SC_OUT = W_SC_IN + 6 * MiB;
constexpr size_t W_NSA_IN = W_SC_OUT + 2 * MiB, W_NSA_OUT = W_NSA_IN + 6 * MiB, W_CMP1 = W_NSA_OUT + 2 * MiB;
constexpr size_t W_FFN_GU = W_CMP1 + 1 * MiB, W_FFN_D = W_FFN_GU + 22 * MiB, W_MOE_GU = W_FFN_D + 11 * MiB, W_MOE_D = W_MOE_GU + 224 * MiB, WS_END = W_MOE_D + 112 * MiB;
static_assert(WS_END <= 896 * MiB, "workspace map");
constexpr size_t A_U = WS_ACT, A_V = WS_ACT + 32 * MiB;
constexpr size_t A_CH = WS_ACT, A_BG = WS_ACT + 32 * MiB, A_YSC = WS_ACT + 64 * MiB;
constexpr size_t A_Q = WS_ACT, A_KC = WS_ACT + 32 * MiB, A_VCT = A_KC + 8 * MiB, A_KS = A_VCT + 8 * MiB, A_VST = A_KS + 8 * MiB, A_KW = A_VST + 8 * MiB, A_VWT = A_KW + 8 * MiB;
constexpr size_t A_O = A_VWT + 8 * MiB, A_GATE = A_O + 32 * MiB, A_KCMP = A_GATE + 4 * MiB, A_VCMPT = A_KCMP + 1 * MiB;
constexpr size_t A_PERM = WS_ACT;
static_assert(A_VCMPT + 1 * MiB <= WS_ACT + 128 * MiB, "ACT map");
constexpr int MOE_ROWS_MAX = 2 * MTOK + NEXP * 256;
static_assert((size_t)MOE_ROWS_MAX * DFFE * 2 <= 238 * MiB && (size_t)MOE_ROWS_MAX * DM * 2 <= 128 * MiB, "MoE buffers");
constexpr size_t MS_LIST = WS_MISC, MS_TSEL = MS_LIST + (size_t)NEXP * MTOK * 4, MS_TWT = MS_TSEL + (size_t)MTOK * 16, MS_END = MS_TWT + (size_t)MTOK * 8;
static_assert(MS_END <= WS_MISC + 4 * MiB, "MISC map");
constexpr int CW_BAR = 4096;
constexpr int CW_MOE = 16384;
constexpr int RING_BYTES = 131072, LDSCTL_OFF = RING_BYTES, LDS_BYTES = 147456;

struct CvtGroup { int in_idx, nmat; size_t src_stride; int ld, col0, K, ncols; size_t dst; size_t dst_stride; int rs, off; };
constexpr int NGROUPS = 17;
__device__ constexpr CvtGroup kGroups[NGROUPS] = {
    {I_CWIN, 2, (size_t)DM * 2 * DM, 2 * DM, 0, DM, DM, W_CONF_IN, 4 * MiB, 256, 0},
    {I_CWIN, 2, (size_t)DM * 2 * DM, 2 * DM, DM, DM, DM, W_CONF_IN, 4 * MiB, 256, 128},
    {I_CWOUT, 2, (size_t)DM * DM, DM, 0, DM, DM, W_CONF_OUT, 2 * MiB, 128, 0},
    {I_SWIN, 1, 0, 3 * DM, 0, DM, DM, W_SC_IN, 0, 128, 2048},
    {I_SWIN, 1, 0, 3 * DM, DM, DM, DM, W_SC_IN, 0, 256, 0},
    {I_SWIN, 1, 0, 3 * DM, 2 * DM, DM, DM, W_SC_IN, 0, 256, 128},
    {I_SWOUT, 1, 0, DM, 0, DM, DM, W_SC_OUT, 0, 128, 0},
    {I_NWIN, 1, 0, NSA_COLS, 0, DM, NSA_COLS, W_NSA_IN, 0, 128, 0},
    {I_NWOUT, 1, 0, DM, 0, DM, DM, W_NSA_OUT, 0, 128, 0},
    {I_NWK1, 1, 0, PHI, 0, CMP_BLOCK * HD, PHI, W_CMP1, 0, 128, 0},
    {I_NWV1, 1, 0, PHI, 0, CMP_BLOCK * HD, PHI, W_CMP1, 0, 128, 128},
    {I_FWG, 2, (size_t)DM * DFF, DFF, 0, DM, DFF, W_FFN_GU, 11 * MiB, 256, 0},
    {I_FWU, 2, (size_t)DM * DFF, DFF, 0, DM, DFF, W_FFN_GU, 11 * MiB, 256, 128},
    {I_FWD, 2, (size_t)DFF * DM, DM, 0, DFF, DM, W_FFN_D, (size_t)DM * DFF * 2, 128, 0},
    {I_MWG, 16, (size_t)DM * DFFE, DFFE, 0, DM, DFFE, W_MOE_GU, (size_t)2 * DFFE * DM * 2, 256, 0},
    {I_MWU, 16, (size_t)DM * DFFE, DFFE, 0, DM, DFFE, W_MOE_GU, (size_t)2 * DFFE * DM * 2, 256, 128},
    {I_MWD, 16, (size_t)DFFE * DM, DM, 0, DFFE, DM, W_MOE_D, (size_t)DM * DFFE * 2, 128, 0},
};
__host__ __device__ constexpr int grp_items_per_mat(int gi) { return (kGroups[gi].K / 64) * ((kGroups[gi].ncols + 31) / 32); }
__host__ __device__ constexpr int grp_items(int gi) { return kGroups[gi].nmat * grp_items_per_mat(gi); }
__host__ __device__ constexpr int grp_total() { int s = 0; for (int i = 0; i < NGROUPS; ++i) s += grp_items(i); return s; }
static_assert(W_FFN_GU + 2 * 11 * MiB == W_FFN_D && (size_t)2 * DFF * DM * 2 == 11 * MiB && (size_t)2 * DFFE * DM * 2 * 16 == 224 * MiB && (size_t)DM * DFFE * 2 * 16 == 112 * MiB, "weight map");

__device__ __forceinline__ void cvt_item(const float* src, int ld, int nvalid, bf16* dst, int Kd, int k0, LAS float* scr, int lane) {
#pragma unroll 8
    for (int i = 0; i < 32; ++i) { const int kk = 2 * i + (lane >> 5), cc = lane & 31; scr[kk * 33 + cc] = (cc < nvalid) ? src[(size_t)kk * ld + cc] : 0.f; }
    LDS_WAIT(); asm volatile("" ::: "memory");
    const int c = lane & 7;
#pragma unroll
    for (int j = 0; j < 4; ++j) { const int n = (lane >> 3) + 8 * j; const LAS float* s = scr + (8 * c) * 33 + n;
        v4u o; o.x = pk2(s[0 * 33], s[1 * 33]); o.y = pk2(s[2 * 33], s[3 * 33]); o.z = pk2(s[4 * 33], s[5 * 33]); o.w = pk2(s[6 * 33], s[7 * 33]);
        *(GAS v4u*)(dst + (size_t)n * Kd + k0 + 8 * c) = o; }
    LDS_WAIT(); asm volatile("" ::: "memory");
}
struct FArgs { const float* in[29]; float* out; unsigned char* ws; int ph_lo, ph_hi; };

__device__ __forceinline__ void phase_prologue(const FArgs& a, LAS unsigned char* lds, int gw, int NGW, int wave, int lane) {
    LAS float* scr = (LAS float*)(lds + wave * 16384);
    constexpr int NITEMS = grp_total();
    for (int it = gw; it < NITEMS; it += NGW) {
        int r = it, gi = 0;
#pragma unroll 1
        for (; gi < NGROUPS - 1; ++gi) { const int n = grp_items(gi); if (r < n) break; r -= n; }
        const CvtGroup G = kGroups[gi];
        const int ipm = (G.K / 64) * ((G.ncols + 31) / 32), mat = r / ipm, r2 = r % ipm, nblk = (G.ncols + 31) / 32, kb = r2 / nblk, nb = r2 % nblk;
        const int c0 = nb * 32, k0 = kb * 64, drow = (c0 / 128) * G.rs + (c0 % 128) + G.off;
        const float* src = a.in[G.in_idx] + (size_t)mat * G.src_stride + (size_t)k0 * G.ld + G.col0 + c0;
        bf16* dst = (bf16*)(a.ws + G.dst + (size_t)mat * G.dst_stride) + (size_t)drow * G.K;
        const int nvalid = (G.ncols - c0) < 32 ? (G.ncols - c0) : 32;
        cvt_item(src, G.ld, nvalid, dst, G.K, k0, scr, lane);
    }
    { const float* x = a.in[I_X]; bf16* xb = (bf16*)(a.ws + WS_XBF);
      for (size_t i = (size_t)gw * 64 + lane; i < (size_t)MTOK * DM / 8; i += (size_t)NGW * 64) {
        const f32x4 v0 = *(const GAS f32x4*)(x + i * 8), v1 = *(const GAS f32x4*)(x + i * 8 + 4);
        v4u o; o.x = pk2(v0.x, v0.y); o.y = pk2(v0.z, v0.w); o.z = pk2(v1.x, v1.y); o.w = pk2(v1.z, v1.w); *(GAS v4u*)(xb + i * 8) = o; } }
}

__device__ __forceinline__ void phase_ln(const float* Y, const float* gam, const float* bet, float* XO, bf16* XB, int gw, int NGW, int lane) {
    f32x4 gg[4], bb[4];
#pragma unroll
    for (int j = 0; j < 4; ++j) { gg[j] = *(const GAS f32x4*)(gam + 4 * lane + 256 * j); bb[j] = *(const GAS f32x4*)(bet + 4 * lane + 256 * j); }
    for (int m = gw; m < MTOK; m += NGW) {
        const GAS f32x4* yr = (const GAS f32x4*)(Y + (size_t)m * DM) + lane;
        f32x4 v[4]; float s = 0.f;
#pragma unroll
        for (int j = 0; j < 4; ++j) { v[j] = yr[64 * j]; s += (v[j].x + v[j].y) + (v[j].z + v[j].w); }
        const float mean = wave_sum(s) * (1.f / DM); float s2 = 0.f;
#pragma unroll
        for (int j = 0; j < 4; ++j) { v[j] = v[j] - mean; s2 += (v[j].x * v[j].x + v[j].y * v[j].y) + (v[j].z * v[j].z + v[j].w * v[j].w); }
        const float rstd = 1.f / sqrtf(wave_sum(s2) * (1.f / DM) + LN_EPS);
        GAS f32x4* xo = (GAS f32x4*)(XO + (size_t)m * DM) + lane;
#pragma unroll
        for (int j = 0; j < 4; ++j) { v[j] = v[j] * rstd * gg[j] + bb[j]; xo[64 * j] = v[j]; }
        if (XB) { GAS v2u* o8 = (GAS v2u*)(XB + (size_t)m * DM) + lane;
#pragma unroll
            for (int j = 0; j < 4; ++j) { v2u w; w.x = pk2(v[j].x, v[j].y); w.y = pk2(v[j].z, v[j].w); o8[64 * j] = w; } }
    }
}

constexpr int DWR = 8;
__device__ __forceinline__ void phase_conf_dw(const bf16* U, const float* wdw, const float* bdw, const float* gam, const float* bet, bf16* V, LAS unsigned char* lds, int tid, int wave, int lane) {
    LAS float* redA = (LAS float*)lds; LAS float* redB = redA + 64;
    LAS f32x2* wl = (LAS f32x2*)(lds + 1024);
    const unsigned loff = (unsigned)tid * 4u;
#pragma unroll 1
    for (int k = 0; k < CONV_K; ++k) wl[k * 512 + tid] = *(const GAS f32x2*)(wdw + k * DM + 2 * tid);
    const f32x2 bd = *(const GAS f32x2*)(bdw + 2 * tid), gg = *(const GAS f32x2*)(gam + 2 * tid), bb = *(const GAS f32x2*)(bet + 2 * tid);
    for (int chunk = blockIdx.x; chunk < MTOK / 64; chunk += gridDim.x) {
        const int r0 = chunk * 64, t0 = r0 % SEQ;
        f32x2 a[30 + DWR];
#pragma unroll
        for (int j = 0; j < 30; ++j) { unsigned u = 0u; if (t0 - 30 + j >= 0) u = *(const GAS unsigned*)((const GAS char*)U + (size_t)(r0 - 30 + j) * (DM * 2) + loff); a[j] = (f32x2){bf_lo(u), bf_hi(u)}; }
#pragma unroll 1
        for (int blk = 0; blk < 64 / DWR; ++blk) {
            const int rb = r0 + blk * DWR;
#pragma unroll
            for (int i = 0; i < DWR; ++i) { const unsigned u = *(const GAS unsigned*)((const GAS char*)U + (size_t)(rb + i) * (DM * 2) + loff); a[30 + i] = (f32x2){bf_lo(u), bf_hi(u)}; }
            f32x2 o[DWR]; float s[DWR];
#pragma unroll
            for (int i = 0; i < DWR; ++i) o[i] = bd;
#pragma unroll
            for (int k = 0; k < CONV_K; ++k) { const f32x2 w = wl[k * 512 + tid];
#pragma unroll
                for (int i = 0; i < DWR; ++i) o[i] += w * a[i + k]; }
#pragma unroll
            for (int i = 0; i < DWR; ++i) s[i] = wave_sum(o[i].x + o[i].y);
            if (lane == 0) {
#pragma unroll
                for (int i = 0; i < DWR; ++i) redA[wave * DWR + i] = s[i]; }
            __syncthreads();
#pragma unroll
            for (int i = 0; i < DWR; ++i) { float t = 0.f;
#pragma unroll
                for (int w = 0; w < 8; ++w) t += redA[w * DWR + i];
                const float mean = t * (1.f / DM); o[i] = o[i] - mean; s[i] = wave_sum(o[i].x * o[i].x + o[i].y * o[i].y); }
            if (lane == 0) {
#pragma unroll
                for (int i = 0; i < DWR; ++i) redB[wave * DWR + i] = s[i]; }
            __syncthreads();
#pragma unroll
            for (int i = 0; i < DWR; ++i) { float t = 0.f;
#pragma unroll
                for (int w = 0; w < 8; ++w) t += redB[w * DWR + i];
                const float rstd = 1.f / sqrtf(t * (1.f / DM) + LN_EPS);
                const f32x2 y = o[i] * rstd * gg + bb;
                *(GAS unsigned*)((GAS char*)V + (size_t)(rb + i) * (DM * 2) + loff) = pk2(fast_silu(y.x), fast_silu(y.y)); }
#pragma unroll
            for (int j = 0; j < 30; ++j) a[j] = a[j + DWR];
        }
    }
}

__device__ __forceinline__ void phase_shortconv(const bf16* CH, const bf16* BG, const float* wc, bf16* Y, int tid) {
    const unsigned loff = (unsigned)tid * 4u;
    const f32x2 w0 = *(const GAS f32x2*)(wc + 0 * DM + 2 * tid), w1 = *(const GAS f32x2*)(wc + 1 * DM + 2 * tid), w2 = *(const GAS f32x2*)(wc + 2 * DM + 2 * tid);
    for (int chunk = blockIdx.x; chunk < MTOK / 64; chunk += gridDim.x) {
        const int r0 = chunk * 64, t0 = r0 % SEQ;
        f32x2 p2 = (f32x2){0.f, 0.f}, p1 = p2;
        if (t0 > 0) { const unsigned ua = *(const GAS unsigned*)((const GAS char*)CH + (size_t)(r0 - 2) * (DM * 2) + loff), ub = *(const GAS unsigned*)((const GAS char*)CH + (size_t)(r0 - 1) * (DM * 2) + loff);
            p2 = (f32x2){bf_lo(ua), bf_hi(ua)}; p1 = (f32x2){bf_lo(ub), bf_hi(ub)}; }
#pragma unroll 8
        for (int i = 0; i < 64; ++i) {
            const unsigned uc = *(const GAS unsigned*)((const GAS char*)CH + (size_t)(r0 + i) * (DM * 2) + loff), ug = *(const GAS unsigned*)((const GAS char*)BG + (size_t)(r0 + i) * (DM * 2) + loff);
            const f32x2 c = (f32x2){bf_lo(uc), bf_hi(uc)}, g = (f32x2){bf_lo(ug), bf_hi(ug)};
            const f32x2 y = g * (w0 * p2 + w1 * p1 + w2 * c);
            *(GAS unsigned*)((GAS char*)Y + (size_t)(r0 + i) * (DM * 2) + loff) = pk2(y.x, y.y);
            p2 = p1; p1 = c; }
    }
}

__device__ __forceinline__ void phase_ln_router(const float* Y, const float* gam, const float* bet, float* XO, bf16* XB, const float* wr, unsigned* cnt, int* list, int* tsel, float* twt,
                                                LAS unsigned char* lds, int gw, int NGW, int tid, int lane) {
    LAS f32x4* wl = (LAS f32x4*)lds;
    for (int i = tid; i < DM * NEXP / 4; i += NTHR) wl[i] = *(const GAS f32x4*)(wr + 4 * i);
    __syncthreads();
    f32x4 gg[4], bb[4];
#pragma unroll
    for (int j = 0; j < 4; ++j) { gg[j] = *(const GAS f32x4*)(gam + 4 * lane + 256 * j); bb[j] = *(const GAS f32x4*)(bet + 4 * lane + 256 * j); }
    for (int m = gw; m < MTOK; m += NGW) {
        const GAS f32x4* yr = (const GAS f32x4*)(Y + (size_t)m * DM) + lane;
        f32x4 v[4]; float s = 0.f;
#pragma unroll
        for (int j = 0; j < 4; ++j) { v[j] = yr[64 * j]; s += (v[j].x + v[j].y) + (v[j].z + v[j].w); }
        const float mean = wave_sum(s) * (1.f / DM); float s2 = 0.f;
#pragma unroll
        for (int j = 0; j < 4; ++j) { v[j] = v[j] - mean; s2 += (v[j].x * v[j].x + v[j].y * v[j].y) + (v[j].z * v[j].z + v[j].w * v[j].w); }
        const float rstd = 1.f / sqrtf(wave_sum(s2) * (1.f / DM) + LN_EPS);
        GAS f32x4* xo = (GAS f32x4*)(XO + (size_t)m * DM) + lane;
        GAS v2u* o8 = (GAS v2u*)(XB + (size_t)m * DM) + lane;
        f32x4 la = (f32x4){0.f, 0.f, 0.f, 0.f}, lb = la;
#pragma unroll
        for (int j = 0; j < 4; ++j) { v[j] = v[j] * rstd * gg[j] + bb[j]; xo[64 * j] = v[j];
            v2u w; w.x = pk2(v[j].x, v[j].y); w.y = pk2(v[j].z, v[j].w); o8[64 * j] = w;
#pragma unroll
            for (int i = 0; i < 4; ++i) { const int c = 4 * lane + 256 * j + i; const f32x4 wa = wl[2 * c], wb = wl[2 * c + 1]; la += wa * v[j][i]; lb += wb * v[j][i]; } }
        float lg[NEXP];
#pragma unroll
        for (int e = 0; e < 4; ++e) { lg[e] = wave_sum(la[e]); lg[4 + e] = wave_sum(lb[e]); }
        if (lane == 0) {
            int e1 = 0; float v1 = lg[0];
#pragma unroll
            for (int e = 1; e < NEXP; ++e) if (lg[e] > v1) { v1 = lg[e]; e1 = e; }
            int e2 = -1; float v2 = -3.4e38f;
#pragma unroll
            for (int e = 0; e < NEXP; ++e) if (e != e1 && lg[e] > v2) { v2 = lg[e]; e2 = e; }
            const float p2 = expf(v2 - v1), w1 = 1.0f / (1.0f + p2), w2 = p2 / (1.0f + p2);
            const int s1 = (int)__hip_atomic_fetch_add(cnt + e1, 1u, RLX_AGENT), sl2 = (int)__hip_atomic_fetch_add(cnt + e2, 1u, RLX_AGENT);
            list[e1 * MTOK + s1] = m; list[e2 * MTOK + sl2] = m;
            *(int4*)(tsel + 4 * m) = make_int4(e1, s1, e2, sl2); *(float2*)(twt + 2 * m) = make_float2(w1, w2);
        }
    }
}
__device__ __forceinline__ void moe_panels(const unsigned* cnt, int (&pb)[9]) {
    int acc = 0;
#pragma unroll
    for (int e = 0; e < NEXP; ++e) { pb[e] = acc; const int c = (int)__builtin_amdgcn_readfirstlane((int)cnt[e]); acc += (c + 255) >> 8; }
    pb[NEXP] = acc;
}
__device__ __forceinline__ void phase_moe_permute(const bf16* XB, const unsigned* cnt, const int* list, bf16* AP, int gw, int NGW, int lane) {
    int pb[9]; moe_panels(cnt, pb);
    const int total = pb[NEXP] * 256;
    for (int r = gw; r < total; r += NGW) {
        const int pm = r >> 8; int e = 0;
#pragma unroll
        for (int k = 1; k < NEXP; ++k) e += (pm >= pb[k]) ? 1 : 0;
        const int c = (int)cnt[e]; int slot = r - pb[e] * 256; slot = slot < c ? slot : c - 1;
        const int m = list[e * MTOK + slot];
        const GAS v4u* src = (const GAS v4u*)(XB + (size_t)m * DM) + lane; GAS v4u* dst = (GAS v4u*)(AP + (size_t)r * DM) + lane;
        const v4u a = src[0], b = src[64]; dst[0] = a; dst[64] = b;
    }
}
__device__ __forceinline__ void phase_ln_moe(const float* X, const bf16* YM, const unsigned* cnt, const int* tsel, const float* twt, const float* gam, const float* bet, float* XO, bf16* XB, int gw, int NGW, int lane) {
    int pb[9]; moe_panels(cnt, pb);
    f32x4 gg[4], bb[4];
#pragma unroll
    for (int j = 0; j < 4; ++j) { gg[j] = *(const GAS f32x4*)(gam + 4 * lane + 256 * j); bb[j] = *(const GAS f32x4*)(bet + 4 * lane + 256 * j); }
    for (int m = gw; m < MTOK; m += NGW) {
        const int4 ts = *(const int4*)(tsel + 4 * m); const float2 tw = *(const float2*)(twt + 2 * m);
        int b1 = 0, b2 = 0;
#pragma unroll
        for (int e = 0; e < NEXP; ++e) { b1 = (ts.x == e) ? pb[e] : b1; b2 = (ts.z == e) ? pb[e] : b2; }
        const GAS v2u* y1 = (const GAS v2u*)(YM + (size_t)(b1 * 256 + ts.y) * DM) + lane; const GAS v2u* y2 = (const GAS v2u*)(YM + (size_t)(b2 * 256 + ts.w) * DM) + lane;
        const GAS f32x4* xr = (const GAS f32x4*)(X + (size_t)m * DM) + lane;
        f32x4 v[4]; float s = 0.f;
#pragma unroll
        for (int j = 0; j < 4; ++j) { const v2u p = y1[64 * j], q = y2[64 * j];
            const f32x4 a = (f32x4){bf_lo(p.x), bf_hi(p.x), bf_lo(p.y), bf_hi(p.y)}, b = (f32x4){bf_lo(q.x), bf_hi(q.x), bf_lo(q.y), bf_hi(q.y)};
            v[j] = xr[64 * j] * ALPHA_F + a * tw.x + b * tw.y; s += (v[j].x + v[j].y) + (v[j].z + v[j].w); }
        const float mean = wave_sum(s) * (1.f / DM); float s2 = 0.f;
#pragma unroll
        for (int j = 0; j < 4; ++j) { v[j] = v[j] - mean; s2 += (v[j].x * v[j].x + v[j].y * v[j].y) + (v[j].z * v[j].z + v[j].w * v[j].w); }
        const float rstd = 1.f / sqrtf(wave_sum(s2) * (1.f / DM) + LN_EPS);
        GAS f32x4* xo = (GAS f32x4*)(XO + (size_t)m * DM) + lane;
#pragma unroll
        for (int j = 0; j < 4; ++j) { v[j] = v[j] * rstd * gg[j] + bb[j]; xo[64 * j] = v[j]; }
        if (XB) { GAS v2u* o8 = (GAS v2u*)(XB + (size_t)m * DM) + lane;
#pragma unroll
            for (int j = 0; j < 4; ++j) { v2u w; w.x = pk2(v[j].x, v[j].y); w.y = pk2(v[j].z, v[j].w); o8[64 * j] = w; } }
    }
}

typedef float f32x16_t __attribute__((ext_vector_type(16)));
__device__ __forceinline__ float gelu_tanh_fast(float x) { const float u = 0.7978845608028654f * (x + 0.044715f * x * x * x); const float e = __builtin_amdgcn_exp2f(2.0f * 1.4426950408889634f * u); return x * (1.0f - __builtin_amdgcn_rcpf(1.0f + e)); }
__device__ __forceinline__ int crow(int r, int hi) { return (r & 3) + 8 * (r >> 2) + 4 * hi; }
__device__ __forceinline__ void phase_compress(const bf16* KC, const bf16* VC, const bf16* W1T, const float* pek, const float* pev, const float* wk2, const float* wv2, bf16* KCMP, bf16* VCMPT,
                                               LAS unsigned char* lds, int tid, int wave, int lane) {
    LAS float* P = (LAS float*)lds;
    const int r32 = lane & 31, hi = lane >> 5;
    for (int unit = blockIdx.x; unit < 2 * BATCH * NKV * 4; unit += gridDim.x) {
        const int kv = unit >> 7, bh = (unit >> 2) & 31, rg = unit & 3;
        const bf16* src = (kv ? VC : KC) + ((size_t)bh * SEQ + 16 * (32 * rg + r32)) * HD;
        const float* pe = kv ? pev : pek;
        const bf16* wb = W1T + (size_t)(kv * PHI + r32) * (CMP_BLOCK * HD);
        f32x16_t acc[4];
#pragma unroll
        for (int nb = 0; nb < 4; ++nb)
#pragma unroll
            for (int q = 0; q < 16; ++q) acc[nb][q] = 0.f;
#pragma unroll 2
        for (int s = 0; s < 16; ++s) {
            const int k0 = (wave * 16 + s) * 16 + 8 * hi;
            const v4u araw = *(const GAS v4u*)(src + k0);
            const f32x4 p0 = *(const GAS f32x4*)(pe + k0), p1 = *(const GAS f32x4*)(pe + k0 + 4);
            v4u af; af.x = pk2(bf_lo(araw.x) + p0.x, bf_hi(araw.x) + p0.y); af.y = pk2(bf_lo(araw.y) + p0.z, bf_hi(araw.y) + p0.w);
            af.z = pk2(bf_lo(araw.z) + p1.x, bf_hi(araw.z) + p1.y); af.w = pk2(bf_lo(araw.w) + p1.z, bf_hi(araw.w) + p1.w);
            const bf16x8 a8 = __builtin_bit_cast(bf16x8, af);
#pragma unroll
            for (int nb = 0; nb < 4; ++nb) { const bf16x8 b8 = __builtin_bit_cast(bf16x8, *(const GAS v4u*)(wb + (size_t)nb * 32 * (CMP_BLOCK * HD) + k0));
                acc[nb] = __builtin_amdgcn_mfma_f32_32x32x16_bf16(a8, b8, acc[nb], 0, 0, 0); }
        }
        __syncthreads();
#pragma unroll
        for (int nb = 0; nb < 4; ++nb)
#pragma unroll
            for (int q = 0; q < 16; ++q) P[(wave * 32 + crow(q, hi)) * 128 + nb * 32 + r32] = acc[nb][q];
        __syncthreads();
#pragma unroll
        for (int i = 0; i < 8; ++i) { const int e = tid + NTHR * i; float t = 0.f;
#pragma unroll
            for (int w = 0; w < 8; ++w) t += P[w * 4096 + e];
            P[e] = gelu_tanh_fast(t); }
        __syncthreads();
        { const int r = tid >> 4, dg = (tid & 15) * 4; const float* w2 = (kv ? wv2 : wk2) + dg; f32x4 o = (f32x4){0.f, 0.f, 0.f, 0.f};
#pragma unroll 8
          for (int jj = 0; jj < PHI; ++jj) o += *(const GAS f32x4*)(w2 + jj * HD) * P[r * 128 + jj];
          const int c = 32 * rg + r;
          if (c == NCMP) o = (f32x4){0.f, 0.f, 0.f, 0.f};
          if (kv == 0) { v2u w; w.x = pk2(o.x, o.y); w.y = pk2(o.z, o.w); *(GAS v2u*)(KCMP + ((size_t)bh * 128 + c) * HD + dg) = w; }
          else {
#pragma unroll
              for (int j = 0; j < 4; ++j) VCMPT[((size_t)bh * HD + dg + j) * 128 + c] = (bf16)f2bf(o[j]); } }
    }
    __syncthreads();
}

#ifndef ATT_LEVEL
#define ATT_LEVEL 4
#endif
constexpr int AT_KP = 144, AT_VP = 136;
constexpr int AT_K = 0, AT_V = 2 * 64 * AT_KP, AT_IMP = AT_V + 2 * 64 * AT_VP, AT_SC = AT_IMP + 4 * 2 * 64 * 33 * 4, AT_SEL = AT_SC + 64 * 33 * 4, AT_WSF = AT_SEL + 512, AT_END = AT_WSF + 8 * 64 * 4;
static_assert(AT_END <= RING_BYTES, "attention LDS map");
struct AttTensors { const bf16 *Q, *KC, *KS, *VST, *KW, *VWT, *KCMP, *VCMPT; const float* GATE; bf16* O; };
__device__ __forceinline__ float swap_max(float v) { auto rr = __builtin_amdgcn_permlane32_swap(__float_as_uint(v), __float_as_uint(v), false, false); return fmaxf(__uint_as_float(rr[0]), __uint_as_float(rr[1])); }
__device__ __forceinline__ float swap_add(float v) { auto rr = __builtin_amdgcn_permlane32_swap(__float_as_uint(v), __float_as_uint(v), false, false); return __uint_as_float(rr[0]) + __uint_as_float(rr[1]); }

__device__ __forceinline__ void phase_nsa_attn(const AttTensors T, LAS unsigned char* lds, int tid, int wave, int lane) {
    const int r32 = lane & 31, hi = lane >> 5, g = wave >> 1, th = wave & 1, tl = 32 * th + r32;
    LAS float* wsf = (LAS float*)(lds + AT_WSF) + wave * 64;
    LAS float* IMP = (LAS float*)(lds + AT_IMP); LAS float* SC = (LAS float*)(lds + AT_SC); LAS unsigned* SEL = (LAS unsigned*)(lds + AT_SEL);
    const int ldrow = tid >> 3, ldch = tid & 7;
    const float NEG = -INFINITY;
    const int vcu = (gridDim.x % 8 == 0) ? (int)((blockIdx.x % 8) * (gridDim.x / 8) + blockIdx.x / 8) : (int)blockIdx.x;
    for (int ui = 0; ; ++ui) {
        int bh, qi;
        if (gridDim.x == 256) { if (ui >= 4) break; const int s = vcu & 7; bh = vcu >> 3; qi = (ui == 0) ? s : (ui == 1) ? 31 - s : (ui == 2) ? 8 + s : 23 - s; }
        else { const int u = blockIdx.x + ui * gridDim.x; if (u >= BATCH * NKV * NSLC) break; bh = u >> 5; qi = u & 31; }
        const int b = bh >> 2, hk = bh & 3, t = qi * 64 + tl;
        const size_t mrow = (size_t)b * SEQ + t;
        bf16x8 qf[4];
        { const bf16* qp = T.Q + (((size_t)(b * NH + hk * NG + g) * SEQ + t) * HD + 8 * hi);
#pragma unroll
          for (int s = 0; s < 4; ++s) qf[s] = __builtin_bit_cast(bf16x8, *(const GAS v4u*)(qp + 16 * s)); }
        const float* gp = T.GATE + mrow * 48 + hk * 12 + g * 3;
        const float g0 = gp[0], g1 = gp[1], g2 = gp[2];
        if (tid < 65) SEL[tid] = 0u;
        f32x16_t ot0, ot1;
#define AT_LOADK(dst, kptr) dst = *(const GAS v4u*)((kptr) + (size_t)ldrow * HD + ldch * 8)
#define AT_LOADV(dst, vptr, vstride) dst = *(const GAS v4u*)((vptr) + (size_t)ldrow * (vstride) + ldch * 8)
#define AT_STORE(buf, kreg, vreg) do { *(LAS v4u*)(lds + AT_K + (buf) * 64 * AT_KP + ldrow * AT_KP + ldch * 16) = kreg; \
        LAS v2u* vd_ = (LAS v2u*)(lds + AT_V + (buf) * 64 * AT_VP + ldrow * AT_VP + ldch * 16); vd_[0] = (v2u){vreg.x, vreg.y}; vd_[1] = (v2u){vreg.z, vreg.w}; } while (0)
#define AT_QK(buf, s0, s1) do { const LAS unsigned char* kb_ = lds + AT_K + (buf) * 64 * AT_KP + r32 * AT_KP + 16 * hi; \
        _Pragma("unroll") for (int r_ = 0; r_ < 16; ++r_) { s0[r_] = 0.f; s1[r_] = 0.f; } \
        _Pragma("unroll") for (int s_ = 0; s_ < 4; ++s_) { const bf16x8 k0_ = *(const LAS bf16x8*)(kb_ + 32 * s_), k1_ = *(const LAS bf16x8*)(kb_ + 32 * AT_KP + 32 * s_); \
            s0 = __builtin_amdgcn_mfma_f32_32x32x16_bf16(k0_, qf[s_], s0, 0, 0, 0); s1 = __builtin_amdgcn_mfma_f32_32x32x16_bf16(k1_, qf[s_], s1, 0, 0, 0); } } while (0)
#define AT_PV(buf, p0, p1, o0, o1) do { \
        v4u pa_[4]; \
        pa_[0] = (v4u){cvt_pk_bf16(p0[0], p0[1]), cvt_pk_bf16(p0[2], p0[3]), cvt_pk_bf16(p0[4], p0[5]), cvt_pk_bf16(p0[6], p0[7])}; \
        pa_[1] = (v4u){cvt_pk_bf16(p0[8], p0[9]), cvt_pk_bf16(p0[10], p0[11]), cvt_pk_bf16(p0[12], p0[13]), cvt_pk_bf16(p0[14], p0[15])}; \
        pa_[2] = (v4u){cvt_pk_bf16(p1[0], p1[1]), cvt_pk_bf16(p1[2], p1[3]), cvt_pk_bf16(p1[4], p1[5]), cvt_pk_bf16(p1[6], p1[7])}; \
        pa_[3] = (v4u){cvt_pk_bf16(p1[8], p1[9]), cvt_pk_bf16(p1[10], p1[11]), cvt_pk_bf16(p1[12], p1[13]), cvt_pk_bf16(p1[14], p1[15])}; \
        const LAS unsigned char* vb_ = lds + AT_V + (buf) * 64 * AT_VP + r32 * AT_VP + 8 * hi; \
        _Pragma("unroll") for (int ks_ = 0; ks_ < 4; ++ks_) { \
            const v2u a0_ = *(const LAS v2u*)(vb_ + 32 * ks_), a1_ = *(const LAS v2u*)(vb_ + 32 * ks_ + 16); \
            const v2u b0_ = *(const LAS v2u*)(vb_ + 32 * AT_VP + 32 * ks_), b1_ = *(const LAS v2u*)(vb_ + 32 * AT_VP + 32 * ks_ + 16); \
            const bf16x8 pf_ = __builtin_bit_cast(bf16x8, pa_[ks_]); \
            o0 = __builtin_amdgcn_mfma_f32_32x32x16_bf16(pf_, __builtin_bit_cast(bf16x8, ((v4u){a0_.x, a0_.y, a1_.x, a1_.y})), o0, 0, 0, 0); \
            o1 = __builtin_amdgcn_mfma_f32_32x32x16_bf16(pf_, __builtin_bit_cast(bf16x8, ((v4u){b0_.x, b0_.y, b1_.x, b1_.y})), o1, 0, 0, 0); } } while (0)
#define AT_ROWSCALE_LOAD(f) do { if (hi == 0) wsf[r32] = (f); asm volatile("s_waitcnt lgkmcnt(0)" ::: "memory"); } while (0)
#define AT_ROWF(r_) wsf[crow(r_, hi)]

        { v4u k0, v0, k1, v1;
          const bf16* kc = T.KCMP + (size_t)bh * 128 * HD; const bf16* vc = T.VCMPT + (size_t)bh * HD * 128;
          AT_LOADK(k0, kc); AT_LOADV(v0, vc, 128); AT_LOADK(k1, kc + 64 * HD); AT_LOADV(v1, vc + 64, 128);
          __syncthreads();
          AT_STORE(0, k0, v0); AT_STORE(1, k1, v1);
          __syncthreads(); }
        {
          f32x16_t s0, s1, s2, s3;
          AT_QK(0, s0, s1); AT_QK(1, s2, s3);
          float mx = NEG;
#pragma unroll
          for (int r = 0; r < 16; ++r) { const int c = crow(r, hi);
              s0[r] = (16 * c + 31 <= t) ? s0[r] : NEG; s1[r] = (16 * (c + 32) + 31 <= t) ? s1[r] : NEG; s2[r] = (16 * (c + 64) + 31 <= t) ? s2[r] : NEG; s3[r] = (16 * (c + 96) + 31 <= t) ? s3[r] : NEG;
              mx = fmaxf(fmaxf(mx, s0[r]), fmaxf(fmaxf(s1[r], s2[r]), s3[r])); }
          mx = fmaxf(swap_max(mx), -1e30f);
          float l = 0.f;
#pragma unroll
          for (int r = 0; r < 16; ++r) { s0[r] = __builtin_amdgcn_exp2f(s0[r] - mx); s1[r] = __builtin_amdgcn_exp2f(s1[r] - mx); s2[r] = __builtin_amdgcn_exp2f(s2[r] - mx); s3[r] = __builtin_amdgcn_exp2f(s3[r] - mx);
              l += (s0[r] + s1[r]) + (s2[r] + s3[r]); }
          l = swap_add(l);
          const float inv = 1.0f / fmaxf(l, 1e-30f);
#pragma unroll
          for (int r = 0; r < 16; ++r) { s0[r] *= inv; s1[r] *= inv; s2[r] *= inv; s3[r] *= inv; }
          { LAS float* I0 = IMP + ((g * 2 + 0) * 64 + tl) * 33; LAS float* I1 = IMP + ((g * 2 + 1) * 64 + tl) * 33;
#pragma unroll
            for (int a = 0; a < 4; ++a) { const int n = 2 * a + hi;
                I0[n] = (s0[4 * a] + s0[4 * a + 1]) + (s0[4 * a + 2] + s0[4 * a + 3]); I1[n + 1] = s0[4 * a + 3];
                I0[n + 8] = (s1[4 * a] + s1[4 * a + 1]) + (s1[4 * a + 2] + s1[4 * a + 3]); I1[n + 9] = s1[4 * a + 3];
                I0[n + 16] = (s2[4 * a] + s2[4 * a + 1]) + (s2[4 * a + 2] + s2[4 * a + 3]); I1[n + 17] = s2[4 * a + 3];
                I0[n + 24] = (s3[4 * a] + s3[4 * a + 1]) + (s3[4 * a + 2] + s3[4 * a + 3]); if (n + 25 < 33) I1[n + 25] = s3[4 * a + 3]; } }
          f32x16_t o0, o1;
#pragma unroll
          for (int r = 0; r < 16; ++r) { o0[r] = 0.f; o1[r] = 0.f; }
          AT_PV(0, s0, s1, o0, o1); AT_PV(1, s2, s3, o0, o1);
          AT_ROWSCALE_LOAD(g0);
#pragma unroll
          for (int r = 0; r < 16; ++r) { const float f = AT_ROWF(r); ot0[r] = o0[r] * f; ot1[r] = o1[r] * f; }
        }
        __syncthreads();
        { const int st = tid >> 3, grp = tid & 7;
#pragma unroll
          for (int i = 0; i < 4; ++i) { const int n = 4 * grp + i; float imp = 0.f;
#pragma unroll
              for (int gg = 0; gg < 4; ++gg) { imp += IMP[((gg * 2 + 0) * 64 + st) * 33 + n]; if (n > 0) imp += IMP[((gg * 2 + 1) * 64 + st) * 33 + n]; }
              const bool forced = (n == 0) || (n == qi) || (n == qi - 1);
              SC[st * 33 + n] = forced ? 1e4f : ((n <= qi) ? imp : -1e30f); }
          __syncthreads();
          unsigned bits = 0u;
#pragma unroll
          for (int i = 0; i < 4; ++i) { const int n = 4 * grp + i; const float sn = SC[st * 33 + n]; int rank = 0;
#pragma unroll 8
              for (int m2 = 0; m2 < NSLC; ++m2) { const float sm = SC[st * 33 + m2]; rank += (sm > sn || (sm == sn && m2 < n)) ? 1 : 0; }
              if (rank < TOPN && n <= qi) bits |= 1u << n; }
          if (bits) { __hip_atomic_fetch_or(SEL + st, bits, __ATOMIC_RELAXED, __HIP_MEMORY_SCOPE_WORKGROUP); __hip_atomic_fetch_or(SEL + 64, bits, __ATOMIC_RELAXED, __HIP_MEMORY_SCOPE_WORKGROUP); }
          __syncthreads(); }
        const unsigned selmask = SEL[tl]; const unsigned selunion = SEL[64];
#pragma unroll 1
        for (int mode = 0; mode < (ATT_LEVEL >= 4 ? 2 : (ATT_LEVEL == 3 ? 1 : 0)); ++mode) {
            const bf16* Kb = (mode == 0 ? T.KS : T.KW) + (size_t)bh * SEQ * HD; const bf16* Vb = (mode == 0 ? T.VST : T.VWT) + (size_t)bh * HD * SEQ;
            const int jlo = qi >= 8 ? qi - 8 : 0;
            unsigned todo = (mode == 0) ? selunion : (((2u << qi) - 1u) & ~((1u << jlo) - 1u));
            float m = -1e30f, l = 0.f; f32x16_t o0, o1;
#pragma unroll
            for (int r = 0; r < 16; ++r) { o0[r] = 0.f; o1[r] = 0.f; }
            int cur = 0;
            { const int j = __builtin_ctz(todo); v4u kr, vr; AT_LOADK(kr, Kb + (size_t)j * 64 * HD); AT_LOADV(vr, Vb + j * 64, SEQ); AT_STORE(0, kr, vr); }
            __syncthreads();
#pragma unroll 1
            while (todo) {
                const int j = __builtin_ctz(todo); todo &= todo - 1u;
                v4u kr, vr;
                if (todo) { const int jn = __builtin_ctz(todo); AT_LOADK(kr, Kb + (size_t)jn * 64 * HD); AT_LOADV(vr, Vb + jn * 64, SEQ); }
                const bool mine = (mode == 0) ? ((selmask >> j) & 1u) != 0u : true;
                if (__any(mine)) {
                    f32x16_t s0, s1;
                    AT_QK(cur, s0, s1);
                    float mx = NEG;
                    const bool diag = (j == qi), tail = (mode == 1 && j == qi - 8);
#pragma unroll
                    for (int r = 0; r < 16; ++r) { const int k0 = crow(r, hi), k1 = k0 + 32;
                        bool v0 = mine, v1 = mine;
                        if (diag) { v0 = v0 && (k0 <= tl); v1 = v1 && (k1 <= tl); }
                        if (tail) { v0 = v0 && (k0 > tl); v1 = v1 && (k1 > tl); }
                        s0[r] = v0 ? s0[r] : NEG; s1[r] = v1 ? s1[r] : NEG; mx = fmaxf(mx, fmaxf(s0[r], s1[r])); }
                    mx = swap_max(mx);
                    const float mn = fmaxf(m, mx);
                    if (__any(mn > m)) { const float f = __builtin_amdgcn_exp2f(m - mn); l *= f; m = mn; AT_ROWSCALE_LOAD(f);
#pragma unroll
                        for (int r = 0; r < 16; ++r) { const float fr_ = AT_ROWF(r); o0[r] *= fr_; o1[r] *= fr_; } }
                    float ls = 0.f;
#pragma unroll
                    for (int r = 0; r < 16; ++r) { s0[r] = __builtin_amdgcn_exp2f(s0[r] - m); s1[r] = __builtin_amdgcn_exp2f(s1[r] - m); ls += s0[r] + s1[r]; }
                    l += ls;
                    AT_PV(cur, s0, s1, o0, o1);
                }
                if (todo) AT_STORE(cur ^ 1, kr, vr);
                __syncthreads();
                cur ^= 1;
            }
            l = swap_add(l);
            AT_ROWSCALE_LOAD((mode == 0 ? g1 : g2) / fmaxf(l, 1e-30f));
#pragma unroll
            for (int r = 0; r < 16; ++r) { const float f = AT_ROWF(r); ot0[r] += o0[r] * f; ot1[r] += o1[r] * f; }
        }
        { bf16* ob = T.O + ((size_t)b * SEQ + qi * 64 + 32 * th) * DM + (hk * NG + g) * HD + r32;
#pragma unroll
          for (int r = 0; r < 16; ++r) { bf16* p = ob + (size_t)crow(r, hi) * DM; if (ATT_LEVEL < 2) { ot0[r] = 0.f; ot1[r] = 0.f; } p[0] = (bf16)f2bf(ot0[r]); p[32] = (bf16)f2bf(ot1[r]); } }
#undef AT_LOADK
#undef AT_LOADV
#undef AT_STORE
#undef AT_QK
#undef AT_PV
#undef AT_ROWSCALE_LOAD
#undef AT_ROWF
    }
    __syncthreads();
}

enum { PH_PRO = 0,
       PH0_WIN, PH0_DW, PH0_WOUT, PH0_LN1, PH0_GU, PH0_DOWN, PH0_LN2,
       PH1_WIN, PH1_CONV, PH1_WOUT, PH1_LN1, PH1_PERM, PH1_MGU, PH1_MDOWN, PH1_LN2,
       PH2_WIN, PH2_CMP, PH2_ATT, PH2_WOUT, PH2_LN1, PH2_GU, PH2_DOWN, PH2_LN2,
       PH3_WIN, PH3_DW, PH3_WOUT, PH3_LN1, PH3_PERM, PH3_MGU, PH3_MDOWN, PH3_LN2, PH_END };

#ifndef FAST_PREFIX
#define FAST_PREFIX 2
#endif
#ifndef ONE_LAUNCH
#define ONE_LAUNCH 0
#endif
constexpr int kSubEnd[8] = {PH0_LN1, PH0_LN2, PH1_LN1, PH1_LN2, PH2_LN1, PH2_LN2, PH3_LN1, PH3_LN2};
constexpr int FAST_END = FAST_PREFIX == 0 ? 0 : kSubEnd[FAST_PREFIX - 1] + 1;

struct Ctx { LAS unsigned char* lds; int tid, lane, wave, G, bx, gw, NGW, lo, hi; XcdBarrier bar; };
#define IN(k) (c.lo <= (k) && (k) < c.hi)
#define SEAM(k) do { if (IN(k) && IN((k) + 1)) xcd_barrier(c.bar); } while (0)
#define WSP(T, off) ((T*)(a.ws + (off)))

template <int L, int PH, bool FFN_SIDE> __device__ __forceinline__ void ln_plain(const FArgs& a, const Ctx& c) {
    if (IN(PH)) { const float* g = a.in[FFN_SIDE ? I_LFG : I_LMG] + L * DM; const float* b = a.in[FFN_SIDE ? I_LFB : I_LMB] + L * DM;
        constexpr bool LAST = FFN_SIDE && L == DEPTH - 1;
        phase_ln(WSP(float, WS_X), g, b, LAST ? a.out : WSP(float, WS_X), LAST ? (bf16*)nullptr : WSP(bf16, WS_XBF), c.gw, c.NGW, c.lane); }
    SEAM(PH);
}
template <int L, int PH> __device__ __forceinline__ void ln_router(const FArgs& a, const Ctx& c) {
    constexpr int f = L / 2;
    if (IN(PH)) phase_ln_router(WSP(float, WS_X), a.in[I_LMG] + L * DM, a.in[I_LMB] + L * DM, WSP(float, WS_X), WSP(bf16, WS_XBF), a.in[I_MWR] + (size_t)f * DM * NEXP,
                                (unsigned*)WSP(unsigned, WS_CTL) + CW_MOE + 64 * f, WSP(int, MS_LIST), WSP(int, MS_TSEL), WSP(float, MS_TWT), c.lds, c.gw, c.NGW, c.tid, c.lane);
    SEAM(PH);
}
template <int L, int PH> __device__ __forceinline__ void conformer_mixer(const FArgs& a, const Ctx& c) {
    constexpr int j = L / 3;
    bf16* U = WSP(bf16, A_U); bf16* V = WSP(bf16, A_V); float* X = WSP(float, WS_X);
    if (IN(PH)) { pg8::Gemm g{WSP(bf16, WS_XBF), WSP(bf16, W_CONF_IN + (size_t)j * 4 * MiB), DM, DM, 0}; pg8::StaticOrder S; S.init(MTOK / 256, 8, c.G, c.bx);
        pg8::EpiPair<0> E{U, DM}; pg8::gemm_phase<pg8::EpiPair<0>, pg8::StaticOrder, true, true>(c.lds, g, S, E); } SEAM(PH);
    if (IN(PH + 1)) phase_conf_dw(U, a.in[I_CWDW] + (size_t)j * CONV_K * DM, a.in[I_CBDW] + j * DM, a.in[I_CLNG] + j * DM, a.in[I_CLNB] + j * DM, V, c.lds, c.tid, c.wave, c.lane);
    SEAM(PH + 1);
    if (IN(PH + 2)) { pg8::Gemm g{V, WSP(bf16, W_CONF_OUT + (size_t)j * 2 * MiB), DM, DM, 0}; pg8::StaticOrder S; S.init(MTOK / 256, 4, c.G, c.bx);
        pg8::EpiResid E{L == 0 ? a.in[I_X] : X, X, DM}; pg8::gemm_phase<pg8::EpiResid, pg8::StaticOrder, false, true>(c.lds, g, S, E); } SEAM(PH + 2);
}
template <int L, int PH> __device__ __forceinline__ void sc_mixer(const FArgs& a, const Ctx& c) {
    constexpr int j = L / 3;
    bf16* CH = WSP(bf16, A_CH); bf16* BG = WSP(bf16, A_BG); bf16* YS = WSP(bf16, A_YSC); float* X = WSP(float, WS_X);
    if (IN(PH)) { pg8::Gemm g{WSP(bf16, WS_XBF), WSP(bf16, W_SC_IN), DM, DM, 0}; pg8::StaticOrder S; S.init(MTOK / 256, 12, c.G, c.bx);
        pg8::EpiSC E{CH, BG}; pg8::gemm_phase<pg8::EpiSC, pg8::StaticOrder, true, true>(c.lds, g, S, E); } SEAM(PH);
    if (IN(PH + 1)) phase_shortconv(CH, BG, a.in[I_SWCONV] + (size_t)j * SHORT_K * DM, YS, c.tid);
    SEAM(PH + 1);
    if (IN(PH + 2)) { pg8::Gemm g{YS, WSP(bf16, W_SC_OUT), DM, DM, 0}; pg8::StaticOrder S; S.init(MTOK / 256, 4, c.G, c.bx);
        pg8::EpiResid E{X, X, DM}; pg8::gemm_phase<pg8::EpiResid, pg8::StaticOrder, false, true>(c.lds, g, S, E); } SEAM(PH + 2);
}
template <int L, int PH> __device__ __forceinline__ void dense_ffn(const FArgs& a, const Ctx& c) {
    constexpr int f = L / 2;
    bf16* HB = WSP(bf16, WS_H); float* X = WSP(float, WS_X);
    if (IN(PH)) { pg8::Gemm g{WSP(bf16, WS_XBF), WSP(bf16, W_FFN_GU + (size_t)f * 11 * MiB), DM, DM, 0}; pg8::StaticOrder S; S.init(MTOK / 256, DFF / 128, c.G, c.bx);
        pg8::EpiPair<1> E{HB, DFF}; pg8::gemm_phase<pg8::EpiPair<1>, pg8::StaticOrder, true, true>(c.lds, g, S, E); } SEAM(PH);
    if (IN(PH + 1)) { pg8::Gemm g{HB, WSP(bf16, W_FFN_D + (size_t)f * DM * DFF * 2), DFF, DFF, 0}; pg8::StaticOrder S; S.init(MTOK / 256, 4, c.G, c.bx);
        pg8::EpiResid E{X, X, DM}; pg8::gemm_phase<pg8::EpiResid, pg8::StaticOrder, false, true>(c.lds, g, S, E); } SEAM(PH + 1);
}
template <int L, int PH> __device__ __forceinline__ void moe_ffn(const FArgs& a, const Ctx& c) {
    constexpr int f = L / 2;
    const unsigned* cnt = (const unsigned*)WSP(unsigned, WS_CTL) + CW_MOE + 64 * f;
    bf16* AP = WSP(bf16, A_PERM); bf16* HB = WSP(bf16, WS_H);
    if (IN(PH)) phase_moe_permute(WSP(bf16, WS_XBF), cnt, WSP(int, MS_LIST), AP, c.gw, c.NGW, c.lane);
    SEAM(PH);
    if (IN(PH + 1)) { pg8::Gemm g{AP, WSP(bf16, W_MOE_GU + (size_t)f * 112 * MiB), DM, DM, (size_t)14 * MiB}; pg8::GroupedOrder S; moe_panels(cnt, S.pb); S.init(S.pb[NEXP], DFFE / 128, c.G, c.bx);
        pg8::EpiPair<1> E{HB, DFFE}; pg8::gemm_phase<pg8::EpiPair<1>, pg8::GroupedOrder, true, true>(c.lds, g, S, E); } SEAM(PH + 1);
    if (IN(PH + 2)) { pg8::Gemm g{HB, WSP(bf16, W_MOE_D + (size_t)f * 56 * MiB), DFFE, DFFE, (size_t)7 * MiB}; pg8::GroupedOrder S; moe_panels(cnt, S.pb); S.init(S.pb[NEXP], 4, c.G, c.bx);
        pg8::EpiBf16 E{AP, DM, 1.0f}; pg8::gemm_phase<pg8::EpiBf16, pg8::GroupedOrder, true, true>(c.lds, g, S, E); } SEAM(PH + 2);
    if (IN(PH + 3)) { constexpr bool LAST = L == DEPTH - 1;
        phase_ln_moe(WSP(float, WS_X), AP, cnt, WSP(int, MS_TSEL), WSP(float, MS_TWT), a.in[I_LFG] + L * DM, a.in[I_LFB] + L * DM, LAST ? a.out : WSP(float, WS_X), LAST ? (bf16*)nullptr : WSP(bf16, WS_XBF), c.gw, c.NGW, c.lane); }
    SEAM(PH + 3);
}

template <int L, int PH> __device__ __forceinline__ void nsa_mixer(const FArgs& a, const Ctx& c) {
    float* X = WSP(float, WS_X);
    if (IN(PH)) { pg8::Gemm g{WSP(bf16, WS_XBF), WSP(bf16, W_NSA_IN), DM, DM, 0}; pg8::StaticOrder S; S.init(MTOK / 256, 11, c.G, c.bx);
        pg8::EpiNSA E{WSP(bf16, A_Q), WSP(bf16, A_KC), WSP(float, A_GATE)}; pg8::gemm_phase<pg8::EpiNSA, pg8::StaticOrder, true, true>(c.lds, g, S, E); } SEAM(PH);
    if (IN(PH + 1)) phase_compress(WSP(bf16, A_KC), WSP(bf16, A_VCT), WSP(bf16, W_CMP1), a.in[I_NPEK], a.in[I_NPEV], a.in[I_NWK2], a.in[I_NWV2], WSP(bf16, A_KCMP), WSP(bf16, A_VCMPT), c.lds, c.tid, c.wave, c.lane);
    SEAM(PH + 1);
    if (IN(PH + 2)) { AttTensors T{WSP(bf16, A_Q), WSP(bf16, A_KC), WSP(bf16, A_KS), WSP(bf16, A_VST), WSP(bf16, A_KW), WSP(bf16, A_VWT), WSP(bf16, A_KCMP), WSP(bf16, A_VCMPT), WSP(float, A_GATE), WSP(bf16, A_O)};
        phase_nsa_attn(T, c.lds, c.tid, c.wave, c.lane); }
    SEAM(PH + 2);
    if (IN(PH + 3)) { pg8::Gemm g{WSP(bf16, A_O), WSP(bf16, W_NSA_OUT), DM, DM, 0}; pg8::StaticOrder S; S.init(MTOK / 256, 4, c.G, c.bx);
        pg8::EpiResid E{X, X, DM}; pg8::gemm_phase<pg8::EpiResid, pg8::StaticOrder, false, true>(c.lds, g, S, E); } SEAM(PH + 3);
}

__global__ void __launch_bounds__(NTHR, 2) mega(FArgs a) {
    extern __shared__ __attribute__((aligned(16))) unsigned char lds_raw[];
    Ctx c; c.lds = (LAS unsigned char*)lds_raw;
    c.tid = threadIdx.x; c.lane = c.tid & 63; c.wave = __builtin_amdgcn_readfirstlane(c.tid >> 6);
    c.G = gridDim.x; c.bx = blockIdx.x; const int vcu = (c.G % 8 == 0) ? (c.bx % 8) * (c.G / 8) + c.bx / 8 : c.bx;
    c.gw = vcu * NWAVES + c.wave; c.NGW = c.G * NWAVES; c.lo = a.ph_lo; c.hi = a.ph_hi;
    for (int u = c.tid; u < (LDS_BYTES - LDSCTL_OFF) / 4; u += NTHR) ((LAS unsigned*)(c.lds + LDSCTL_OFF))[u] = 0u;
    __syncthreads();
    c.bar = xcd_barrier_post((unsigned*)(a.ws + WS_CTL) + CW_BAR, (volatile LAS unsigned*)(c.lds + LDSCTL_OFF + 32));

    if (IN(PH_PRO)) phase_prologue(a, c.lds, c.gw, c.NGW, c.wave, c.lane);
    SEAM(PH_PRO);
    conformer_mixer<0, PH0_WIN>(a, c); ln_plain<0, PH0_LN1, false>(a, c); dense_ffn<0, PH0_GU>(a, c); ln_plain<0, PH0_LN2, true>(a, c);
#if FAST_PREFIX > 2
    sc_mixer<1, PH1_WIN>(a, c); ln_router<1, PH1_LN1>(a, c); moe_ffn<1, PH1_PERM>(a, c);
#endif
#if FAST_PREFIX > 4
    nsa_mixer<2, PH2_WIN>(a, c); ln_plain<2, PH2_LN1, false>(a, c); dense_ffn<2, PH2_GU>(a, c); ln_plain<2, PH2_LN2, true>(a, c);
#endif
#if FAST_PREFIX > 6
    conformer_mixer<3, PH3_WIN>(a, c); ln_router<3, PH3_LN1>(a, c); moe_ffn<3, PH3_PERM>(a, c);
#endif
}
#undef IN
#undef SEAM
#undef WSP


#ifndef DEBUG_MODE
#define DEBUG_MODE 0
#endif
__global__ void dbg_sqdiff(const float* a, const float* b, size_t n, float* acc2) {
    float d = 0.f, r = 0.f;
    for (size_t i = (size_t)blockIdx.x * blockDim.x + threadIdx.x; i < n; i += (size_t)gridDim.x * blockDim.x) { const float x = a[i], y = b[i]; const float t = x - y; d += (t == t) ? t * t : 1e6f; r += y * y; }
    d = wave_sum(d); r = wave_sum(r);
    if ((threadIdx.x & 63) == 0) { atomicAdd(acc2, d); atomicAdd(acc2 + 1, r); }
}
__global__ void dbg_scale(float* out, size_t n, const float* acc2) {
    float e = sqrtf(acc2[0] / fmaxf(acc2[1], 1e-30f)); e = e < 10.f ? e : 10.f;
    for (size_t i = (size_t)blockIdx.x * blockDim.x + threadIdx.x; i < n; i += (size_t)gridDim.x * blockDim.x) out[i] *= (1.0f + e);
}

static void gemm(hipStream_t st, const float* A, int lda, const int* gather, const int* mcount, int M, const float* W, int ldw, int N, int K, float* C, int ldc) {
    hipLaunchKernelGGL(ngemm, dim3((N + 127) / 128, (M + 127) / 128), dim3(256), 0, st, A, lda, gather, mcount, M, W, ldw, N, K, C, ldc);
}
struct NaiveBufs { float *BA, *BB, *BC, *BD; int *cnt, *list, *tsel; float *twt, *cmp; };
static void naive_sublayer(hipStream_t stream, const float* const* in, int s, const float* x, float* xo, const NaiveBufs& nb) {
    const int i = s / 2, kind = i % 3, j = i / 3, f = i / 2, EW = 256;
    constexpr int CR = MTOK / 2, CB = BATCH / 2;
    float *BA = nb.BA, *BB = nb.BB, *BC = nb.BC, *BD = nb.BD;
    for (int c = 0; c < 2; ++c) {
        const float* xc = x + (size_t)c * CR * DM; float* xoc = xo + (size_t)c * CR * DM;
        if ((s & 1) == 0) {
            if (kind == 0) {
                gemm(stream, xc, DM, nullptr, nullptr, CR, in[I_CWIN] + (size_t)j * DM * 2 * DM, 2 * DM, 2 * DM, DM, BA, 2 * DM);
                hipLaunchKernelGGL(n_glu, dim3(CR * DM / EW), dim3(EW), 0, stream, BA, BB, CR);
                hipLaunchKernelGGL(n_conf_dw, dim3(CR), dim3(256), 0, stream, BB, in[I_CWDW] + (size_t)j * CONV_K * DM, in[I_CBDW] + j * DM, in[I_CLNG] + j * DM, in[I_CLNB] + j * DM, BD);
                gemm(stream, BD, DM, nullptr, nullptr, CR, in[I_CWOUT] + (size_t)j * DM * DM, DM, DM, DM, BC, DM);
            } else if (kind == 1) {
                gemm(stream, xc, DM, nullptr, nullptr, CR, in[I_SWIN] + (size_t)j * DM * 3 * DM, 3 * DM, 3 * DM, DM, BA, 3 * DM);
                hipLaunchKernelGGL(n_shortconv, dim3(CR * DM / EW), dim3(EW), 0, stream, BA, in[I_SWCONV] + (size_t)j * SHORT_K * DM, BD, CR);
                gemm(stream, BD, DM, nullptr, nullptr, CR, in[I_SWOUT] + (size_t)j * DM * DM, DM, DM, DM, BC, DM);
            } else {
                gemm(stream, xc, DM, nullptr, nullptr, CR, in[I_NWIN] + (size_t)j * DM * NSA_COLS, NSA_COLS, NSA_COLS, DM, BA, NSA_COLS);
                hipLaunchKernelGGL(n_compress, dim3(NCMP, CB * NKV, 2), dim3(128), 0, stream, BA, in[I_NPEK] + j * CMP_BLOCK * HD, in[I_NPEV] + j * CMP_BLOCK * HD,
                                   in[I_NWK1] + (size_t)j * CMP_BLOCK * HD * PHI, in[I_NWK2] + j * PHI * HD, in[I_NWV1] + (size_t)j * CMP_BLOCK * HD * PHI, in[I_NWV2] + j * PHI * HD, nb.cmp);
                hipLaunchKernelGGL(n_nsa_attn, dim3(SEQ / 64, CB * NKV), dim3(256), 0, stream, BA, nb.cmp, BD);
                gemm(stream, BD, DM, nullptr, nullptr, CR, in[I_NWOUT] + (size_t)j * DM * DM, DM, DM, DM, BC, DM);
            }
            hipLaunchKernelGGL(n_ln_res, dim3(CR), dim3(256), 0, stream, xc, BC, in[I_LMG] + i * DM, in[I_LMB] + i * DM, xoc);
        } else {
            if (i % 2 == 0) {
                gemm(stream, xc, DM, nullptr, nullptr, CR, in[I_FWG] + (size_t)f * DM * DFF, DFF, DFF, DM, BA, DFF);
                gemm(stream, xc, DM, nullptr, nullptr, CR, in[I_FWU] + (size_t)f * DM * DFF, DFF, DFF, DM, BB, DFF);
                hipLaunchKernelGGL(n_swiglu, dim3((unsigned)(((size_t)CR * DFF + EW - 1) / EW)), dim3(EW), 0, stream, BA, BB, BA, (const int*)nullptr, CR, DFF);
                gemm(stream, BA, DFF, nullptr, nullptr, CR, in[I_FWD] + (size_t)f * DFF * DM, DM, DM, DFF, BC, DM);
            } else {
                (void)hipMemsetAsync(nb.cnt, 0, 256, stream);
                (void)hipMemsetAsync(BC, 0, (size_t)CR * DM * 4, stream);
                hipLaunchKernelGGL(n_router, dim3(CR / 4), dim3(256), 0, stream, xc, in[I_MWR] + (size_t)f * DM * NEXP, nb.cnt, nb.list, nb.tsel, nb.twt);
                for (int e = 0; e < NEXP; ++e) {
                    const size_t wo = ((size_t)f * NEXP + e) * DM * DFFE;
                    gemm(stream, xc, DM, nb.list + e * MOE_CAP, nb.cnt + e, MOE_CAP, in[I_MWG] + wo, DFFE, DFFE, DM, BA, DFFE);
                    gemm(stream, xc, DM, nb.list + e * MOE_CAP, nb.cnt + e, MOE_CAP, in[I_MWU] + wo, DFFE, DFFE, DM, BB, DFFE);
                    hipLaunchKernelGGL(n_swiglu, dim3((unsigned)(((size_t)MOE_CAP * DFFE + EW - 1) / EW)), dim3(EW), 0, stream, BA, BB, BA, (const int*)(nb.cnt + e), MOE_CAP, DFFE);
                    gemm(stream, BA, DFFE, nullptr, nb.cnt + e, MOE_CAP, in[I_MWD] + wo, DM, DM, DFFE, BD, DM);
                    hipLaunchKernelGGL(n_moe_scatter, dim3(MOE_CAP), dim3(256), 0, stream, BD, nb.cnt, nb.list, nb.tsel, nb.twt, e, BC);
                }
            }
            hipLaunchKernelGGL(n_ln_res, dim3(CR), dim3(256), 0, stream, xc, BC, in[I_LFG] + i * DM, in[I_LFB] + i * DM, xoc);
        }
    }
}

extern "C" void kernel_launch(void* const* d_in, const int* in_sizes, int n_in, void* d_out, int out_size, void* d_ws, size_t ws_size, hipStream_t stream) {
    (void)in_sizes; (void)out_size;
    static int grid = 0;
    if (grid == 0) {
        if (n_in != 29 || ws_size < WS_END) { fprintf(stderr, "kernel_launch: unexpected n_in %d / ws_size %zu (need %zu)\n", n_in, ws_size, (size_t)WS_END); grid = -1; return; }
        int dev = 0, cus = 0, per_cu = 0;
        if (hipGetDevice(&dev) != hipSuccess || hipDeviceGetAttribute(&cus, hipDeviceAttributeMultiprocessorCount, dev) != hipSuccess) { grid = -1; return; }
        if (hipFuncSetAttribute((const void*)mega, hipFuncAttributeMaxDynamicSharedMemorySize, LDS_BYTES) != hipSuccess) { fprintf(stderr, "kernel_launch: hipFuncSetAttribute failed\n"); grid = -1; return; }
        if (hipOccupancyMaxActiveBlocksPerMultiprocessor(&per_cu, (const void*)mega, NTHR, LDS_BYTES) != hipSuccess || per_cu < 1) { fprintf(stderr, "kernel_launch: occupancy query says %d\n", per_cu); }
        (void)hipGetLastError();
        grid = cus;
    }
    if (grid < 0) return;
    unsigned char* ws = (unsigned char*)d_ws;
    const float* in[29]; for (int i = 0; i < 29; ++i) in[i] = (const float*)d_in[i];
    auto run_fast = [&]() {
        (void)hipMemsetAsync(ws + WS_CTL, 0, CTL_ZERO_BYTES, stream);
        FArgs a{}; for (int i = 0; i < 29; ++i) a.in[i] = in[i];
        a.out = (float*)d_out; a.ws = ws;
        if (ONE_LAUNCH) { a.ph_lo = 0; a.ph_hi = FAST_END; hipLaunchKernelGGL(mega, dim3(grid), dim3(NTHR), LDS_BYTES, stream, a); }
        else for (int p = 0; p < FAST_END; ++p) { a.ph_lo = p; a.ph_hi = p + 1; hipLaunchKernelGGL(mega, dim3(grid), dim3(NTHR), LDS_BYTES, stream, a); }
    };
    NaiveBufs nb; unsigned char* nbase = ws + WS_ACT;
    nb.BA = (float*)nbase; nb.BB = (float*)(nbase + 96 * MiB); nb.BC = (float*)(nbase + 192 * MiB); nb.BD = (float*)(nbase + 224 * MiB);
    unsigned char* sm = nbase + 256 * MiB; nb.cnt = (int*)sm; nb.list = nb.cnt + 64; nb.tsel = nb.list + NEXP * MOE_CAP; nb.twt = (float*)(nb.tsel + (MTOK / 2) * 4); nb.cmp = (float*)(sm + 2 * MiB);
    float* X = (float*)(ws + WS_X);
#if DEBUG_MODE
    static_assert(FAST_PREFIX >= 1 && FAST_PREFIX <= 6 && !ONE_LAUNCH, "debug builds compare a fast prefix that leaves its result in X");
    float* XF1 = (float*)(ws + W_MOE_GU + 112 * MiB);
    float* acc2 = (float*)(sm + 1 * MiB);
    run_fast();
    (void)hipMemcpyAsync(XF1, X, (size_t)MTOK * DM * 4, hipMemcpyDeviceToDevice, stream);
    (void)hipMemsetAsync(acc2, 0, 64, stream);
    if (DEBUG_MODE == 2) { run_fast(); hipLaunchKernelGGL(dbg_sqdiff, dim3(2048), dim3(256), 0, stream, (const float*)X, (const float*)XF1, (size_t)MTOK * DM, acc2); }
    { const float* x = in[I_X];
      for (int s = 0; s < 8; ++s) { float* xo = (s == 7) ? (float*)d_out : X; naive_sublayer(stream, in, s, x, xo, nb); x = xo;
          if (DEBUG_MODE == 1 && s == FAST_PREFIX - 1) hipLaunchKernelGGL(dbg_sqdiff, dim3(2048), dim3(256), 0, stream, (const float*)XF1, (const float*)X, (size_t)MTOK * DM, acc2); } }
    hipLaunchKernelGGL(dbg_scale, dim3(2048), dim3(256), 0, stream, (float*)d_out, (size_t)MTOK * DM, (const float*)acc2);
#else
    if (FAST_END > 0) run_fast();
    if (FAST_PREFIX < 8) {
        const float* x = FAST_PREFIX == 0 ? in[I_X] : (const float*)X;
        for (int s = FAST_PREFIX; s < 8; ++s) { float* xo = (s == 7) ? (float*)d_out : X; naive_sublayer(stream, in, s, x, xo, nb); x = xo; }
    }
#endif
}
```

```cpp
#define FAST_PREFIX 8
#define ONE_LAUNCH 1
#include <hip/hip_runtime.h>
#include <cstdio>
#include <cstdint>

constexpr int BATCH = 8, SEQ = 2048, DM = 1024, MTOK = BATCH * SEQ, DEPTH = 4;
constexpr int CONV_K = 31, SHORT_K = 3;
constexpr int NH = 16, NKV = 4, NG = 4, HD = 64;
constexpr int CMP_BLOCK = 32, CMP_STRIDE = 16, NCMP = (SEQ - CMP_BLOCK) / CMP_STRIDE + 1;
constexpr int SLC_BLOCK = 64, NSLC = SEQ / SLC_BLOCK, TOPN = 16, WINDOW = 512, PHI = 128;
constexpr int NSA_COLS = NH * HD + 6 * NKV * HD + 3 * NH;
constexpr int DFF = 2816, NEXP = 8, DFFE = 3584;
constexpr float LN_EPS = 1e-5f;
#define ALPHA_F 1.681792830507429f

typedef float f32x16 __attribute__((ext_vector_type(16)));

__device__ __forceinline__ float wave_sum(float v) {
#pragma unroll
    for (int o = 1; o < 64; o <<= 1) v += __shfl_xor(v, o);
    return v;
}
__device__ __forceinline__ float block_sum256(float v, float* red) {
    v = wave_sum(v);
    __syncthreads();
    if ((threadIdx.x & 63) == 0) red[threadIdx.x >> 6] = v;
    __syncthreads();
    return (red[0] + red[1]) + (red[2] + red[3]);
}
__device__ __forceinline__ float sigmoidf_(float x) { return 1.0f / (1.0f + expf(-x)); }
__device__ __forceinline__ float siluf_(float x) { return x / (1.0f + expf(-x)); }
__device__ __forceinline__ float gelu_tanh(float x) { return 0.5f * x * (1.0f + tanhf(0.7978845608028654f * (x + 0.044715f * x * x * x))); }

__global__ __launch_bounds__(256) void ngemm(const float* __restrict__ A, int lda, const int* __restrict__ gather, const int* __restrict__ mcount, int M,
                                             const float* __restrict__ W, int ldw, int N, int K, float* __restrict__ C, int ldc) {
    __shared__ float As[128][17];
    __shared__ float Bs[16][132];
    if (mcount) { const int mc = *mcount; M = mc < M ? mc : M; }
    const int bm = blockIdx.y * 128, bn = blockIdx.x * 128;
    if (bm >= M) return;
    const int tid = threadIdx.x, lane = tid & 63, w = tid >> 6, wr = w >> 1, wc = w & 1;
    const int ar = tid >> 1, ak = (tid & 1) * 8;
    const int arow = bm + ar; const bool aok = arow < M;
    const int asrc = aok ? (gather ? gather[arow] : arow) : 0;
    const float* ap = A + (size_t)asrc * lda + ak;
    const int bk = tid >> 4, bc = (tid & 15) * 8;
    const bool bok = (bn + bc + 8) <= N;
    const float* bp = W + (size_t)bk * ldw + bn + bc;
    f32x16 acc[2][2];
#pragma unroll
    for (int i = 0; i < 2; ++i)
#pragma unroll
        for (int j = 0; j < 2; ++j)
#pragma unroll
            for (int r = 0; r < 16; ++r) acc[i][j][r] = 0.f;
    for (int k0 = 0; k0 < K; k0 += 16) {
        float4 a0 = make_float4(0.f, 0.f, 0.f, 0.f), a1 = a0, b0 = a0, b1 = a0;
        if (aok) { a0 = *(const float4*)(ap + k0); a1 = *(const float4*)(ap + k0 + 4); }
        if (bok) { b0 = *(const float4*)(bp + (size_t)k0 * ldw); b1 = *(const float4*)(bp + (size_t)k0 * ldw + 4); }
        __syncthreads();
        As[ar][ak + 0] = a0.x; As[ar][ak + 1] = a0.y; As[ar][ak + 2] = a0.z; As[ar][ak + 3] = a0.w;
        As[ar][ak + 4] = a1.x; As[ar][ak + 5] = a1.y; As[ar][ak + 6] = a1.z; As[ar][ak + 7] = a1.w;
        *(float4*)&Bs[bk][bc] = b0; *(float4*)&Bs[bk][bc + 4] = b1;
        __syncthreads();
#pragma unroll
        for (int kk = 0; kk < 16; kk += 2) {
            float a[2], b[2];
#pragma unroll
            for (int i = 0; i < 2; ++i) a[i] = As[wr * 64 + i * 32 + (lane & 31)][kk + (lane >> 5)];
#pragma unroll
            for (int j = 0; j < 2; ++j) b[j] = Bs[kk + (lane >> 5)][wc * 64 + j * 32 + (lane & 31)];
#pragma unroll
            for (int i = 0; i < 2; ++i)
#pragma unroll
                for (int j = 0; j < 2; ++j) acc[i][j] = __builtin_amdgcn_mfma_f32_32x32x2f32(a[i], b[j], acc[i][j], 0, 0, 0);
        }
    }
#pragma unroll
    for (int i = 0; i < 2; ++i)
#pragma unroll
        for (int j = 0; j < 2; ++j)
#pragma unroll
            for (int r = 0; r < 16; ++r) {
                const int row = bm + wr * 64 + i * 32 + (r & 3) + 8 * (r >> 2) + 4 * (lane >> 5);
                const int col = bn + wc * 64 + j * 32 + (lane & 31);
                if (row < M && col < N) C[(size_t)row * ldc + col] = acc[i][j][r];
            }
}

__global__ void n_glu(const float* __restrict__ t, float* __restrict__ u, int rows) {
    const size_t i = (size_t)blockIdx.x * blockDim.x + threadIdx.x; if (i >= (size_t)rows * DM) return;
    const size_t m = i / DM; const int c = (int)(i % DM);
    u[i] = t[m * 2 * DM + c] * sigmoidf_(t[m * 2 * DM + DM + c]);
}
__global__ __launch_bounds__(256) void n_conf_dw(const float* __restrict__ u, const float* __restrict__ wdw, const float* __restrict__ bdw, const float* __restrict__ g, const float* __restrict__ bb, float* __restrict__ out) {
    __shared__ float red[8];
    const int m = blockIdx.x, t = m % SEQ, c = threadIdx.x * 4;
    float4 acc = *(const float4*)(bdw + c);
    for (int k = 0; k < CONV_K; ++k) { const int tt = t - (CONV_K - 1) + k; if (tt < 0) continue;
        const float4 w = *(const float4*)(wdw + k * DM + c), x = *(const float4*)(u + (size_t)(m - t + tt) * DM + c);
        acc.x += w.x * x.x; acc.y += w.y * x.y; acc.z += w.z * x.z; acc.w += w.w * x.w; }
    const float mean = block_sum256((acc.x + acc.y) + (acc.z + acc.w), red) * (1.0f / DM);
    const float dx = acc.x - mean, dy = acc.y - mean, dz = acc.z - mean, dw = acc.w - mean;
    const float var = block_sum256((dx * dx + dy * dy) + (dz * dz + dw * dw), red) * (1.0f / DM);
    const float rstd = 1.0f / sqrtf(var + LN_EPS);
    const float4 gg = *(const float4*)(g + c), b4 = *(const float4*)(bb + c);
    float4 o; o.x = siluf_(dx * rstd * gg.x + b4.x); o.y = siluf_(dy * rstd * gg.y + b4.y); o.z = siluf_(dz * rstd * gg.z + b4.z); o.w = siluf_(dw * rstd * gg.w + b4.w);
    *(float4*)(out + (size_t)m * DM + c) = o;
}
__global__ __launch_bounds__(256) void n_ln_res(const float* __restrict__ x, const float* __restrict__ mix, const float* __restrict__ g, const float* __restrict__ bb, float* __restrict__ xo) {
    __shared__ float red[8];
    const int m = blockIdx.x, c = threadIdx.x * 4;
    const float4 xv = *(const float4*)(x + (size_t)m * DM + c), mv = *(const float4*)(mix + (size_t)m * DM + c);
    float4 v; v.x = ALPHA_F * xv.x + mv.x; v.y = ALPHA_F * xv.y + mv.y; v.z = ALPHA_F * xv.z + mv.z; v.w = ALPHA_F * xv.w + mv.w;
    const float mean = block_sum256((v.x + v.y) + (v.z + v.w), red) * (1.0f / DM);
    const float dx = v.x - mean, dy = v.y - mean, dz = v.z - mean, dw = v.w - mean;
    const float var = block_sum256((dx * dx + dy * dy) + (dz * dz + dw * dw), red) * (1.0f / DM);
    const float rstd = 1.0f / sqrtf(var + LN_EPS);
    const float4 gg = *(const float4*)(g + c), b4 = *(const float4*)(bb + c);
    float4 o; o.x = dx * rstd * gg.x + b4.x; o.y = dy * rstd * gg.y + b4.y; o.z = dz * rstd * gg.z + b4.z; o.w = dw * rstd * gg.w + b4.w;
    *(float4*)(xo + (size_t)m * DM + c) = o;
}
__global__ void n_swiglu(const float* __restrict__ g, const float* __restrict__ u, float* __restrict__ h, const int* __restrict__ mcount, int rows, int n) {
    if (mcount) { const int mc = *mcount; rows = mc < rows ? mc : rows; }
    const size_t i = (size_t)blockIdx.x * blockDim.x + threadIdx.x; if (i >= (size_t)rows * n) return;
    h[i] = siluf_(g[i]) * u[i];
}
__global__ void n_shortconv(const float* __restrict__ t, const float* __restrict__ w, float* __restrict__ y, int rows) {
    const size_t i = (size_t)blockIdx.x * blockDim.x + threadIdx.x; if (i >= (size_t)rows * DM) return;
    const int m = (int)(i / DM), c = (int)(i % DM), tt = m % SEQ;
    float acc = 0.f;
    for (int k = 0; k < SHORT_K; ++k) { const int ts = tt - (SHORT_K - 1) + k; if (ts < 0) continue;
        const float* r = t + (size_t)(m - tt + ts) * 3 * DM; acc += w[k * DM + c] * (r[DM + c] * r[2 * DM + c]); }
    y[i] = t[(size_t)m * 3 * DM + c] * acc;
}

__global__ __launch_bounds__(128) void n_compress(const float* __restrict__ T, const float* __restrict__ pek, const float* __restrict__ pev, const float* __restrict__ wk1, const float* __restrict__ wk2,
                                                  const float* __restrict__ wv1, const float* __restrict__ wv2, float* __restrict__ cmp) {
    __shared__ float in[CMP_BLOCK * HD]; __shared__ float hid[PHI];
    const int c = blockIdx.x, bh = blockIdx.y, kv = blockIdx.z, b = bh / NKV, hk = bh % NKV, tid = threadIdx.x;
    const float* pe = kv ? pev : pek; const float* w1 = kv ? wv1 : wk1; const float* w2 = kv ? wv2 : wk2;
    const int col0 = NH * HD + kv * NKV * HD + hk * HD;
    for (int i = tid; i < CMP_BLOCK * HD; i += 128) { const int j = i / HD, d = i % HD; in[i] = T[(size_t)(b * SEQ + c * CMP_STRIDE + j) * NSA_COLS + col0 + d] + pe[i]; }
    __syncthreads();
    float a = 0.f;
    for (int i = 0; i < CMP_BLOCK * HD; ++i) a += in[i] * w1[(size_t)i * PHI + tid];
    hid[tid] = gelu_tanh(a);
    __syncthreads();
    if (tid < HD) { float o = 0.f; for (int j = 0; j < PHI; ++j) o += hid[j] * w2[j * HD + tid]; cmp[((size_t)(kv * gridDim.y + bh) * 128 + c) * HD + tid] = o; }
}

#define NATT_TILE 32
__device__ __forceinline__ void natt_load_tile(float (*Kt)[HD], float (*Vt)[HD], const float* kp, const float* vp, size_t stride, int nrows) {
    __syncthreads();
    for (int i = threadIdx.x; i < NATT_TILE * HD / 4; i += 256) { const int r = i / (HD / 4), d4 = (i % (HD / 4)) * 4;
        float4 kx = make_float4(0.f, 0.f, 0.f, 0.f), vx = kx;
        if (r < nrows) { kx = *(const float4*)(kp + (size_t)r * stride + d4); vx = *(const float4*)(vp + (size_t)r * stride + d4); }
        *(float4*)&Kt[r][d4] = kx; *(float4*)&Vt[r][d4] = vx; }
    __syncthreads();
}
__global__ __launch_bounds__(256) void n_nsa_attn(const float* __restrict__ T, const float* __restrict__ cmp, float* __restrict__ O) {
    __shared__ float Kt[NATT_TILE][HD]; __shared__ float Vt[NATT_TILE][HD];
    __shared__ float impS[64][NG][NSLC]; __shared__ float scS[64][NSLC + 1];
    const int qi = blockIdx.x, bh = blockIdx.y, b = bh / NKV, hk = bh % NKV, tid = threadIdx.x, g = tid >> 6, tl = tid & 63, t = qi * 64 + tl;
    const size_t mrow = (size_t)b * SEQ + t; const int hcol = (hk * NG + g) * HD;
    float q[HD];
#pragma unroll
    for (int d = 0; d < HD; ++d) q[d] = T[mrow * NSA_COLS + hcol + d] * 0.125f;
    const float* gp = T + mrow * NSA_COLS + (NH * HD + 6 * NKV * HD) + hk * 12 + g * 3;
    const float g0 = sigmoidf_(gp[0]), g1 = sigmoidf_(gp[1]), g2 = sigmoidf_(gp[2]);
    float acc[HD]; float mx, l;
#define NATT_RESET() do { mx = -1e30f; l = 0.f; _Pragma("unroll") for (int d = 0; d < HD; ++d) acc[d] = 0.f; } while (0)
#define NATT_DOT(s, kk) do { s = 0.f; _Pragma("unroll") for (int d = 0; d < HD; d += 4) { const float4 kx = *(const float4*)&Kt[kk][d]; s += q[d] * kx.x + q[d + 1] * kx.y + q[d + 2] * kx.z + q[d + 3] * kx.w; } } while (0)
#define NATT_UPD(s, kk) do { const float mn = fmaxf(mx, s), sc = expf(mx - mn), p = expf(s - mn); l = l * sc + p; mx = mn; \
        _Pragma("unroll") for (int d = 0; d < HD; d += 4) { const float4 vx = *(const float4*)&Vt[kk][d]; acc[d] = acc[d] * sc + p * vx.x; acc[d + 1] = acc[d + 1] * sc + p * vx.y; acc[d + 2] = acc[d + 2] * sc + p * vx.z; acc[d + 3] = acc[d + 3] * sc + p * vx.w; } } while (0)
    float* op = O + mrow * DM + hcol;
    const float* kc = cmp + (size_t)bh * 128 * HD; const float* vc = cmp + (size_t)(gridDim.y + bh) * 128 * HD;
    NATT_RESET();
    for (int c0 = 0; c0 < NCMP; c0 += NATT_TILE) {
        natt_load_tile(Kt, Vt, kc + (size_t)c0 * HD, vc + (size_t)c0 * HD, HD, NCMP - c0 < NATT_TILE ? NCMP - c0 : NATT_TILE);
        for (int kk = 0; kk < NATT_TILE; ++kk) { const int c = c0 + kk; if (c < NCMP && c * CMP_STRIDE + CMP_BLOCK - 1 <= t) { float s; NATT_DOT(s, kk); NATT_UPD(s, kk); } }
    }
    { const float inv = g0 / fmaxf(l, 1e-30f);
#pragma unroll
      for (int d = 0; d < HD; d += 4) *(float4*)(op + d) = make_float4(acc[d] * inv, acc[d + 1] * inv, acc[d + 2] * inv, acc[d + 3] * inv); }
    { const float invl = 1.0f / fmaxf(l, 1e-30f); float cur = 0.f, nxt = 0.f;
      for (int c0 = 0; c0 < 128; c0 += NATT_TILE) {
        natt_load_tile(Kt, Vt, kc + (size_t)c0 * HD, vc + (size_t)c0 * HD, HD, NCMP - c0 < NATT_TILE ? NCMP - c0 : NATT_TILE);
        for (int kk = 0; kk < NATT_TILE; ++kk) { const int c = c0 + kk; float p = 0.f;
            if (c < NCMP && c * CMP_STRIDE + CMP_BLOCK - 1 <= t) { float s; NATT_DOT(s, kk); p = expf(s - mx) * invl; }
            cur += p; if ((c & 3) == 3) { nxt = p; impS[tl][g][c >> 2] = cur; cur = nxt; } }
      } }
    __syncthreads();
    if (g == 0) { for (int n = 0; n < NSLC; ++n) { const float imp = (impS[tl][0][n] + impS[tl][1][n]) + (impS[tl][2][n] + impS[tl][3][n]);
        const bool forced = (n == 0) || (n == qi) || (n == qi - 1); const bool valid = n <= qi;
        scS[tl][n] = forced ? 1e4f : (valid ? imp : -1e30f); } }
    __syncthreads();
    unsigned selmask = 0u;
    for (int n = 0; n < NSLC; ++n) { const float sn = scS[tl][n]; int rank = 0;
        for (int m2 = 0; m2 < NSLC; ++m2) { const float sm = scS[tl][m2]; rank += (sm > sn || (sm == sn && m2 < n)) ? 1 : 0; }
        if (rank < TOPN) selmask |= (1u << n); }
    NATT_RESET();
    for (int j = 0; j <= qi; ++j)
        for (int hf = 0; hf < 2; ++hf) { const int p0 = j * 64 + hf * 32;
            const float* kp = T + ((size_t)b * SEQ + p0) * NSA_COLS + (NH * HD + 2 * NKV * HD) + hk * HD; const float* vp = kp + NKV * HD;
            natt_load_tile(Kt, Vt, kp, vp, NSA_COLS, NATT_TILE);
            if ((selmask >> j) & 1u) for (int kk = 0; kk < NATT_TILE; ++kk) if (p0 + kk <= t) { float s; NATT_DOT(s, kk); NATT_UPD(s, kk); } }
    { const float inv = g1 / fmaxf(l, 1e-30f);
#pragma unroll
      for (int d = 0; d < HD; d += 4) { float4 o = *(float4*)(op + d); o.x += acc[d] * inv; o.y += acc[d + 1] * inv; o.z += acc[d + 2] * inv; o.w += acc[d + 3] * inv; *(float4*)(op + d) = o; } }
    NATT_RESET();
    for (int j = (qi >= 8 ? qi - 8 : 0); j <= qi; ++j)
        for (int hf = 0; hf < 2; ++hf) { const int p0 = j * 64 + hf * 32;
            const float* kp = T + ((size_t)b * SEQ + p0) * NSA_COLS + (NH * HD + 4 * NKV * HD) + hk * HD; const float* vp = kp + NKV * HD;
            natt_load_tile(Kt, Vt, kp, vp, NSA_COLS, NATT_TILE);
            for (int kk = 0; kk < NATT_TILE; ++kk) { const int df = t - (p0 + kk); if (df >= 0 && df < WINDOW) { float s; NATT_DOT(s, kk); NATT_UPD(s, kk); } } }
    { const float inv = g2 / fmaxf(l, 1e-30f);
#pragma unroll
      for (int d = 0; d < HD; d += 4) { float4 o = *(float4*)(op + d); o.x += acc[d] * inv; o.y += acc[d + 1] * inv; o.z += acc[d + 2] * inv; o.w += acc[d + 3] * inv; *(float4*)(op + d) = o; } }
#undef NATT_RESET
#undef NATT_DOT
#undef NATT_UPD
}

constexpr int MOE_CAP = 6144;
__global__ __launch_bounds__(256) void n_router(const float* __restrict__ x, const float* __restrict__ wr, int* __restrict__ cnt, int* __restrict__ list, int* __restrict__ tsel, float* __restrict__ twt) {
    const int m = blockIdx.x * 4 + (threadIdx.x >> 6), lane = threadIdx.x & 63;
    float lg[NEXP];
#pragma unroll
    for (int e = 0; e < NEXP; ++e) lg[e] = 0.f;
    for (int k = lane; k < DM; k += 64) { const float xv = x[(size_t)m * DM + k];
#pragma unroll
        for (int e = 0; e < NEXP; ++e) lg[e] += xv * wr[k * NEXP + e]; }
#pragma unroll
    for (int e = 0; e < NEXP; ++e) lg[e] = wave_sum(lg[e]);
    if (lane == 0) {
        int e1 = 0; float v1 = lg[0];
#pragma unroll
        for (int e = 1; e < NEXP; ++e) if (lg[e] > v1) { v1 = lg[e]; e1 = e; }
        int e2 = -1; float v2 = -3.4e38f;
#pragma unroll
        for (int e = 0; e < NEXP; ++e) if (e != e1 && lg[e] > v2) { v2 = lg[e]; e2 = e; }
        const float p2 = expf(v2 - v1), w1 = 1.0f / (1.0f + p2), w2 = p2 / (1.0f + p2);
        const int s1 = atomicAdd(cnt + e1, 1), s2 = atomicAdd(cnt + e2, 1);
        if (s1 < MOE_CAP) list[e1 * MOE_CAP + s1] = m;
        if (s2 < MOE_CAP) list[e2 * MOE_CAP + s2] = m;
        tsel[m * 4 + 0] = e1; tsel[m * 4 + 1] = s1; tsel[m * 4 + 2] = e2; tsel[m * 4 + 3] = s2; twt[m * 2] = w1; twt[m * 2 + 1] = w2;
    }
}
__global__ __launch_bounds__(256) void n_moe_scatter(const float* __restrict__ Y, const int* __restrict__ cnt, const int* __restrict__ list, const int* __restrict__ tsel, const float* __restrict__ twt, int e, float* __restrict__ F) {
    const int slot = blockIdx.x; int c = cnt[e]; c = c < MOE_CAP ? c : MOE_CAP; if (slot >= c) return;
    const int m = list[e * MOE_CAP + slot]; const float w = (tsel[m * 4] == e) ? twt[m * 2] : twt[m * 2 + 1];
    const int col = threadIdx.x * 4; const float4 y = *(const float4*)(Y + (size_t)slot * DM + col); float4 f = *(float4*)(F + (size_t)m * DM + col);
    f.x += w * y.x; f.y += w * y.y; f.z += w * y.z; f.w += w * y.w; *(float4*)(F + (size_t)m * DM + col) = f;
}


enum { I_X = 0, I_LMG, I_LMB, I_LFG, I_LFB, I_CWIN, I_CWDW, I_CBDW, I_CLNG, I_CLNB, I_CWOUT, I_SWIN, I_SWCONV, I_SWOUT, I_NWIN, I_NPEK, I_NPEV, I_NWK1, I_NWK2, I_NWV1, I_NWV2, I_NWOUT,
       I_FWG, I_FWU, I_FWD, I_MWR, I_MWG, I_MWU, I_MWD };

#define GAS __attribute__((address_space(1)))
#define LAS __attribute__((address_space(3)))
typedef unsigned short bf16;
typedef unsigned v4u __attribute__((ext_vector_type(4)));
typedef unsigned v2u __attribute__((ext_vector_type(2)));
typedef float f32x4 __attribute__((ext_vector_type(4)));
typedef float f32x2 __attribute__((ext_vector_type(2)));
typedef short bf16x8 __attribute__((ext_vector_type(8)));
typedef short s16x4 __attribute__((ext_vector_type(4)));
typedef GAS unsigned gu32;
#define RLX_AGENT __ATOMIC_RELAXED, __HIP_MEMORY_SCOPE_AGENT
#define LDS_WAIT() asm volatile("s_waitcnt lgkmcnt(0)" ::: "memory")
#define VM_WAIT() asm volatile("s_waitcnt vmcnt(0)" ::: "memory")
constexpr int NWAVES = 8, NTHR = NWAVES * 64;
__device__ __forceinline__ unsigned f2bf(float f) { unsigned u = __builtin_bit_cast(unsigned, f); return (u + 0x7fffu + ((u >> 16) & 1u)) >> 16; }
__device__ __forceinline__ unsigned pk2(float lo, float hi) { return f2bf(lo) | (f2bf(hi) << 16); }
typedef __bf16 bf16x2_t __attribute__((ext_vector_type(2)));
__device__ __forceinline__ unsigned cvt_pk_bf16(float lo, float hi) { f32x2 v = {lo, hi}; bf16x2_t b = __builtin_convertvector(v, bf16x2_t); return __builtin_bit_cast(unsigned, b); }
__device__ __forceinline__ float bf_lo(unsigned u) { return __builtin_bit_cast(float, u << 16); }
__device__ __forceinline__ float bf_hi(unsigned u) { return __builtin_bit_cast(float, u & 0xffff0000u); }
__device__ __forceinline__ float fast_sigmoid(float x) { return __builtin_amdgcn_rcpf(1.0f + __builtin_amdgcn_exp2f(-1.4426950408889634f * x)); }
__device__ __forceinline__ float fast_silu(float x) { return x * fast_sigmoid(x); }

#define XB_TMO      128
#define XB_XCNT(j)  (256  + 64 * (j))
#define XB_XSUB(j)  (1280 + 64 * (j))
#define XB_XGEN(j)  (2304 + 64 * (j))
#define XB_TOP      3328
#define XB_TOPGEN   3392
#define XCD_BAR_WORDS 3456
#define XB_SPIN_CAP (1u << 18)
__device__ __forceinline__ unsigned xb_ld(unsigned* p)              { return __hip_atomic_load(p, __ATOMIC_RELAXED, __HIP_MEMORY_SCOPE_AGENT); }
__device__ __forceinline__ unsigned xb_add(unsigned* p, unsigned v) { return __hip_atomic_fetch_add(p, v, __ATOMIC_RELAXED, __HIP_MEMORY_SCOPE_AGENT); }
__device__ __forceinline__ unsigned xb_xcc_id() { return (unsigned)__builtin_amdgcn_s_getreg((3 << 11) | 20) & 0xFu; }
#define XB_SPIN(cond, bar) do { unsigned _sp = 0; while (cond) { __builtin_amdgcn_s_sleep(1); \
    if ((++_sp & 255u) == 0u) { if (xb_ld(&(bar)[XB_TMO])) break; if (_sp > XB_SPIN_CAP) { atomicAdd(&(bar)[XB_TMO], 1u); break; } } } } while (0)
struct XcdBarrier { unsigned* bar; unsigned x; volatile LAS unsigned* st; };
__device__ __forceinline__ XcdBarrier xcd_barrier_post(unsigned* bar, volatile LAS unsigned* st) {
    XcdBarrier b; b.bar = bar; b.x = xb_xcc_id(); b.st = st;
    if (threadIdx.x == 0) (void)xb_add(&bar[XB_XCNT(b.x)], 1u);
    return b;
}
__device__ __forceinline__ void xcd_barrier_complete(unsigned* bar, unsigned x, unsigned& nloc, unsigned& nx) {
    const unsigned G = gridDim.x * gridDim.y * gridDim.z;
    unsigned sum, cnt, mine, sp = 0u;
    for (;;) {
        sum = 0u; cnt = 0u; mine = 0u;
#pragma unroll
        for (unsigned j = 0; j < 16; ++j) { const unsigned c = xb_ld(&bar[XB_XCNT(j)]); sum += c; cnt += (c > 0u) ? 1u : 0u; mine = (j == x) ? c : mine; }
        if (sum == G) break;
        __builtin_amdgcn_s_sleep(1);
        if ((++sp & 255u) == 0u) { if (xb_ld(&bar[XB_TMO])) break; if (sp > XB_SPIN_CAP) { atomicAdd(&bar[XB_TMO], 1u); break; } }
    }
    nloc = mine > 0u ? mine : 1u; nx = cnt > 0u ? cnt : 1u;
}
__device__ __forceinline__ void xcd_barrier(const XcdBarrier& b) {
    asm volatile("s_waitcnt vmcnt(0)" ::: "memory");
    __syncthreads();
    if (threadIdx.x == 0) {
        unsigned* bar = b.bar;
        __builtin_amdgcn_s_waitcnt(0);
        unsigned nloc = b.st[0], nx = b.st[1];
        if (nloc == 0u) { xcd_barrier_complete(bar, b.x, nloc, nx); b.st[0] = nloc; b.st[1] = nx; }
        const unsigned old = xb_add(&bar[XB_XSUB(b.x)], 1u);
        const unsigned gen = old / nloc;
        if (old + 1u == (gen + 1u) * nloc) {
            __builtin_amdgcn_fence(__ATOMIC_RELEASE, "agent");
            asm volatile("s_waitcnt vmcnt(0)" ::: "memory");
            const unsigned og = xb_add(&bar[XB_TOP], 1u);
            const unsigned tg = og / nx;
            if (og + 1u == (tg + 1u) * nx) xb_add(&bar[XB_TOPGEN], 1u);
            else XB_SPIN(xb_ld(&bar[XB_TOPGEN]) == tg, bar);
            __builtin_amdgcn_fence(__ATOMIC_ACQUIRE, "agent");
            xb_add(&bar[XB_XGEN(b.x)], 1u);
            asm volatile("s_waitcnt vmcnt(0)" ::: "memory");
        } else {
            XB_SPIN(xb_ld(&bar[XB_XGEN(b.x)]) == gen, bar);
            __builtin_amdgcn_fence(__ATOMIC_ACQUIRE, "agent");
            asm volatile("s_waitcnt vmcnt(0)" ::: "memory");
        }
    }
    __syncthreads();
}

namespace pg8 {
#define PG8_LAS __attribute__((address_space(3)))
typedef unsigned short bf16_t;
constexpr int BM = 256, BK = 64, HALF = 128, HTB = HALF * BK * 2  , STAGE_BYTES = 8 * HTB, NXCD = 8, WGM = 8;
__host__ __device__ __forceinline__ int lds_byte(int r, int c) { const int st = (r >> 4) * 2 + (c >> 5), rr = r & 15, cc = c & 31, ob = rr * 64 + cc * 2; return st * 1024 + (ob ^ (((ob >> 9) & 1) << 5)); }
__host__ __device__ __forceinline__ void stage_rc(int b, int& R, int& C) { const int st = b / 1024, sb = b % 1024, swz = sb ^ (((sb >> 9) & 1) << 5); R = (st >> 1) * 16 + swz / 64; C = (st & 1) * 32 + (swz % 64) / 2; }
__host__ __device__ __forceinline__ int perm32(int rho) { const int n = rho >> 4, i = rho & 15; return 8 * (i >> 2) + 4 * n + (i & 3); }

struct Unit { int pm, pn, eb; };
struct Gemm { const bf16_t* A; const bf16_t* Bt; int lda, K; size_t bexp; };

struct StaticOrder {
    int nM, nN, nwg, G, c;
    __host__ __device__ void init(int nM_, int nN_, int G_, int c_) { nM = nM_; nN = nN_; nwg = nM * nN; G = G_; c = c_; }
    __host__ __device__ bool next(int i, Unit& u) const {
        const long L = (long)i * G + c; if (L >= nwg) return false;
        int wgid = (int)L; { const int q = nwg / NXCD, r = nwg % NXCD, xcd = wgid % NXCD, off = wgid / NXCD; wgid = (xcd < r ? xcd * (q + 1) : r * (q + 1) + (xcd - r) * q) + off; }
        const int nig = WGM * nN, gid = wgid / nig, fm = gid * WGM, gsz = (nM - fm) < WGM ? (nM - fm) : WGM;
        u.pm = fm + ((wgid % nig) % gsz); u.pn = (wgid % nig) / gsz; u.eb = 0; return true;
    }
    __device__ __forceinline__ void a_ready(const Unit&) const {}
    __device__ __forceinline__ void done(const Unit&) const {}
};
struct GroupedOrder : StaticOrder {
    int pb[9];
    __device__ __forceinline__ bool next(int i, Unit& u) const {
        if (!StaticOrder::next(i, u)) return false;
        int e = 0;
#pragma unroll
        for (int k = 1; k < 8; ++k) e += (u.pm >= pb[k]) ? 1 : 0;
        u.eb = e; return true;
    }
};

template <class Epi, class Sched, bool ALIGN_EPI = false, bool SP2 = false>
__device__ __forceinline__ void gemm_phase(PG8_LAS unsigned char* lds, const Gemm g, const Sched& S, const Epi& E) {
    const int tid = threadIdx.x, wid = __builtin_amdgcn_readfirstlane(tid >> 6), lane = tid & 63, wr = wid >> 2, wc = wid & 3, fr = lane & 15, fq = lane >> 4;
    const int K = g.K, nt = K / BK;
    unsigned voffA[2], voffB[2];
#pragma unroll
    for (int i = 0; i < 2; ++i) { int R, C; stage_rc(tid * 16 + i * 8192, R, C); const int Rb = Epi::PERM ? ((R & ~31) + perm32(R & 31)) : R;
        voffA[i] = (unsigned)(R * g.lda + C) * 2u; voffB[i] = (unsigned)(Rb * K + C) * 2u; }
    const size_t kstep = (size_t)(BK * 2);
    const size_t hstepA = (size_t)HALF * g.lda * 2, hstepB = (size_t)HALF * K * 2;
    const size_t tstepA = 2 * hstepA, tstepB = 2 * hstepB;
    const unsigned ldsw = (unsigned)wid * 1024u;
    const int aoff = lds_byte(wr * 64 + fr, fq * 8), boff = lds_byte(wc * 32 + fr, fq * 8);
#define PG8_SA(b, h) (((b) * 2 + (h)) * HTB)
#define PG8_SB(b, h) ((4 + (b) * 2 + (h)) * HTB)
#define PG8_STAGE(bufoff, gbase, voff) do { _Pragma("unroll") for (int _i = 0; _i < 2; ++_i) \
        __builtin_amdgcn_global_load_lds((const unsigned*)((const char*)(gbase) + (voff)[_i]), (PG8_LAS unsigned*)(lds + (bufoff) + ldsw + _i * 8192), 16, 0, 0); } while (0)
#define PG8_LDA(dst, b, h) do { _Pragma("unroll") for (int m = 0; m < 4; ++m) _Pragma("unroll") for (int k = 0; k < 2; ++k) dst[m][k] = *(const PG8_LAS bf16x8*)(lds + PG8_SA(b, h) + aoff + m * 2048 + k * 1024); } while (0)
#define PG8_LDB(dst, b, h) do { _Pragma("unroll") for (int n = 0; n < 2; ++n) _Pragma("unroll") for (int k = 0; k < 2; ++k) dst[n][k] = *(const PG8_LAS bf16x8*)(lds + PG8_SB(b, h) + boff + n * 2048 + k * 1024); } while (0)
#define PG8_MMA(ai, bj, At, Bt) do { __builtin_amdgcn_s_setprio(1); _Pragma("unroll") for (int m = 0; m < 4; ++m) _Pragma("unroll") for (int n = 0; n < 2; ++n) _Pragma("unroll") for (int k = 0; k < 2; ++k) \
        acc[ai][bj][m][n] = __builtin_amdgcn_mfma_f32_16x16x32_bf16(Bt[n][k], At[m][k], acc[ai][bj][m][n], 0, 0, 0); __builtin_amdgcn_s_setprio(0); } while (0)
#define PG8_WAIT_V(n) asm volatile("s_waitcnt vmcnt(" #n ")" ::: "memory")
#define PG8_WAIT_L(n) asm volatile("s_waitcnt lgkmcnt(" #n ")" ::: "memory")
#define PG8_BAR __builtin_amdgcn_s_barrier()
#define PG8_SCHED __builtin_amdgcn_sched_barrier(0)
    Unit cur, nxt; int ui = 0;
    if (!S.next(0, cur)) return;
    f32x4 acc[2][2][4][2];
#pragma unroll
    for (int a = 0; a < 2; ++a)
#pragma unroll
        for (int b = 0; b < 2; ++b)
#pragma unroll
            for (int m = 0; m < 4; ++m)
#pragma unroll
                for (int n = 0; n < 2; ++n) acc[a][b][m][n] = (f32x4){0.f, 0.f, 0.f, 0.f};
    bf16x8 At[4][2], B0[2][2], B1[2][2];
    const char* cA = (const char*)g.A + (size_t)cur.pm * tstepA; const char* cB = (const char*)g.Bt + (size_t)cur.eb * g.bexp + (size_t)cur.pn * tstepB;
    S.a_ready(cur);
    if constexpr (SP2) {
        PG8_STAGE(PG8_SB(0, 0), cB, voffB); PG8_STAGE(PG8_SB(0, 1), cB + hstepB, voffB); PG8_STAGE(PG8_SA(0, 0), cA, voffA); PG8_STAGE(PG8_SA(0, 1), cA + hstepA, voffA);
        if (wr == 1) PG8_BAR;
        PG8_WAIT_V(2); PG8_BAR;
        PG8_STAGE(PG8_SB(1, 0), cB + kstep, voffB); PG8_STAGE(PG8_SA(1, 0), cA + kstep, voffA); PG8_STAGE(PG8_SB(1, 1), cB + hstepB + kstep, voffB);
        PG8_WAIT_V(6); PG8_BAR;
    } else {
        PG8_STAGE(PG8_SB(0, 0), cB, voffB); PG8_STAGE(PG8_SA(0, 0), cA, voffA); PG8_STAGE(PG8_SB(0, 1), cB + hstepB, voffB); PG8_STAGE(PG8_SA(0, 1), cA + hstepA, voffA);
        if (wr == 1) PG8_BAR;
        PG8_WAIT_V(4); PG8_BAR;
        PG8_STAGE(PG8_SB(1, 0), cB + kstep, voffB); PG8_STAGE(PG8_SA(1, 0), cA + kstep, voffA); PG8_STAGE(PG8_SB(1, 1), cB + hstepB + kstep, voffB);
        PG8_WAIT_V(6); PG8_BAR;
    }
    for (;;) {
        const bool has_next = S.next(ui + 1, nxt);
        const char* nA = has_next ? (const char*)g.A + (size_t)nxt.pm * tstepA : cA; const char* nB = has_next ? (const char*)g.Bt + (size_t)nxt.eb * g.bexp + (size_t)nxt.pn * tstepB : cB;
        for (int t = 0; t < nt; t += 2) {
            const bool last = (t == nt - 2);
            const char* a1 = cA + (size_t)(t + 1) * kstep;
            const char* a2 = last ? nA : cA + (size_t)(t + 2) * kstep; const char* b2 = last ? nB : cB + (size_t)(t + 2) * kstep;
            const char* a3 = a2 + kstep; const char* b3 = b2 + kstep;
            if (last && has_next) S.a_ready(nxt);
            if constexpr (SP2) {
            PG8_LDB(B0, 0, 0); PG8_LDB(B1, 0, 1); PG8_SCHED; PG8_LDA(At, 0, 0); PG8_STAGE(PG8_SA(1, 1), a1 + hstepA, voffA);
            PG8_WAIT_V(8); PG8_WAIT_L(0); PG8_BAR; PG8_MMA(0, 0, At, B0); PG8_MMA(0, 1, At, B1); PG8_BAR; PG8_SCHED;
            PG8_LDA(At, 0, 1); PG8_STAGE(PG8_SB(0, 0), b2, voffB); PG8_STAGE(PG8_SB(0, 1), b2 + hstepB, voffB); PG8_STAGE(PG8_SA(0, 0), a2, voffA);
            PG8_WAIT_V(8); PG8_WAIT_L(0); PG8_BAR; PG8_MMA(1, 0, At, B0); PG8_MMA(1, 1, At, B1); PG8_BAR; PG8_SCHED;
            PG8_LDB(B0, 1, 0); PG8_LDB(B1, 1, 1); PG8_SCHED; PG8_LDA(At, 1, 0); PG8_STAGE(PG8_SA(0, 1), a2 + hstepA, voffA);
            PG8_WAIT_V(8); PG8_WAIT_L(0); PG8_BAR; PG8_MMA(0, 0, At, B0); PG8_MMA(0, 1, At, B1); PG8_BAR; PG8_SCHED;
            PG8_LDA(At, 1, 1); PG8_STAGE(PG8_SB(1, 0), b3, voffB); PG8_STAGE(PG8_SB(1, 1), b3 + hstepB, voffB); PG8_STAGE(PG8_SA(1, 0), a3, voffA);
            PG8_WAIT_V(8); PG8_WAIT_L(0); PG8_BAR; PG8_MMA(1, 0, At, B0); PG8_MMA(1, 1, At, B1); PG8_BAR; PG8_SCHED;
            } else {
            PG8_LDB(B0, 0, 0); PG8_SCHED; PG8_LDA(At, 0, 0); PG8_STAGE(PG8_SA(1, 1), a1 + hstepA, voffA);
            PG8_WAIT_L(8); PG8_BAR; PG8_WAIT_L(0); PG8_MMA(0, 0, At, B0); PG8_BAR; PG8_SCHED;
            PG8_LDB(B1, 0, 1); PG8_STAGE(PG8_SB(0, 0), b2, voffB);
            PG8_BAR; PG8_WAIT_L(0); PG8_MMA(0, 1, At, B1); PG8_BAR;
            PG8_LDA(At, 0, 1); PG8_STAGE(PG8_SA(0, 0), a2, voffA);
            PG8_BAR; PG8_WAIT_L(0); PG8_MMA(1, 0, At, B0); PG8_BAR; PG8_SCHED;
            PG8_STAGE(PG8_SB(0, 1), b2 + hstepB, voffB);
            PG8_WAIT_V(6); PG8_BAR; PG8_MMA(1, 1, At, B1); PG8_BAR;
            PG8_LDB(B0, 1, 0); PG8_SCHED; PG8_LDA(At, 1, 0); PG8_STAGE(PG8_SA(0, 1), a2 + hstepA, voffA);
            PG8_WAIT_L(8); PG8_BAR; PG8_WAIT_L(0); PG8_MMA(0, 0, At, B0); PG8_BAR; PG8_SCHED;
            PG8_LDB(B1, 1, 1); PG8_STAGE(PG8_SB(1, 0), b3, voffB);
            PG8_BAR; PG8_WAIT_L(0); PG8_MMA(0, 1, At, B1); PG8_BAR;
            PG8_LDA(At, 1, 1); PG8_STAGE(PG8_SA(1, 0), a3, voffA);
            PG8_BAR; PG8_WAIT_L(0); PG8_MMA(1, 0, At, B0); PG8_BAR; PG8_SCHED;
            PG8_STAGE(PG8_SB(1, 1), b3 + hstepB, voffB);
            PG8_WAIT_V(6); PG8_BAR; PG8_MMA(1, 1, At, B1); PG8_BAR;
            }
        }
        if constexpr (ALIGN_EPI) { if (wr == 0) PG8_BAR; }
        E(acc, cur, wr, wc, fr, fq); S.done(cur);
        if (!has_next) break;
#pragma unroll
        for (int a = 0; a < 2; ++a)
#pragma unroll
            for (int b = 0; b < 2; ++b)
#pragma unroll
                for (int m = 0; m < 4; ++m)
#pragma unroll
                    for (int n = 0; n < 2; ++n) acc[a][b][m][n] = (f32x4){0.f, 0.f, 0.f, 0.f};
        cur = nxt; cA = nA; cB = nB; ++ui;
        if constexpr (ALIGN_EPI) { if (wr == 1) PG8_BAR; }
    }
    PG8_WAIT_V(0);
    if constexpr (!ALIGN_EPI) { if (wr == 0) PG8_BAR; }
    PG8_BAR;
#undef PG8_SA
#undef PG8_SB
#undef PG8_STAGE
#undef PG8_LDA
#undef PG8_LDB
#undef PG8_MMA
#undef PG8_WAIT_V
#undef PG8_WAIT_L
#undef PG8_BAR
#undef PG8_SCHED
}

template <int MODE> struct EpiPair {
    static constexpr bool PERM = true;
    bf16_t* O; int ldc;
    __device__ __forceinline__ void operator()(const f32x4 (&acc)[2][2][4][2], const Unit& u, int wr, int wc, int fr, int fq) const {
        const int row0 = u.pm * BM + wr * 64 + fr, col0 = u.pn * HALF + wc * 32 + 8 * fq;
#pragma unroll
        for (int ai = 0; ai < 2; ++ai)
#pragma unroll
            for (int m = 0; m < 4; ++m) { bf16_t* p = O + (size_t)(row0 + ai * HALF + m * 16) * ldc + col0; float r[8];
#pragma unroll
                for (int n = 0; n < 2; ++n)
#pragma unroll
                    for (int j = 0; j < 4; ++j) { const float x0 = acc[ai][0][m][n][j], x1 = acc[ai][1][m][n][j];
                        r[n * 4 + j] = MODE == 0 ? x0 * fast_sigmoid(x1) : (MODE == 1 ? fast_silu(x0) * x1 : x0 * x1); }
                v4u w; w.x = cvt_pk_bf16(r[0], r[1]); w.y = cvt_pk_bf16(r[2], r[3]); w.z = cvt_pk_bf16(r[4], r[5]); w.w = cvt_pk_bf16(r[6], r[7]);
                *(v4u*)p = w; }
    }
};
struct EpiBf16 {
    static constexpr bool PERM = true;
    bf16_t* O; int ldc; float scale;
    __device__ __forceinline__ void operator()(const f32x4 (&acc)[2][2][4][2], const Unit& u, int wr, int wc, int fr, int fq) const {
        const int row0 = u.pm * BM + wr * 64 + fr, col0 = u.pn * BM + wc * 32 + 8 * fq;
#pragma unroll
        for (int ai = 0; ai < 2; ++ai)
#pragma unroll
            for (int m = 0; m < 4; ++m) { bf16_t* rowp = O + (size_t)(row0 + ai * HALF + m * 16) * ldc + col0;
#pragma unroll
                for (int bj = 0; bj < 2; ++bj) { const f32x4 v0 = acc[ai][bj][m][0] * scale, v1 = acc[ai][bj][m][1] * scale;
                    v4u w; w.x = cvt_pk_bf16(v0[0], v0[1]); w.y = cvt_pk_bf16(v0[2], v0[3]); w.z = cvt_pk_bf16(v1[0], v1[1]); w.w = cvt_pk_bf16(v1[2], v1[3]);
                    *(v4u*)(rowp + bj * HALF) = w; } }
    }
};
struct EpiResid {
    static constexpr bool PERM = false;
    const float* res; float* out; int ldc;
    __device__ __forceinline__ void operator()(const f32x4 (&acc)[2][2][4][2], const Unit& u, int wr, int wc, int fr, int fq) const {
        const int row0 = u.pm * BM + wr * 64 + fr, col0 = u.pn * BM + wc * 32 + 4 * fq;
#pragma unroll
        for (int ai = 0; ai < 2; ++ai)
#pragma unroll
            for (int m = 0; m < 4; ++m) { const size_t off = (size_t)(row0 + ai * HALF + m * 16) * ldc + col0;
#pragma unroll
                for (int bj = 0; bj < 2; ++bj)
#pragma unroll
                    for (int n = 0; n < 2; ++n) { const f32x4 r = *(const f32x4*)(res + off + bj * HALF + n * 16); *(f32x4*)(out + off + bj * HALF + n * 16) = r * ALPHA_F + acc[ai][bj][m][n]; } }
    }
};
}
namespace pg8 {
struct EpiSC {
    static constexpr bool PERM = true;
    bf16_t* CH; bf16_t* BG;
    __device__ __forceinline__ void operator()(const f32x4 (&acc)[2][2][4][2], const Unit& u, int wr, int wc, int fr, int fq) const {
        if (u.pn < 8) { EpiPair<2> e{CH, DM}; e(acc, u, wr, wc, fr, fq); }
        else { Unit u2 = u; u2.pn = u.pn - 8; EpiBf16 e{BG, DM, 1.0f}; e(acc, u2, wr, wc, fr, fq); }
    }
};
}
namespace pg8 {
struct EpiNSA {
    static constexpr bool PERM = true;
    bf16_t* Q; bf16_t* KV; float* GATE;
    __device__ __forceinline__ void operator()(const f32x4 (&acc)[2][2][4][2], const Unit& u, int wr, int wc, int fr, int fq) const {
        const int b = u.pm >> 3, tb = (u.pm & 7) * 256 + wr * 64 + fr, d0 = 32 * (wc & 1) + 8 * fq;
        if (u.pn < 4) {
            const float sc = 0.125f * 1.4426950408889634f;
#pragma unroll
            for (int ai = 0; ai < 2; ++ai)
#pragma unroll
                for (int m = 0; m < 4; ++m) { const int t = tb + ai * HALF + m * 16;
#pragma unroll
                    for (int bj = 0; bj < 2; ++bj) { const int h = u.pn * 4 + 2 * bj + (wc >> 1); const f32x4 v0 = acc[ai][bj][m][0] * sc, v1 = acc[ai][bj][m][1] * sc;
                        v4u w; w.x = cvt_pk_bf16(v0[0], v0[1]); w.y = cvt_pk_bf16(v0[2], v0[3]); w.z = cvt_pk_bf16(v1[0], v1[1]); w.w = cvt_pk_bf16(v1[2], v1[3]);
                        *(v4u*)(Q + (((size_t)(b * NH + h) * SEQ + t) * HD + d0)) = w; } }
        } else if (u.pn < 10) {
            const int ti = u.pn - 4; bf16_t* base = KV + (size_t)ti * (4u << 20);
            const bool tr = (ti == 3) || (ti == 5);
#pragma unroll
            for (int ai = 0; ai < 2; ++ai)
#pragma unroll
                for (int m = 0; m < 4; ++m) { const int t = tb + ai * HALF + m * 16;
#pragma unroll
                    for (int bj = 0; bj < 2; ++bj) { const int hk = 2 * bj + (wc >> 1); const f32x4 v0 = acc[ai][bj][m][0], v1 = acc[ai][bj][m][1];
                        if (!tr) { v4u w; w.x = cvt_pk_bf16(v0[0], v0[1]); w.y = cvt_pk_bf16(v0[2], v0[3]); w.z = cvt_pk_bf16(v1[0], v1[1]); w.w = cvt_pk_bf16(v1[2], v1[3]);
                            *(v4u*)(base + (((size_t)(b * NKV + hk) * SEQ + t) * HD + d0)) = w; }
                        else { bf16_t* p = base + ((size_t)(b * NKV + hk) * HD + d0) * SEQ + t;
#pragma unroll
                            for (int j = 0; j < 4; ++j) { p[(size_t)j * SEQ] = (bf16_t)f2bf(v0[j]); p[(size_t)(4 + j) * SEQ] = (bf16_t)f2bf(v1[j]); } } } }
        } else {
            if (wc < 2 && (wc == 0 || fq < 2)) {
#pragma unroll
                for (int ai = 0; ai < 2; ++ai)
#pragma unroll
                    for (int m = 0; m < 4; ++m) { const size_t row = (size_t)u.pm * BM + wr * 64 + fr + ai * HALF + m * 16; float* p = GATE + row * 48 + 32 * wc + 8 * fq;
                        const f32x4 v0 = acc[ai][0][m][0], v1 = acc[ai][0][m][1];
                        *(f32x4*)p = (f32x4){fast_sigmoid(v0[0]), fast_sigmoid(v0[1]), fast_sigmoid(v0[2]), fast_sigmoid(v0[3])};
                        *(f32x4*)(p + 4) = (f32x4){fast_sigmoid(v1[0]), fast_sigmoid(v1[1]), fast_sigmoid(v1[2]), fast_sigmoid(v1[3])}; }
            }
        }
    }
};
}

constexpr size_t MiB = 1u << 20;
constexpr size_t WS_CTL = 0, CTL_ZERO_BYTES = 1 * MiB;
constexpr size_t WS_X = 1 * MiB;
constexpr size_t WS_XBF = 65 * MiB;
constexpr size_t WS_ACT = 97 * MiB;
constexpr size_t WS_H = 225 * MiB;
constexpr size_t WS_MISC = 463 * MiB;
constexpr size_t WS_W = 467 * MiB;
constexpr size_t W_CONF_IN = WS_W, W_CONF_OUT = W_CONF_IN + 8 * MiB, W_SC_IN = W_CONF_OUT + 4 * MiB, W_SC_OUT = W_SC_IN + 6 * MiB;
constexpr size_t W_NSA_IN = W_SC_OUT + 2 * MiB, W_NSA_OUT = W_NSA_IN + 6 * MiB, W_CMP1 = W_NSA_OUT + 2 * MiB;
constexpr size_t W_FFN_GU = W_CMP1 + 1 * MiB, W_FFN_D = W_FFN_GU + 22 * MiB, W_MOE_GU = W_FFN_D + 11 * MiB, W_MOE_D = W_MOE_GU + 224 * MiB, WS_END = W_MOE_D + 112 * MiB;
static_assert(WS_END <= 896 * MiB, "workspace map");
constexpr size_t A_U = WS_ACT, A_V = WS_ACT + 32 * MiB;
constexpr size_t A_CH = WS_ACT, A_BG = WS_ACT + 32 * MiB, A_YSC = WS_ACT + 64 * MiB;
constexpr size_t A_Q = WS_ACT, A_KC = WS_ACT + 32 * MiB, A_VCT = A_KC + 8 * MiB, A_KS = A_VCT + 8 * MiB, A_VST = A_KS + 8 * MiB, A_KW = A_VST + 8 * MiB, A_VWT = A_KW + 8 * MiB;
constexpr size_t A_O = A_VWT + 8 * MiB, A_GATE = A_O + 32 * MiB, A_KCMP = A_GATE + 4 * MiB, A_VCMPT = A_KCMP + 1 * MiB;
constexpr size_t A_PERM = WS_ACT;
static_assert(A_VCMPT + 1 * MiB <= WS_ACT + 128 * MiB, "ACT map");
constexpr int MOE_ROWS_MAX = 2 * MTOK + NEXP * 256;
static_assert((size_t)MOE_ROWS_MAX * DFFE * 2 <= 238 * MiB && (size_t)MOE_ROWS_MAX * DM * 2 <= 128 * MiB, "MoE buffers");
constexpr size_t MS_LIST = WS_MISC, MS_TSEL = MS_LIST + (size_t)NEXP * MTOK * 4, MS_TWT = MS_TSEL + (size_t)MTOK * 16, MS_END = MS_TWT + (size_t)MTOK * 8;
static_assert(MS_END <= WS_MISC + 4 * MiB, "MISC map");
constexpr int CW_BAR = 4096;
constexpr int CW_MOE = 16384;
constexpr int RING_BYTES = 131072, LDSCTL_OFF = RING_BYTES, LDS_BYTES = 147456;

struct CvtGroup { int in_idx, nmat; size_t src_stride; int ld, col0, K, ncols; size_t dst; size_t dst_stride; int rs, off; };
constexpr int NGROUPS = 17;
__device__ constexpr CvtGroup kGroups[NGROUPS] = {
    {I_CWIN, 2, (size_t)DM * 2 * DM, 2 * DM, 0, DM, DM, W_CONF_IN, 4 * MiB, 256, 0},
    {I_CWIN, 2, (size_t)DM * 2 * DM, 2 * DM, DM, DM, DM, W_CONF_IN, 4 * MiB, 256, 128},
    {I_CWOUT, 2, (size_t)DM * DM, DM, 0, DM, DM, W_CONF_OUT, 2 * MiB, 128, 0},
    {I_SWIN, 1, 0, 3 * DM, 0, DM, DM, W_SC_IN, 0, 128, 2048},
    {I_SWIN, 1, 0, 3 * DM, DM, DM, DM, W_SC_IN, 0, 256, 0},
    {I_SWIN, 1, 0, 3 * DM, 2 * DM, DM, DM, W_SC_IN, 0, 256, 128},
    {I_SWOUT, 1, 0, DM, 0, DM, DM, W_SC_OUT, 0, 128, 0},
    {I_NWIN, 1, 0, NSA_COLS, 0, DM, NSA_COLS, W_NSA_IN, 0, 128, 0},
    {I_NWOUT, 1, 0, DM, 0, DM, DM, W_NSA_OUT, 0, 128, 0},
    {I_NWK1, 1, 0, PHI, 0, CMP_BLOCK * HD, PHI, W_CMP1, 0, 128, 0},
    {I_NWV1, 1, 0, PHI, 0, CMP_BLOCK * HD, PHI, W_CMP1, 0, 128, 128},
    {I_FWG, 2, (size_t)DM * DFF, DFF, 0, DM, DFF, W_FFN_GU, 11 * MiB, 256, 0},
    {I_FWU, 2, (size_t)DM * DFF, DFF, 0, DM, DFF, W_FFN_GU, 11 * MiB, 256, 128},
    {I_FWD, 2, (size_t)DFF * DM, DM, 0, DFF, DM, W_FFN_D, (size_t)DM * DFF * 2, 128, 0},
    {I_MWG, 16, (size_t)DM * DFFE, DFFE, 0, DM, DFFE, W_MOE_GU, (size_t)2 * DFFE * DM * 2, 256, 0},
    {I_MWU, 16, (size_t)DM * DFFE, DFFE, 0, DM, DFFE, W_MOE_GU, (size_t)2 * DFFE * DM * 2, 256, 128},
    {I_MWD, 16, (size_t)DFFE * DM, DM, 0, DFFE, DM, W_MOE_D, (size_t)DM * DFFE * 2, 128, 0},
};
__host__ __device__ constexpr int grp_items_per_mat(int gi) { return (kGroups[gi].K / 64) * ((kGroups[gi].ncols + 31) / 32); }
__host__ __device__ constexpr int grp_items(int gi) { return kGroups[gi].nmat * grp_items_per_mat(gi); }
__host__ __device__ constexpr int grp_total() { int s = 0; for (int i = 0; i < NGROUPS; ++i) s += grp_items(i); return s; }
static_assert(W_FFN_GU + 2 * 11 * MiB == W_FFN_D && (size_t)2 * DFF * DM * 2 == 11 * MiB && (size_t)2 * DFFE * DM * 2 * 16 == 224 * MiB && (size_t)DM * DFFE * 2 * 16 == 112 * MiB, "weight map");

__device__ __forceinline__ void cvt_item(const float* src, int ld, int nvalid, bf16* dst, int Kd, int k0, LAS float* scr, int lane) {
    const int lr = lane >> 3, lc = (lane & 7) * 4;
    f32x4 v[8];
#pragma unroll
    for (int i = 0; i < 8; ++i) v[i] = (lc < nvalid) ? __builtin_nontemporal_load((const GAS f32x4*)(src + (size_t)(i * 8 + lr) * ld + lc)) : (f32x4){0.f, 0.f, 0.f, 0.f};
#pragma unroll
    for (int i = 0; i < 8; ++i) { LAS float* d = scr + (i * 8 + lr) * 33 + lc; d[0] = v[i].x; d[1] = v[i].y; d[2] = v[i].z; d[3] = v[i].w; }
    LDS_WAIT(); asm volatile("" ::: "memory");
    const int c = lane & 7;
#pragma unroll
    for (int j = 0; j < 4; ++j) { const int n = (lane >> 3) + 8 * j; const LAS float* s = scr + (8 * c) * 33 + n;
        v4u o; o.x = pk2(s[0 * 33], s[1 * 33]); o.y = pk2(s[2 * 33], s[3 * 33]); o.z = pk2(s[4 * 33], s[5 * 33]); o.w = pk2(s[6 * 33], s[7 * 33]);
        *(GAS v4u*)(dst + (size_t)n * Kd + k0 + 8 * c) = o; }
    LDS_WAIT(); asm volatile("" ::: "memory");
}
struct FArgs { const float* in[29]; float* out; unsigned char* ws; int ph_lo, ph_hi; };

__device__ __forceinline__ void phase_prologue(const FArgs& a, LAS unsigned char* lds, int gw, int NGW, int wave, int lane) {
    LAS float* scr = (LAS float*)(lds + wave * 16384);
    constexpr int NITEMS = grp_total();
    for (int it = gw; it < NITEMS; it += NGW) {
        int r = it, gi = 0;
#pragma unroll 1
        for (; gi < NGROUPS - 1; ++gi) { const int n = grp_items(gi); if (r < n) break; r -= n; }
        const CvtGroup G = kGroups[gi];
        const int ipm = (G.K / 64) * ((G.ncols + 31) / 32), mat = r / ipm, r2 = r % ipm, nblk = (G.ncols + 31) / 32, kb = r2 / nblk, nb = r2 % nblk;
        const int c0 = nb * 32, k0 = kb * 64, drow = (c0 / 128) * G.rs + (c0 % 128) + G.off;
        const float* src = a.in[G.in_idx] + (size_t)mat * G.src_stride + (size_t)k0 * G.ld + G.col0 + c0;
        bf16* dst = (bf16*)(a.ws + G.dst + (size_t)mat * G.dst_stride) + (size_t)drow * G.K;
        const int nvalid = (G.ncols - c0) < 32 ? (G.ncols - c0) : 32;
        cvt_item(src, G.ld, nvalid, dst, G.K, k0, scr, lane);
    }
    { const float* x = a.in[I_X]; bf16* xb = (bf16*)(a.ws + WS_XBF);
      for (size_t i = (size_t)gw * 64 + lane; i < (size_t)MTOK * DM / 8; i += (size_t)NGW * 64) {
        const f32x4 v0 = *(const GAS f32x4*)(x + i * 8), v1 = *(const GAS f32x4*)(x + i * 8 + 4);
        v4u o; o.x = pk2(v0.x, v0.y); o.y = pk2(v0.z, v0.w); o.z = pk2(v1.x, v1.y); o.w = pk2(v1.z, v1.w); *(GAS v4u*)(xb + i * 8) = o; } }
}

__device__ __forceinline__ void phase_ln(const float* Y, const float* gam, const float* bet, float* XO, bf16* XB, int gw, int NGW, int lane) {
    f32x4 gg[4], bb[4];
#pragma unroll
    for (int j = 0; j < 4; ++j) { gg[j] = *(const GAS f32x4*)(gam + 4 * lane + 256 * j); bb[j] = *(const GAS f32x4*)(bet + 4 * lane + 256 * j); }
    for (int m = gw; m < MTOK; m += NGW) {
        const GAS f32x4* yr = (const GAS f32x4*)(Y + (size_t)m * DM) + lane;
        f32x4 v[4]; float s = 0.f;
#pragma unroll
        for (int j = 0; j < 4; ++j) { v[j] = yr[64 * j]; s += (v[j].x + v[j].y) + (v[j].z + v[j].w); }
        const float mean = wave_sum(s) * (1.f / DM); float s2 = 0.f;
#pragma unroll
        for (int j = 0; j < 4; ++j) { v[j] = v[j] - mean; s2 += (v[j].x * v[j].x + v[j].y * v[j].y) + (v[j].z * v[j].z + v[j].w * v[j].w); }
        const float rstd = 1.f / sqrtf(wave_sum(s2) * (1.f / DM) + LN_EPS);
        GAS f32x4* xo = (GAS f32x4*)(XO + (size_t)m * DM) + lane;
#pragma unroll
        for (int j = 0; j < 4; ++j) { v[j] = v[j] * rstd * gg[j] + bb[j]; xo[64 * j] = v[j]; }
        if (XB) { GAS v2u* o8 = (GAS v2u*)(XB + (size_t)m * DM) + lane;
#pragma unroll
            for (int j = 0; j < 4; ++j) { v2u w; w.x = pk2(v[j].x, v[j].y); w.y = pk2(v[j].z, v[j].w); o8[64 * j] = w; } }
    }
}

constexpr int DWR = 8;
__device__ __forceinline__ void phase_conf_dw(const bf16* U, const float* wdw, const float* bdw, const float* gam, const float* bet, bf16* V, LAS unsigned char* lds, int tid, int wave, int lane) {
    LAS float* redA = (LAS float*)lds; LAS float* redB = redA + 64;
    LAS f32x2* wl = (LAS f32x2*)(lds + 1024);
    const unsigned loff = (unsigned)tid * 4u;
#pragma unroll 1
    for (int k = 0; k < CONV_K; ++k) wl[k * 512 + tid] = *(const GAS f32x2*)(wdw + k * DM + 2 * tid);
    const f32x2 bd = *(const GAS f32x2*)(bdw + 2 * tid), gg = *(const GAS f32x2*)(gam + 2 * tid), bb = *(const GAS f32x2*)(bet + 2 * tid);
    for (int chunk = blockIdx.x; chunk < MTOK / 64; chunk += gridDim.x) {
        const int r0 = chunk * 64, t0 = r0 % SEQ;
        f32x2 a[30 + DWR];
#pragma unroll
        for (int j = 0; j < 30; ++j) { unsigned u = 0u; if (t0 - 30 + j >= 0) u = *(const GAS unsigned*)((const GAS char*)U + (size_t)(r0 - 30 + j) * (DM * 2) + loff); a[j] = (f32x2){bf_lo(u), bf_hi(u)}; }
#pragma unroll 1
        for (int blk = 0; blk < 64 / DWR; ++blk) {
            const int rb = r0 + blk * DWR;
#pragma unroll
            for (int i = 0; i < DWR; ++i) { const unsigned u = *(const GAS unsigned*)((const GAS char*)U + (size_t)(rb + i) * (DM * 2) + loff); a[30 + i] = (f32x2){bf_lo(u), bf_hi(u)}; }
            f32x2 o[DWR]; float s[DWR];
#pragma unroll
            for (int i = 0; i < DWR; ++i) o[i] = bd;
#pragma unroll
            for (int k = 0; k < CONV_K; ++k) { const f32x2 w = wl[k * 512 + tid];
#pragma unroll
                for (int i = 0; i < DWR; ++i) o[i] += w * a[i + k]; }
#pragma unroll
            for (int i = 0; i < DWR; ++i) s[i] = wave_sum(o[i].x + o[i].y);
            if (lane == 0) {
#pragma unroll
                for (int i = 0; i < DWR; ++i) redA[wave * DWR + i] = s[i]; }
            __syncthreads();
#pragma unroll
            for (int i = 0; i < DWR; ++i) { float t = 0.f;
#pragma unroll
                for (int w = 0; w < 8; ++w) t += redA[w * DWR + i];
                const float mean = t * (1.f / DM); o[i] = o[i] - mean; s[i] = wave_sum(o[i].x * o[i].x + o[i].y * o[i].y); }
            if (lane == 0) {
#pragma unroll
                for (int i = 0; i < DWR; ++i) redB[wave * DWR + i] = s[i]; }
            __syncthreads();
#pragma unroll
            for (int i = 0; i < DWR; ++i) { float t = 0.f;
#pragma unroll
                for (int w = 0; w < 8; ++w) t += redB[w * DWR + i];
                const float rstd = 1.f / sqrtf(t * (1.f / DM) + LN_EPS);
                const f32x2 y = o[i] * rstd * gg + bb;
                *(GAS unsigned*)((GAS char*)V + (size_t)(rb + i) * (DM * 2) + loff) = pk2(fast_silu(y.x), fast_silu(y.y)); }
#pragma unroll
            for (int j = 0; j < 30; ++j) a[j] = a[j + DWR];
        }
    }
}

__device__ __forceinline__ void phase_shortconv(const bf16* CH, const bf16* BG, const float* wc, bf16* Y, int tid) {
    const unsigned loff = (unsigned)tid * 4u;
    const f32x2 w0 = *(const GAS f32x2*)(wc + 0 * DM + 2 * tid), w1 = *(const GAS f32x2*)(wc + 1 * DM + 2 * tid), w2 = *(const GAS f32x2*)(wc + 2 * DM + 2 * tid);
    for (int chunk = blockIdx.x; chunk < MTOK / 64; chunk += gridDim.x) {
        const int r0 = chunk * 64, t0 = r0 % SEQ;
        f32x2 p2 = (f32x2){0.f, 0.f}, p1 = p2;
        if (t0 > 0) { const unsigned ua = *(const GAS unsigned*)((const GAS char*)CH + (size_t)(r0 - 2) * (DM * 2) + loff), ub = *(const GAS unsigned*)((const GAS char*)CH + (size_t)(r0 - 1) * (DM * 2) + loff);
            p2 = (f32x2){bf_lo(ua), bf_hi(ua)}; p1 = (f32x2){bf_lo(ub), bf_hi(ub)}; }
#pragma unroll 8
        for (int i = 0; i < 64; ++i) {
            const unsigned uc = *(const GAS unsigned*)((const GAS char*)CH + (size_t)(r0 + i) * (DM * 2) + loff), ug = *(const GAS unsigned*)((const GAS char*)BG + (size_t)(r0 + i) * (DM * 2) + loff);
            const f32x2 c = (f32x2){bf_lo(uc), bf_hi(uc)}, g = (f32x2){bf_lo(ug), bf_hi(ug)};
            const f32x2 y = g * (w0 * p2 + w1 * p1 + w2 * c);
            *(GAS unsigned*)((GAS char*)Y + (size_t)(r0 + i) * (DM * 2) + loff) = pk2(y.x, y.y);
            p2 = p1; p1 = c; }
    }
}

__device__ __forceinline__ void phase_ln_router(const float* Y, const float* gam, const float* bet, float* XO, bf16* XB, const float* wr, unsigned* cnt, int* list, int* tsel, float* twt,
                                                LAS unsigned char* lds, int gw, int NGW, int tid, int lane) {
    LAS f32x4* wl = (LAS f32x4*)lds;
    for (int i = tid; i < DM * NEXP / 4; i += NTHR) wl[i] = *(const GAS f32x4*)(wr + 4 * i);
    __syncthreads();
    f32x4 gg[4], bb[4];
#pragma unroll
    for (int j = 0; j < 4; ++j) { gg[j] = *(const GAS f32x4*)(gam + 4 * lane + 256 * j); bb[j] = *(const GAS f32x4*)(bet + 4 * lane + 256 * j); }
    for (int m = gw; m < MTOK; m += NGW) {
        const GAS f32x4* yr = (const GAS f32x4*)(Y + (size_t)m * DM) + lane;
        f32x4 v[4]; float s = 0.f;
#pragma unroll
        for (int j = 0; j < 4; ++j) { v[j] = yr[64 * j]; s += (v[j].x + v[j].y) + (v[j].z + v[j].w); }
        const float mean = wave_sum(s) * (1.f / DM); float s2 = 0.f;
#pragma unroll
        for (int j = 0; j < 4; ++j) { v[j] = v[j] - mean; s2 += (v[j].x * v[j].x + v[j].y * v[j].y) + (v[j].z * v[j].z + v[j].w * v[j].w); }
        const float rstd = 1.f / sqrtf(wave_sum(s2) * (1.f / DM) + LN_EPS);
        GAS f32x4* xo = (GAS f32x4*)(XO + (size_t)m * DM) + lane;
        GAS v2u* o8 = (GAS v2u*)(XB + (size_t)m * DM) + lane;
        f32x4 la = (f32x4){0.f, 0.f, 0.f, 0.f}, lb = la;
#pragma unroll
        for (int j = 0; j < 4; ++j) { v[j] = v[j] * rstd * gg[j] + bb[j]; xo[64 * j] = v[j];
            v2u w; w.x = pk2(v[j].x, v[j].y); w.y = pk2(v[j].z, v[j].w); o8[64 * j] = w;
#pragma unroll
            for (int i = 0; i < 4; ++i) { const int c = 4 * lane + 256 * j + i; const f32x4 wa = wl[2 * c], wb = wl[2 * c + 1]; la += wa * v[j][i]; lb += wb * v[j][i]; } }
        float lg[NEXP];
#pragma unroll
        for (int e = 0; e < 4; ++e) { lg[e] = wave_sum(la[e]); lg[4 + e] = wave_sum(lb[e]); }
        if (lane == 0) {
            int e1 = 0; float v1 = lg[0];
#pragma unroll
            for (int e = 1; e < NEXP; ++e) if (lg[e] > v1) { v1 = lg[e]; e1 = e; }
            int e2 = -1; float v2 = -3.4e38f;
#pragma unroll
            for (int e = 0; e < NEXP; ++e) if (e != e1 && lg[e] > v2) { v2 = lg[e]; e2 = e; }
            const float p2 = expf(v2 - v1), w1 = 1.0f / (1.0f + p2), w2 = p2 / (1.0f + p2);
            const int s1 = (int)__hip_atomic_fetch_add(cnt + e1, 1u, RLX_AGENT), sl2 = (int)__hip_atomic_fetch_add(cnt + e2, 1u, RLX_AGENT);
            list[e1 * MTOK + s1] = m; list[e2 * MTOK + sl2] = m;
            *(int4*)(tsel + 4 * m) = make_int4(e1, s1, e2, sl2); *(float2*)(twt + 2 * m) = make_float2(w1, w2);
        }
    }
}
__device__ __forceinline__ void moe_panels(const unsigned* cnt, int (&pb)[9]) {
    int acc = 0;
#pragma unroll
    for (int e = 0; e < NEXP; ++e) { pb[e] = acc; const int c = (int)__builtin_amdgcn_readfirstlane((int)cnt[e]); acc += (c + 255) >> 8; }
    pb[NEXP] = acc;
}
__device__ __forceinline__ void phase_moe_permute(const bf16* XB, const unsigned* cnt, const int* list, bf16* AP, int gw, int NGW, int lane) {
    int pb[9]; moe_panels(cnt, pb);
    const int total = pb[NEXP] * 256;
    for (int r = gw; r < total; r += NGW) {
        const int pm = r >> 8; int e = 0;
#pragma unroll
        for (int k = 1; k < NEXP; ++k) e += (pm >= pb[k]) ? 1 : 0;
        const int c = (int)cnt[e]; int slot = r - pb[e] * 256; slot = slot < c ? slot : c - 1;
        const int m = list[e * MTOK + slot];
        const GAS v4u* src = (const GAS v4u*)(XB + (size_t)m * DM) + lane; GAS v4u* dst = (GAS v4u*)(AP + (size_t)r * DM) + lane;
        const v4u a = src[0], b = src[64]; dst[0] = a; dst[64] = b;
    }
}
__device__ __forceinline__ void phase_ln_moe(const float* X, const bf16* YM, const unsigned* cnt, const int* tsel, const float* twt, const float* gam, const float* bet, float* XO, bf16* XB, int gw, int NGW, int lane) {
    int pb[9]; moe_panels(cnt, pb);
    f32x4 gg[4], bb[4];
#pragma unroll
    for (int j = 0; j < 4; ++j) { gg[j] = *(const GAS f32x4*)(gam + 4 * lane + 256 * j); bb[j] = *(const GAS f32x4*)(bet + 4 * lane + 256 * j); }
    for (int m = gw; m < MTOK; m += NGW) {
        const int4 ts = *(const int4*)(tsel + 4 * m); const float2 tw = *(const float2*)(twt + 2 * m);
        int b1 = 0, b2 = 0;
#pragma unroll
        for (int e = 0; e < NEXP; ++e) { b1 = (ts.x == e) ? pb[e] : b1; b2 = (ts.z == e) ? pb[e] : b2; }
        const GAS v2u* y1 = (const GAS v2u*)(YM + (size_t)(b1 * 256 + ts.y) * DM) + lane; const GAS v2u* y2 = (const GAS v2u*)(YM + (size_t)(b2 * 256 + ts.w) * DM) + lane;
        const GAS f32x4* xr = (const GAS f32x4*)(X + (size_t)m * DM) + lane;
        f32x4 v[4]; float s = 0.f;
#pragma unroll
        for (int j = 0; j < 4; ++j) { const v2u p = y1[64 * j], q = y2[64 * j];
            const f32x4 a = (f32x4){bf_lo(p.x), bf_hi(p.x), bf_lo(p.y), bf_hi(p.y)}, b = (f32x4){bf_lo(q.x), bf_hi(q.x), bf_lo(q.y), bf_hi(q.y)};
            v[j] = xr[64 * j] * ALPHA_F + a * tw.x + b * tw.y; s += (v[j].x + v[j].y) + (v[j].z + v[j].w); }
        const float mean = wave_sum(s) * (1.f / DM); float s2 = 0.f;
#pragma unroll
        for (int j = 0; j < 4; ++j) { v[j] = v[j] - mean; s2 += (v[j].x * v[j].x + v[j].y * v[j].y) + (v[j].z * v[j].z + v[j].w * v[j].w); }
        const float rstd = 1.f / sqrtf(wave_sum(s2) * (1.f / DM) + LN_EPS);
        GAS f32x4* xo = (GAS f32x4*)(XO + (size_t)m * DM) + lane;
#pragma unroll
        for (int j = 0; j < 4; ++j) { v[j] = v[j] * rstd * gg[j] + bb[j]; xo[64 * j] = v[j]; }
        if (XB) { GAS v2u* o8 = (GAS v2u*)(XB + (size_t)m * DM) + lane;
#pragma unroll
            for (int j = 0; j < 4; ++j) { v2u w; w.x = pk2(v[j].x, v[j].y); w.y = pk2(v[j].z, v[j].w); o8[64 * j] = w; } }
    }
}

typedef float f32x16_t __attribute__((ext_vector_type(16)));
__device__ __forceinline__ float gelu_tanh_fast(float x) { const float u = 0.7978845608028654f * (x + 0.044715f * x * x * x); const float e = __builtin_amdgcn_exp2f(2.0f * 1.4426950408889634f * u); return x * (1.0f - __builtin_amdgcn_rcpf(1.0f + e)); }
__device__ __forceinline__ int crow(int r, int hi) { return (r & 3) + 8 * (r >> 2) + 4 * hi; }
__device__ __forceinline__ void phase_compress(const bf16* KC, const bf16* VC, const bf16* W1T, const float* pek, const float* pev, const float* wk2, const float* wv2, bf16* KCMP, bf16* VCMPT,
                                               LAS unsigned char* lds, int tid, int wave, int lane) {
    LAS float* P = (LAS float*)lds;
    const int r32 = lane & 31, hi = lane >> 5;
    for (int unit = blockIdx.x; unit < 2 * BATCH * NKV * 4; unit += gridDim.x) {
        const int kv = unit >> 7, bh = (unit >> 2) & 31, rg = unit & 3;
        const bf16* src = (kv ? VC : KC) + ((size_t)bh * SEQ + 16 * (32 * rg + r32)) * HD;
        const float* pe = kv ? pev : pek;
        const bf16* wb = W1T + (size_t)(kv * PHI + r32) * (CMP_BLOCK * HD);
        f32x16_t acc[4];
#pragma unroll
        for (int nb = 0; nb < 4; ++nb)
#pragma unroll
            for (int q = 0; q < 16; ++q) acc[nb][q] = 0.f;
#pragma unroll 2
        for (int s = 0; s < 16; ++s) {
            const int k0 = (wave * 16 + s) * 16 + 8 * hi;
            const v4u araw = *(const GAS v4u*)(src + k0);
            const f32x4 p0 = *(const GAS f32x4*)(pe + k0), p1 = *(const GAS f32x4*)(pe + k0 + 4);
            v4u af; af.x = pk2(bf_lo(araw.x) + p0.x, bf_hi(araw.x) + p0.y); af.y = pk2(bf_lo(araw.y) + p0.z, bf_hi(araw.y) + p0.w);
            af.z = pk2(bf_lo(araw.z) + p1.x, bf_hi(araw.z) + p1.y); af.w = pk2(bf_lo(araw.w) + p1.z, bf_hi(araw.w) + p1.w);
            const bf16x8 a8 = __builtin_bit_cast(bf16x8, af);
#pragma unroll
            for (int nb = 0; nb < 4; ++nb) { const bf16x8 b8 = __builtin_bit_cast(bf16x8, *(const GAS v4u*)(wb + (size_t)nb * 32 * (CMP_BLOCK * HD) + k0));
                acc[nb] = __builtin_amdgcn_mfma_f32_32x32x16_bf16(a8, b8, acc[nb], 0, 0, 0); }
        }
        __syncthreads();
#pragma unroll
        for (int nb = 0; nb < 4; ++nb)
#pragma unroll
            for (int q = 0; q < 16; ++q) P[(wave * 32 + crow(q, hi)) * 128 + nb * 32 + r32] = acc[nb][q];
        __syncthreads();
#pragma unroll
        for (int i = 0; i < 8; ++i) { const int e = tid + NTHR * i; float t = 0.f;
#pragma unroll
            for (int w = 0; w < 8; ++w) t += P[w * 4096 + e];
            P[e] = gelu_tanh_fast(t); }
        __syncthreads();
        { const int r = tid >> 4, dg = (tid & 15) * 4; const float* w2 = (kv ? wv2 : wk2) + dg; f32x4 o = (f32x4){0.f, 0.f, 0.f, 0.f};
#pragma unroll 8
          for (int jj = 0; jj < PHI; ++jj) o += *(const GAS f32x4*)(w2 + jj * HD) * P[r * 128 + jj];
          const int c = 32 * rg + r;
          if (c == NCMP) o = (f32x4){0.f, 0.f, 0.f, 0.f};
          if (kv == 0) { v2u w; w.x = pk2(o.x, o.y); w.y = pk2(o.z, o.w); *(GAS v2u*)(KCMP + ((size_t)bh * 128 + c) * HD + dg) = w; }
          else {
#pragma unroll
              for (int j = 0; j < 4; ++j) VCMPT[((size_t)bh * HD + dg + j) * 128 + c] = (bf16)f2bf(o[j]); } }
    }
    __syncthreads();
}

#ifndef ATT_LEVEL
#define ATT_LEVEL 4
#endif
constexpr int AT_KP = 144, AT_VP = 136;
constexpr int AT_K = 0, AT_V = 2 * 64 * AT_KP, AT_IMP = AT_V + 2 * 64 * AT_VP, AT_SC = AT_IMP + 4 * 2 * 64 * 33 * 4, AT_SEL = AT_SC + 64 * 33 * 4, AT_WSF = AT_SEL + 512, AT_END = AT_WSF + 8 * 64 * 4;
static_assert(AT_END <= RING_BYTES, "attention LDS map");
struct AttTensors { const bf16 *Q, *KC, *KS, *VST, *KW, *VWT, *KCMP, *VCMPT; const float* GATE; bf16* O; };
__device__ __forceinline__ float swap_max(float v) { auto rr = __builtin_amdgcn_permlane32_swap(__float_as_uint(v), __float_as_uint(v), false, false); return fmaxf(__uint_as_float(rr[0]), __uint_as_float(rr[1])); }
__device__ __forceinline__ float swap_add(float v) { auto rr = __builtin_amdgcn_permlane32_swap(__float_as_uint(v), __float_as_uint(v), false, false); return __uint_as_float(rr[0]) + __uint_as_float(rr[1]); }

__device__ __forceinline__ void phase_nsa_attn(const AttTensors T, LAS unsigned char* lds, int tid, int wave, int lane) {
    const int r32 = lane & 31, hi = lane >> 5, g = wave >> 1, th = wave & 1, tl = 32 * th + r32;
    LAS float* wsf = (LAS float*)(lds + AT_WSF) + wave * 64;
    LAS float* IMP = (LAS float*)(lds + AT_IMP); LAS float* SC = (LAS float*)(lds + AT_SC); LAS unsigned* SEL = (LAS unsigned*)(lds + AT_SEL);
    const int ldrow = tid >> 3, ldch = tid & 7;
    const float NEG = -INFINITY;
    const int vcu = (gridDim.x % 8 == 0) ? (int)((blockIdx.x % 8) * (gridDim.x / 8) + blockIdx.x / 8) : (int)blockIdx.x;
    for (int ui = 0; ; ++ui) {
        int bh, qi;
        if (gridDim.x == 256) { if (ui >= 4) break; const int s = vcu & 7; bh = vcu >> 3; qi = (ui == 0) ? s : (ui == 1) ? 31 - s : (ui == 2) ? 8 + s : 23 - s; }
        else { const int u = blockIdx.x + ui * gridDim.x; if (u >= BATCH * NKV * NSLC) break; bh = u >> 5; qi = u & 31; }
        const int b = bh >> 2, hk = bh & 3, t = qi * 64 + tl;
        const size_t mrow = (size_t)b * SEQ + t;
        bf16x8 qf[4];
        { const bf16* qp = T.Q + (((size_t)(b * NH + hk * NG + g) * SEQ + t) * HD + 8 * hi);
#pragma unroll
          for (int s = 0; s < 4; ++s) qf[s] = __builtin_bit_cast(bf16x8, *(const GAS v4u*)(qp + 16 * s)); }
        const float* gp = T.GATE + mrow * 48 + hk * 12 + g * 3;
        const float g0 = gp[0], g1 = gp[1], g2 = gp[2];
        if (tid < 65) SEL[tid] = 0u;
        f32x16_t ot0, ot1;
#define AT_LOADK(dst, kptr) dst = *(const GAS v4u*)((kptr) + (size_t)ldrow * HD + ldch * 8)
#define AT_LOADV(dst, vptr, vstride) dst = *(const GAS v4u*)((vptr) + (size_t)ldrow * (vstride) + ldch * 8)
#define AT_STORE(buf, kreg, vreg) do { *(LAS v4u*)(lds + AT_K + (buf) * 64 * AT_KP + ldrow * AT_KP + ldch * 16) = kreg; \
        LAS v2u* vd_ = (LAS v2u*)(lds + AT_V + (buf) * 64 * AT_VP + ldrow * AT_VP + ldch * 16); vd_[0] = (v2u){vreg.x, vreg.y}; vd_[1] = (v2u){vreg.z, vreg.w}; } while (0)
#define AT_QK(buf, s0, s1) do { const LAS unsigned char* kb_ = lds + AT_K + (buf) * 64 * AT_KP + r32 * AT_KP + 16 * hi; \
        _Pragma("unroll") for (int r_ = 0; r_ < 16; ++r_) { s0[r_] = 0.f; s1[r_] = 0.f; } \
        _Pragma("unroll") for (int s_ = 0; s_ < 4; ++s_) { const bf16x8 k0_ = *(const LAS bf16x8*)(kb_ + 32 * s_), k1_ = *(const LAS bf16x8*)(kb_ + 32 * AT_KP + 32 * s_); \
            s0 = __builtin_amdgcn_mfma_f32_32x32x16_bf16(k0_, qf[s_], s0, 0, 0, 0); s1 = __builtin_amdgcn_mfma_f32_32x32x16_bf16(k1_, qf[s_], s1, 0, 0, 0); } } while (0)
#define AT_PV(buf, p0, p1, o0, o1) do { \
        v4u pa_[4]; \
        pa_[0] = (v4u){cvt_pk_bf16(p0[0], p0[1]), cvt_pk_bf16(p0[2], p0[3]), cvt_pk_bf16(p0[4], p0[5]), cvt_pk_bf16(p0[6], p0[7])}; \
        pa_[1] = (v4u){cvt_pk_bf16(p0[8], p0[9]), cvt_pk_bf16(p0[10], p0[11]), cvt_pk_bf16(p0[12], p0[13]), cvt_pk_bf16(p0[14], p0[15])}; \
        pa_[2] = (v4u){cvt_pk_bf16(p1[0], p1[1]), cvt_pk_bf16(p1[2], p1[3]), cvt_pk_bf16(p1[4], p1[5]), cvt_pk_bf16(p1[6], p1[7])}; \
        pa_[3] = (v4u){cvt_pk_bf16(p1[8], p1[9]), cvt_pk_bf16(p1[10], p1[11]), cvt_pk_bf16(p1[12], p1[13]), cvt_pk_bf16(p1[14], p1[15])}; \
        const LAS unsigned char* vb_ = lds + AT_V + (buf) * 64 * AT_VP + r32 * AT_VP + 8 * hi; \
        _Pragma("unroll") for (int ks_ = 0; ks_ < 4; ++ks_) { \
            const v2u a0_ = *(const LAS v2u*)(vb_ + 32 * ks_), a1_ = *(const LAS v2u*)(vb_ + 32 * ks_ + 16); \
            const v2u b0_ = *(const LAS v2u*)(vb_ + 32 * AT_VP + 32 * ks_), b1_ = *(const LAS v2u*)(vb_ + 32 * AT_VP + 32 * ks_ + 16); \
            const bf16x8 pf_ = __builtin_bit_cast(bf16x8, pa_[ks_]); \
            o0 = __builtin_amdgcn_mfma_f32_32x32x16_bf16(pf_, __builtin_bit_cast(bf16x8, ((v4u){a0_.x, a0_.y, a1_.x, a1_.y})), o0, 0, 0, 0); \
            o1 = __builtin_amdgcn_mfma_f32_32x32x16_bf16(pf_, __builtin_bit_cast(bf16x8, ((v4u){b0_.x, b0_.y, b1_.x, b1_.y})), o1, 0, 0, 0); } } while (0)
#define AT_ROWSCALE_LOAD(f) do { if (hi == 0) wsf[r32] = (f); asm volatile("s_waitcnt lgkmcnt(0)" ::: "memory"); } while (0)
#define AT_ROWF(r_) wsf[crow(r_, hi)]

        { v4u k0, v0, k1, v1;
          const bf16* kc = T.KCMP + (size_t)bh * 128 * HD; const bf16* vc = T.VCMPT + (size_t)bh * HD * 128;
          AT_LOADK(k0, kc); AT_LOADV(v0, vc, 128); AT_LOADK(k1, kc + 64 * HD); AT_LOADV(v1, vc + 64, 128);
          __syncthreads();
          AT_STORE(0, k0, v0); AT_STORE(1, k1, v1);
          __syncthreads(); }
        {
          f32x16_t s0, s1, s2, s3;
          AT_QK(0, s0, s1); AT_QK(1, s2, s3);
          float mx = NEG;
#pragma unroll
          for (int r = 0; r < 16; ++r) { const int c = crow(r, hi);
              s0[r] = (16 * c + 31 <= t) ? s0[r] : NEG; s1[r] = (16 * (c + 32) + 31 <= t) ? s1[r] : NEG; s2[r] = (16 * (c + 64) + 31 <= t) ? s2[r] : NEG; s3[r] = (16 * (c + 96) + 31 <= t) ? s3[r] : NEG;
              mx = fmaxf(fmaxf(mx, s0[r]), fmaxf(fmaxf(s1[r], s2[r]), s3[r])); }
          mx = fmaxf(swap_max(mx), -1e30f);
          float l = 0.f;
#pragma unroll
          for (int r = 0; r < 16; ++r) { s0[r] = __builtin_amdgcn_exp2f(s0[r] - mx); s1[r] = __builtin_amdgcn_exp2f(s1[r] - mx); s2[r] = __builtin_amdgcn_exp2f(s2[r] - mx); s3[r] = __builtin_amdgcn_exp2f(s3[r] - mx);
              l += (s0[r] + s1[r]) + (s2[r] + s3[r]); }
          l = swap_add(l);
          const float inv = 1.0f / fmaxf(l, 1e-30f);
#pragma unroll
          for (int r = 0; r < 16; ++r) { s0[r] *= inv; s1[r] *= inv; s2[r] *= inv; s3[r] *= inv; }
          { LAS float* I0 = IMP + ((g * 2 + 0) * 64 + tl) * 33; LAS float* I1 = IMP + ((g * 2 + 1) * 64 + tl) * 33;
#pragma unroll
            for (int a = 0; a < 4; ++a) { const int n = 2 * a + hi;
                I0[n] = (s0[4 * a] + s0[4 * a + 1]) + (s0[4 * a + 2] + s0[4 * a + 3]); I1[n + 1] = s0[4 * a + 3];
                I0[n + 8] = (s1[4 * a] + s1[4 * a + 1]) + (s1[4 * a + 2] + s1[4 * a + 3]); I1[n + 9] = s1[4 * a + 3];
                I0[n + 16] = (s2[4 * a] + s2[4 * a + 1]) + (s2[4 * a + 2] + s2[4 * a + 3]); I1[n + 17] = s2[4 * a + 3];
                I0[n + 24] = (s3[4 * a] + s3[4 * a + 1]) + (s3[4 * a + 2] + s3[4 * a + 3]); if (n + 25 < 33) I1[n + 25] = s3[4 * a + 3]; } }
          f32x16_t o0, o1;
#pragma unroll
          for (int r = 0; r < 16; ++r) { o0[r] = 0.f; o1[r] = 0.f; }
          AT_PV(0, s0, s1, o0, o1); AT_PV(1, s2, s3, o0, o1);
          AT_ROWSCALE_LOAD(g0);
#pragma unroll
          for (int r = 0; r < 16; ++r) { const float f = AT_ROWF(r); ot0[r] = o0[r] * f; ot1[r] = o1[r] * f; }
        }
        __syncthreads();
        { const int st = tid >> 3, grp = tid & 7;
#pragma unroll
          for (int i = 0; i < 4; ++i) { const int n = 4 * grp + i; float imp = 0.f;
#pragma unroll
              for (int gg = 0; gg < 4; ++gg) { imp += IMP[((gg * 2 + 0) * 64 + st) * 33 + n]; if (n > 0) imp += IMP[((gg * 2 + 1) * 64 + st) * 33 + n]; }
              const bool forced = (n == 0) || (n == qi) || (n == qi - 1);
              SC[st * 33 + n] = forced ? 1e4f : ((n <= qi) ? imp : -1e30f); }
          __syncthreads();
          unsigned bits = 0u;
#pragma unroll
          for (int i = 0; i < 4; ++i) { const int n = 4 * grp + i; const float sn = SC[st * 33 + n]; int rank = 0;
#pragma unroll 8
              for (int m2 = 0; m2 < NSLC; ++m2) { const float sm = SC[st * 33 + m2]; rank += (sm > sn || (sm == sn && m2 < n)) ? 1 : 0; }
              if (rank < TOPN && n <= qi) bits |= 1u << n; }
          if (bits) { __hip_atomic_fetch_or(SEL + st, bits, __ATOMIC_RELAXED, __HIP_MEMORY_SCOPE_WORKGROUP); __hip_atomic_fetch_or(SEL + 64, bits, __ATOMIC_RELAXED, __HIP_MEMORY_SCOPE_WORKGROUP); }
          __syncthreads(); }
        const unsigned selmask = SEL[tl]; const unsigned selunion = SEL[64];
#pragma unroll 1
        for (int mode = 0; mode < (ATT_LEVEL >= 4 ? 2 : (ATT_LEVEL == 3 ? 1 : 0)); ++mode) {
            const bf16* Kb = (mode == 0 ? T.KS : T.KW) + (size_t)bh * SEQ * HD; const bf16* Vb = (mode == 0 ? T.VST : T.VWT) + (size_t)bh * HD * SEQ;
            const int jlo = qi >= 8 ? qi - 8 : 0;
            unsigned todo = (mode == 0) ? selunion : (((2u << qi) - 1u) & ~((1u << jlo) - 1u));
            float m = -1e30f, l = 0.f; f32x16_t o0, o1;
#pragma unroll
            for (int r = 0; r < 16; ++r) { o0[r] = 0.f; o1[r] = 0.f; }
            int cur = 0;
            { const int j = __builtin_ctz(todo); v4u kr, vr; AT_LOADK(kr, Kb + (size_t)j * 64 * HD); AT_LOADV(vr, Vb + j * 64, SEQ); AT_STORE(0, kr, vr); }
            __syncthreads();
#pragma unroll 1
            while (todo) {
                const int j = __builtin_ctz(todo); todo &= todo - 1u;
                v4u kr, vr;
                if (todo) { const int jn = __builtin_ctz(todo); AT_LOADK(kr, Kb + (size_t)jn * 64 * HD); AT_LOADV(vr, Vb + jn * 64, SEQ); }
                const bool mine = (mode == 0) ? ((selmask >> j) & 1u) != 0u : true;
                if (__any(mine)) {
                    f32x16_t s0, s1;
                    AT_QK(cur, s0, s1);
                    float mx = NEG;
                    const bool diag = (j == qi), tail = (mode == 1 && j == qi - 8);
#pragma unroll
                    for (int r = 0; r < 16; ++r) { const int k0 = crow(r, hi), k1 = k0 + 32;
                        bool v0 = mine, v1 = mine;
                        if (diag) { v0 = v0 && (k0 <= tl); v1 = v1 && (k1 <= tl); }
                        if (tail) { v0 = v0 && (k0 > tl); v1 = v1 && (k1 > tl); }
                        s0[r] = v0 ? s0[r] : NEG; s1[r] = v1 ? s1[r] : NEG; mx = fmaxf(mx, fmaxf(s0[r], s1[r])); }
                    mx = swap_max(mx);
                    const float mn = fmaxf(m, mx);
                    if (__any(mn > m)) { const float f = __builtin_amdgcn_exp2f(m - mn); l *= f; m = mn; AT_ROWSCALE_LOAD(f);
#pragma unroll
                        for (int r = 0; r < 16; ++r) { const float fr_ = AT_ROWF(r); o0[r] *= fr_; o1[r] *= fr_; } }
                    float ls = 0.f;
#pragma unroll
                    for (int r = 0; r < 16; ++r) { s0[r] = __builtin_amdgcn_exp2f(s0[r] - m); s1[r] = __builtin_amdgcn_exp2f(s1[r] - m); ls += s0[r] + s1[r]; }
                    l += ls;
                    AT_PV(cur, s0, s1, o0, o1);
                }
                if (todo) AT_STORE(cur ^ 1, kr, vr);
                __syncthreads();
                cur ^= 1;
            }
            l = swap_add(l);
            AT_ROWSCALE_LOAD((mode == 0 ? g1 : g2) / fmaxf(l, 1e-30f));
#pragma unroll
            for (int r = 0; r < 16; ++r) { const float f = AT_ROWF(r); ot0[r] += o0[r] * f; ot1[r] += o1[r] * f; }
        }
        { bf16* ob = T.O + ((size_t)b * SEQ + qi * 64 + 32 * th) * DM + (hk * NG + g) * HD + r32;
#pragma unroll
          for (int r = 0; r < 16; ++r) { bf16* p = ob + (size_t)crow(r, hi) * DM; if (ATT_LEVEL < 2) { ot0[r] = 0.f; ot1[r] = 0.f; } p[0] = (bf16)f2bf(ot0[r]); p[32] = (bf16)f2bf(ot1[r]); } }
#undef AT_LOADK
#undef AT_LOADV
#undef AT_STORE
#undef AT_QK
#undef AT_PV
#undef AT_ROWSCALE_LOAD
#undef AT_ROWF
    }
    __syncthreads();
}

enum { PH_PRO = 0,
       PH0_WIN, PH0_DW, PH0_WOUT, PH0_LN1, PH0_GU, PH0_DOWN, PH0_LN2,
       PH1_WIN, PH1_CONV, PH1_WOUT, PH1_LN1, PH1_PERM, PH1_MGU, PH1_MDOWN, PH1_LN2,
       PH2_WIN, PH2_CMP, PH2_ATT, PH2_WOUT, PH2_LN1, PH2_GU, PH2_DOWN, PH2_LN2,
       PH3_WIN, PH3_DW, PH3_WOUT, PH3_LN1, PH3_PERM, PH3_MGU, PH3_MDOWN, PH3_LN2, PH_END };

#ifndef FAST_PREFIX
#define FAST_PREFIX 2
#endif
#ifndef ONE_LAUNCH
#define ONE_LAUNCH 0
#endif
constexpr int kSubEnd[8] = {PH0_LN1, PH0_LN2, PH1_LN1, PH1_LN2, PH2_LN1, PH2_LN2, PH3_LN1, PH3_LN2};
constexpr int FAST_END = FAST_PREFIX == 0 ? 0 : kSubEnd[FAST_PREFIX - 1] + 1;

struct Ctx { LAS unsigned char* lds; int tid, lane, wave, G, bx, gw, NGW, lo, hi; XcdBarrier bar; };
#define IN(k) (c.lo <= (k) && (k) < c.hi)
#define SEAM(k) do { if (IN(k) && IN((k) + 1)) xcd_barrier(c.bar); } while (0)
#define WSP(T, off) ((T*)(a.ws + (off)))

template <int L, int PH, bool FFN_SIDE> __device__ __forceinline__ void ln_plain(const FArgs& a, const Ctx& c) {
    if (IN(PH)) { const float* g = a.in[FFN_SIDE ? I_LFG : I_LMG] + L * DM; const float* b = a.in[FFN_SIDE ? I_LFB : I_LMB] + L * DM;
        constexpr bool LAST = FFN_SIDE && L == DEPTH - 1;
        phase_ln(WSP(float, WS_X), g, b, LAST ? a.out : WSP(float, WS_X), LAST ? (bf16*)nullptr : WSP(bf16, WS_XBF), c.gw, c.NGW, c.lane); }
    SEAM(PH);
}
template <int L, int PH> __device__ __forceinline__ void ln_router(const FArgs& a, const Ctx& c) {
    constexpr int f = L / 2;
    if (IN(PH)) phase_ln_router(WSP(float, WS_X), a.in[I_LMG] + L * DM, a.in[I_LMB] + L * DM, WSP(float, WS_X), WSP(bf16, WS_XBF), a.in[I_MWR] + (size_t)f * DM * NEXP,
                                (unsigned*)WSP(unsigned, WS_CTL) + CW_MOE + 64 * f, WSP(int, MS_LIST), WSP(int, MS_TSEL), WSP(float, MS_TWT), c.lds, c.gw, c.NGW, c.tid, c.lane);
    SEAM(PH);
}
template <int L, int PH> __device__ __forceinline__ void conformer_mixer(const FArgs& a, const Ctx& c) {
    constexpr int j = L / 3;
    bf16* U = WSP(bf16, A_U); bf16* V = WSP(bf16, A_V); float* X = WSP(float, WS_X);
    if (IN(PH)) { pg8::Gemm g{WSP(bf16, WS_XBF), WSP(bf16, W_CONF_IN + (size_t)j * 4 * MiB), DM, DM, 0}; pg8::StaticOrder S; S.init(MTOK / 256, 8, c.G, c.bx);
        pg8::EpiPair<0> E{U, DM}; pg8::gemm_phase<pg8::EpiPair<0>, pg8::StaticOrder, true, true>(c.lds, g, S, E); } SEAM(PH);
    if (IN(PH + 1)) phase_conf_dw(U, a.in[I_CWDW] + (size_t)j * CONV_K * DM, a.in[I_CBDW] + j * DM, a.in[I_CLNG] + j * DM, a.in[I_CLNB] + j * DM, V, c.lds, c.tid, c.wave, c.lane);
    SEAM(PH + 1);
    if (IN(PH + 2)) { pg8::Gemm g{V, WSP(bf16, W_CONF_OUT + (size_t)j * 2 * MiB), DM, DM, 0}; pg8::StaticOrder S; S.init(MTOK / 256, 4, c.G, c.bx);
        pg8::EpiResid E{L == 0 ? a.in[I_X] : X, X, DM}; pg8::gemm_phase<pg8::EpiResid, pg8::StaticOrder, false, true>(c.lds, g, S, E); } SEAM(PH + 2);
}
template <int L, int PH> __device__ __forceinline__ void sc_mixer(const FArgs& a, const Ctx& c) {
    constexpr int j = L / 3;
    bf16* CH = WSP(bf16, A_CH); bf16* BG = WSP(bf16, A_BG); bf16* YS = WSP(bf16, A_YSC); float* X = WSP(float, WS_X);
    if (IN(PH)) { pg8::Gemm g{WSP(bf16, WS_XBF), WSP(bf16, W_SC_IN), DM, DM, 0}; pg8::StaticOrder S; S.init(MTOK / 256, 12, c.G, c.bx);
        pg8::EpiSC E{CH, BG}; pg8::gemm_phase<pg8::EpiSC, pg8::StaticOrder, true, true>(c.lds, g, S, E); } SEAM(PH);
    if (IN(PH + 1)) phase_shortconv(CH, BG, a.in[I_SWCONV] + (size_t)j * SHORT_K * DM, YS, c.tid);
    SEAM(PH + 1);
    if (IN(PH + 2)) { pg8::Gemm g{YS, WSP(bf16, W_SC_OUT), DM, DM, 0}; pg8::StaticOrder S; S.init(MTOK / 256, 4, c.G, c.bx);
        pg8::EpiResid E{X, X, DM}; pg8::gemm_phase<pg8::EpiResid, pg8::StaticOrder, false, true>(c.lds, g, S, E); } SEAM(PH + 2);
}
template <int L, int PH> __device__ __forceinline__ void dense_ffn(const FArgs& a, const Ctx& c) {
    constexpr int f = L / 2;
    bf16* HB = WSP(bf16, WS_H); float* X = WSP(float, WS_X);
    if (IN(PH)) { pg8::Gemm g{WSP(bf16, WS_XBF), WSP(bf16, W_FFN_GU + (size_t)f * 11 * MiB), DM, DM, 0}; pg8::StaticOrder S; S.init(MTOK / 256, DFF / 128, c.G, c.bx);
        pg8::EpiPair<1> E{HB, DFF}; pg8::gemm_phase<pg8::EpiPair<1>, pg8::StaticOrder, true, true>(c.lds, g, S, E); } SEAM(PH);
    if (IN(PH + 1)) { pg8::Gemm g{HB, WSP(bf16, W_FFN_D + (size_t)f * DM * DFF * 2), DFF, DFF, 0}; pg8::StaticOrder S; S.init(MTOK / 256, 4, c.G, c.bx);
        pg8::EpiResid E{X, X, DM}; pg8::gemm_phase<pg8::EpiResid, pg8::StaticOrder, false, true>(c.lds, g, S, E); } SEAM(PH + 1);
}
template <int L, int PH> __device__ __forceinline__ void moe_ffn(const FArgs& a, const Ctx& c) {
    constexpr int f = L / 2;
    const unsigned* cnt = (const unsigned*)WSP(unsigned, WS_CTL) + CW_MOE + 64 * f;
    bf16* AP = WSP(bf16, A_PERM); bf16* HB = WSP(bf16, WS_H);
    if (IN(PH)) phase_moe_permute(WSP(bf16, WS_XBF), cnt, WSP(int, MS_LIST), AP, c.gw, c.NGW, c.lane);
    SEAM(PH);
    if (IN(PH + 1)) { pg8::Gemm g{AP, WSP(bf16, W_MOE_GU + (size_t)f * 112 * MiB), DM, DM, (size_t)14 * MiB}; pg8::GroupedOrder S; moe_panels(cnt, S.pb); S.init(S.pb[NEXP], DFFE / 128, c.G, c.bx);
        pg8::EpiPair<1> E{HB, DFFE}; pg8::gemm_phase<pg8::EpiPair<1>, pg8::GroupedOrder, true, true>(c.lds, g, S, E); } SEAM(PH + 1);
    if (IN(PH + 2)) { pg8::Gemm g{HB, WSP(bf16, W_MOE_D + (size_t)f * 56 * MiB), DFFE, DFFE, (size_t)7 * MiB}; pg8::GroupedOrder S; moe_panels(cnt, S.pb); S.init(S.pb[NEXP], 4, c.G, c.bx);
        pg8::EpiBf16 E{AP, DM, 1.0f}; pg8::gemm_phase<pg8::EpiBf16, pg8::GroupedOrder, true, true>(c.lds, g, S, E); } SEAM(PH + 2);
    if (IN(PH + 3)) { constexpr bool LAST = L == DEPTH - 1;
        phase_ln_moe(WSP(float, WS_X), AP, cnt, WSP(int, MS_TSEL), WSP(float, MS_TWT), a.in[I_LFG] + L * DM, a.in[I_LFB] + L * DM, LAST ? a.out : WSP(float, WS_X), LAST ? (bf16*)nullptr : WSP(bf16, WS_XBF), c.gw, c.NGW, c.lane); }
    SEAM(PH + 3);
}

template <int L, int PH> __device__ __forceinline__ void nsa_mixer(const FArgs& a, const Ctx& c) {
    float* X = WSP(float, WS_X);
    if (IN(PH)) { pg8::Gemm g{WSP(bf16, WS_XBF), WSP(bf16, W_NSA_IN), DM, DM, 0}; pg8::StaticOrder S; S.init(MTOK / 256, 11, c.G, c.bx);
        pg8::EpiNSA E{WSP(bf16, A_Q), WSP(bf16, A_KC), WSP(float, A_GATE)}; pg8::gemm_phase<pg8::EpiNSA, pg8::StaticOrder, true, true>(c.lds, g, S, E); } SEAM(PH);
    if (IN(PH + 1)) phase_compress(WSP(bf16, A_KC), WSP(bf16, A_VCT), WSP(bf16, W_CMP1), a.in[I_NPEK], a.in[I_NPEV], a.in[I_NWK2], a.in[I_NWV2], WSP(bf16, A_KCMP), WSP(bf16, A_VCMPT), c.lds, c.tid, c.wave, c.lane);
    SEAM(PH + 1);
    if (IN(PH + 2)) { AttTensors T{WSP(bf16, A_Q), WSP(bf16, A_KC), WSP(bf16, A_KS), WSP(bf16, A_VST), WSP(bf16, A_KW), WSP(bf16, A_VWT), WSP(bf16, A_KCMP), WSP(bf16, A_VCMPT), WSP(float, A_GATE), WSP(bf16, A_O)};
        phase_nsa_attn(T, c.lds, c.tid, c.wave, c.lane); }
    SEAM(PH + 2);
    if (IN(PH + 3)) { pg8::Gemm g{WSP(bf16, A_O), WSP(bf16, W_NSA_OUT), DM, DM, 0}; pg8::StaticOrder S; S.init(MTOK / 256, 4, c.G, c.bx);
        pg8::EpiResid E{X, X, DM}; pg8::gemm_phase<pg8::EpiResid, pg8::StaticOrder, false, true>(c.lds, g, S, E); } SEAM(PH + 3);
}

__global__ void __launch_bounds__(NTHR, 2) mega(FArgs a) {
    extern __shared__ __attribute__((aligned(16))) unsigned char lds_raw[];
    Ctx c; c.lds = (LAS unsigned char*)lds_raw;
    c.tid = threadIdx.x; c.lane = c.tid & 63; c.wave = __builtin_amdgcn_readfirstlane(c.tid >> 6);
    c.G = gridDim.x; c.bx = blockIdx.x; const int vcu = (c.G % 8 == 0) ? (c.bx % 8) * (c.G / 8) + c.bx / 8 : c.bx;
    c.gw = vcu * NWAVES + c.wave; c.NGW = c.G * NWAVES; c.lo = a.ph_lo; c.hi = a.ph_hi;
    for (int u = c.tid; u < (LDS_BYTES - LDSCTL_OFF) / 4; u += NTHR) ((LAS unsigned*)(c.lds + LDSCTL_OFF))[u] = 0u;
    __syncthreads();
    c.bar = xcd_barrier_post((unsigned*)(a.ws + WS_CTL) + CW_BAR, (volatile LAS unsigned*)(c.lds + LDSCTL_OFF + 32));

    if (IN(PH_PRO)) phase_prologue(a, c.lds, c.gw, c.NGW, c.wave, c.lane);
    SEAM(PH_PRO);
    conformer_mixer<0, PH0_WIN>(a, c); ln_plain<0, PH0_LN1, false>(a, c); dense_ffn<0, PH0_GU>(a, c); ln_plain<0, PH0_LN2, true>(a, c);
#if FAST_PREFIX > 2
    sc_mixer<1, PH1_WIN>(a, c); ln_router<1, PH1_LN1>(a, c); moe_ffn<1, PH1_PERM>(a, c);
#endif
#if FAST_PREFIX > 4
    nsa_mixer<2, PH2_WIN>(a, c); ln_plain<2, PH2_LN1, false>(a, c); dense_ffn<2, PH2_GU>(a, c); ln_plain<2, PH2_LN2, true>(a, c);
#endif
#if FAST_PREFIX > 6
    conformer_mixer<3, PH3_WIN>(a, c); ln_router<3, PH3_LN1>(a, c); moe_ffn<3, PH3_PERM>(a, c);
#endif
}
#undef IN
#undef SEAM
#undef WSP


#ifndef DEBUG_MODE
#define DEBUG_MODE 0
#endif
__global__ void dbg_sqdiff(const float* a, const float* b, size_t n, float* acc2) {
    float d = 0.f, r = 0.f;
    for (size_t i = (size_t)blockIdx.x * blockDim.x + threadIdx.x; i < n; i += (size_t)gridDim.x * blockDim.x) { const float x = a[i], y = b[i]; const float t = x - y; d += (t == t) ? t * t : 1e6f; r += y * y; }
    d = wave_sum(d); r = wave_sum(r);
    if ((threadIdx.x & 63) == 0) { atomicAdd(acc2, d); atomicAdd(acc2 + 1, r); }
}
__global__ void dbg_scale(float* out, size_t n, const float* acc2) {
    float e = sqrtf(acc2[0] / fmaxf(acc2[1], 1e-30f)); e = e < 10.f ? e : 10.f;
    for (size_t i = (size_t)blockIdx.x * blockDim.x + threadIdx.x; i < n; i += (size_t)gridDim.x * blockDim.x) out[i] *= (1.0f + e);
}

static void gemm(hipStream_t st, const float* A, int lda, const int* gather, const int* mcount, int M, const float* W, int ldw, int N, int K, float* C, int ldc) {
    hipLaunchKernelGGL(ngemm, dim3((N + 127) / 128, (M + 127) / 128), dim3(256), 0, st, A, lda, gather, mcount, M, W, ldw, N, K, C, ldc);
}
struct NaiveBufs { float *BA, *BB, *BC, *BD; int *cnt, *list, *tsel; float *twt, *cmp; };
static void naive_sublayer(hipStream_t stream, const float* const* in, int s, const float* x, float* xo, const NaiveBufs& nb) {
    const int i = s / 2, kind = i % 3, j = i / 3, f = i / 2, EW = 256;
    constexpr int CR = MTOK / 2, CB = BATCH / 2;
    float *BA = nb.BA, *BB = nb.BB, *BC = nb.BC, *BD = nb.BD;
    for (int c = 0; c < 2; ++c) {
        const float* xc = x + (size_t)c * CR * DM; float* xoc = xo + (size_t)c * CR * DM;
        if ((s & 1) == 0) {
            if (kind == 0) {
                gemm(stream, xc, DM, nullptr, nullptr, CR, in[I_CWIN] + (size_t)j * DM * 2 * DM, 2 * DM, 2 * DM, DM, BA, 2 * DM);
                hipLaunchKernelGGL(n_glu, dim3(CR * DM / EW), dim3(EW), 0, stream, BA, BB, CR);
                hipLaunchKernelGGL(n_conf_dw, dim3(CR), dim3(256), 0, stream, BB, in[I_CWDW] + (size_t)j * CONV_K * DM, in[I_CBDW] + j * DM, in[I_CLNG] + j * DM, in[I_CLNB] + j * DM, BD);
                gemm(stream, BD, DM, nullptr, nullptr, CR, in[I_CWOUT] + (size_t)j * DM * DM, DM, DM, DM, BC, DM);
            } else if (kind == 1) {
                gemm(stream, xc, DM, nullptr, nullptr, CR, in[I_SWIN] + (size_t)j * DM * 3 * DM, 3 * DM, 3 * DM, DM, BA, 3 * DM);
                hipLaunchKernelGGL(n_shortconv, dim3(CR * DM / EW), dim3(EW), 0, stream, BA, in[I_SWCONV] + (size_t)j * SHORT_K * DM, BD, CR);
                gemm(stream, BD, DM, nullptr, nullptr, CR, in[I_SWOUT] + (size_t)j * DM * DM, DM, DM, DM, BC, DM);
            } else {
                gemm(stream, xc, DM, nullptr, nullptr, CR, in[I_NWIN] + (size_t)j * DM * NSA_COLS, NSA_COLS, NSA_COLS, DM, BA, NSA_COLS);
                hipLaunchKernelGGL(n_compress, dim3(NCMP, CB * NKV, 2), dim3(128), 0, stream, BA, in[I_NPEK] + j * CMP_BLOCK * HD, in[I_NPEV] + j * CMP_BLOCK * HD,
                                   in[I_NWK1] + (size_t)j * CMP_BLOCK * HD * PHI, in[I_NWK2] + j * PHI * HD, in[I_NWV1] + (size_t)j * CMP_BLOCK * HD * PHI, in[I_NWV2] + j * PHI * HD, nb.cmp);
                hipLaunchKernelGGL(n_nsa_attn, dim3(SEQ / 64, CB * NKV), dim3(256), 0, stream, BA, nb.cmp, BD);
                gemm(stream, BD, DM, nullptr, nullptr, CR, in[I_NWOUT] + (size_t)j * DM * DM, DM, DM, DM, BC, DM);
            }
            hipLaunchKernelGGL(n_ln_res, dim3(CR), dim3(256), 0, stream, xc, BC, in[I_LMG] + i * DM, in[I_LMB] + i * DM, xoc);
        } else {
            if (i % 2 == 0) {
                gemm(stream, xc, DM, nullptr, nullptr, CR, in[I_FWG] + (size_t)f * DM * DFF, DFF, DFF, DM, BA, DFF);
                gemm(stream, xc, DM, nullptr, nullptr, CR, in[I_FWU] + (size_t)f * DM * DFF, DFF, DFF, DM, BB, DFF);
                hipLaunchKernelGGL(n_swiglu, dim3((unsigned)(((size_t)CR * DFF + EW - 1) / EW)), dim3(EW), 0, stream, BA, BB, BA, (const int*)nullptr, CR, DFF);
                gemm(stream, BA, DFF, nullptr, nullptr, CR, in[I_FWD] + (size_t)f * DFF * DM, DM, DM, DFF, BC, DM);
            } else {
                (void)hipMemsetAsync(nb.cnt, 0, 256, stream);
                (void)hipMemsetAsync(BC, 0, (size_t)CR * DM * 4, stream);
                hipLaunchKernelGGL(n_router, dim3(CR / 4), dim3(256), 0, stream, xc, in[I_MWR] + (size_t)f * DM * NEXP, nb.cnt, nb.list, nb.tsel, nb.twt);
                for (int e = 0; e < NEXP; ++e) {
                    const size_t wo = ((size_t)f * NEXP + e) * DM * DFFE;
                    gemm(stream, xc, DM, nb.list + e * MOE_CAP, nb.cnt + e, MOE_CAP, in[I_MWG] + wo, DFFE, DFFE, DM, BA, DFFE);
                    gemm(stream, xc, DM, nb.list + e * MOE_CAP, nb.cnt + e, MOE_CAP, in[I_MWU] + wo, DFFE, DFFE, DM, BB, DFFE);
                    hipLaunchKernelGGL(n_swiglu, dim3((unsigned)(((size_t)MOE_CAP * DFFE + EW - 1) / EW)), dim3(EW), 0, stream, BA, BB, BA, (const int*)(nb.cnt + e), MOE_CAP, DFFE);
                    gemm(stream, BA, DFFE, nullptr, nb.cnt + e, MOE_CAP, in[I_MWD] + wo, DM, DM, DFFE, BD, DM);
                    hipLaunchKernelGGL(n_moe_scatter, dim3(MOE_CAP), dim3(256), 0, stream, BD, nb.cnt, nb.list, nb.tsel, nb.twt, e, BC);
                }
            }
            hipLaunchKernelGGL(n_ln_res, dim3(CR), dim3(256), 0, stream, xc, BC, in[I_LFG] + i * DM, in[I_LFB] + i * DM, xoc);
        }
    }
}

extern "C" void kernel_launch(void* const* d_in, const int* in_sizes, int n_in, void* d_out, int out_size, void* d_ws, size_t ws_size, hipStream_t stream) {
    (void)in_sizes; (void)out_size;
    static int grid = 0;
    if (grid == 0) {
        if (n_in != 29 || ws_size < WS_END) { fprintf(stderr, "kernel_launch: unexpected n_in %d / ws_size %zu (need %zu)\n", n_in, ws_size, (size_t)WS_END); grid = -1; return; }
        int dev = 0, cus = 0, per_cu = 0;
        if (hipGetDevice(&dev) != hipSuccess || hipDeviceGetAttribute(&cus, hipDeviceAttributeMultiprocessorCount, dev) != hipSuccess) { grid = -1; return; }
        if (hipFuncSetAttribute((const void*)mega, hipFuncAttributeMaxDynamicSharedMemorySize, LDS_BYTES) != hipSuccess) { fprintf(stderr, "kernel_launch: hipFuncSetAttribute failed\n"); grid = -1; return; }
        if (hipOccupancyMaxActiveBlocksPerMultiprocessor(&per_cu, (const void*)mega, NTHR, LDS_BYTES) != hipSuccess || per_cu < 1) { fprintf(stderr, "kernel_launch: occupancy query says %d\n", per_cu); }
        (void)hipGetLastError();
        grid = cus;
    }
    if (grid < 0) return;
    unsigned char* ws = (unsigned char*)d_ws;
    const float* in[29]; for (int i = 0; i < 29; ++i) in[i] = (const float*)d_in[i];
    auto run_fast = [&]() {
        (void)hipMemsetAsync(ws + WS_CTL, 0, CTL_ZERO_BYTES, stream);
        FArgs a{}; for (int i = 0; i < 29; ++i) a.in[i] = in[i];
        a.out = (float*)d_out; a.ws = ws;
        if (ONE_LAUNCH) { a.ph_lo = 0; a.ph_hi = FAST_END; hipLaunchKernelGGL(mega, dim3(grid), dim3(NTHR), LDS_BYTES, stream, a); }
        else for (int p = 0; p < FAST_END; ++p) { a.ph_lo = p; a.ph_hi = p + 1;
#ifdef REP_PHASE
            const int nrep = (p == REP_PHASE) ? 1 + REP_N : 1;
#else
            const int nrep = 1;
#endif
            for (int r = 0; r < nrep; ++r) hipLaunchKernelGGL(mega, dim3(grid), dim3(NTHR), LDS_BYTES, stream, a); }
    };
    NaiveBufs nb; unsigned char* nbase = ws + WS_ACT;
    nb.BA = (float*)nbase; nb.BB = (float*)(nbase + 96 * MiB); nb.BC = (float*)(nbase + 192 * MiB); nb.BD = (float*)(nbase + 224 * MiB);
    unsigned char* sm = nbase + 256 * MiB; nb.cnt = (int*)sm; nb.list = nb.cnt + 64; nb.tsel = nb.list + NEXP * MOE_CAP; nb.twt = (float*)(nb.tsel + (MTOK / 2) * 4); nb.cmp = (float*)(sm + 2 * MiB);
    float* X = (float*)(ws + WS_X);
#if DEBUG_MODE
    static_assert(FAST_PREFIX >= 1 && FAST_PREFIX <= 6 && !ONE_LAUNCH, "debug builds compare a fast prefix that leaves its result in X");
    float* XF1 = (float*)(ws + W_MOE_GU + 112 * MiB);
    float* acc2 = (float*)(sm + 1 * MiB);
    run_fast();
    (void)hipMemcpyAsync(XF1, X, (size_t)MTOK * DM * 4, hipMemcpyDeviceToDevice, stream);
    (void)hipMemsetAsync(acc2, 0, 64, stream);
    if (DEBUG_MODE == 2) { run_fast(); hipLaunchKernelGGL(dbg_sqdiff, dim3(2048), dim3(256), 0, stream, (const float*)X, (const float*)XF1, (size_t)MTOK * DM, acc2); }
    { const float* x = in[I_X];
      for (int s = 0; s < 8; ++s) { float* xo = (s == 7) ? (float*)d_out : X; naive_sublayer(stream, in, s, x, xo, nb); x = xo;
          if (DEBUG_MODE == 1 && s == FAST_PREFIX - 1) hipLaunchKernelGGL(dbg_sqdiff, dim3(2048), dim3(256), 0, stream, (const float*)XF1, (const float*)X, (size_t)MTOK * DM, acc2); } }
    hipLaunchKernelGGL(dbg_scale, dim3(2048), dim3(256), 0, stream, (float*)d_out, (size_t)MTOK * DM, (const float*)acc2);
#else
    if (FAST_END > 0) run_fast();
    if (FAST_PREFIX < 8) {
        const float* x = FAST_PREFIX == 0 ? in[I_X] : (const float*)X;
        for (int s = FAST_PREFIX; s < 8; ++s) { float* xo = (s == 7) ? (float*)d_out : X; naive_sublayer(stream, in, s, x, xo, nb); x = xo; }
    }
#endif
}
```

```cpp
#define FAST_PREFIX 8
#define ONE_LAUNCH 1
#include <hip/hip_runtime.h>
#include <cstdio>
#include <cstdint>

constexpr int BATCH = 8, SEQ = 2048, DM = 1024, MTOK = BATCH * SEQ, DEPTH = 4;
constexpr int CONV_K = 31, SHORT_K = 3;
constexpr int NH = 16, NKV = 4, NG = 4, HD = 64;
constexpr int CMP_BLOCK = 32, CMP_STRIDE = 16, NCMP = (SEQ - CMP_BLOCK) / CMP_STRIDE + 1;
constexpr int SLC_BLOCK = 64, NSLC = SEQ / SLC_BLOCK, TOPN = 16, WINDOW = 512, PHI = 128;
constexpr int NSA_COLS = NH * HD + 6 * NKV * HD + 3 * NH;
constexpr int DFF = 2816, NEXP = 8, DFFE = 3584;
constexpr float LN_EPS = 1e-5f;
#define ALPHA_F 1.681792830507429f

typedef float f32x16 __attribute__((ext_vector_type(16)));

__device__ __forceinline__ float wave_sum(float v) {
#pragma unroll
    for (int o = 1; o < 64; o <<= 1) v += __shfl_xor(v, o);
    return v;
}
__device__ __forceinline__ float block_sum256(float v, float* red) {
    v = wave_sum(v);
    __syncthreads();
    if ((threadIdx.x & 63) == 0) red[threadIdx.x >> 6] = v;
    __syncthreads();
    return (red[0] + red[1]) + (red[2] + red[3]);
}
__device__ __forceinline__ float sigmoidf_(float x) { return 1.0f / (1.0f + expf(-x)); }
__device__ __forceinline__ float siluf_(float x) { return x / (1.0f + expf(-x)); }
__device__ __forceinline__ float gelu_tanh(float x) { return 0.5f * x * (1.0f + tanhf(0.7978845608028654f * (x + 0.044715f * x * x * x))); }

__global__ __launch_bounds__(256) void ngemm(const float* __restrict__ A, int lda, const int* __restrict__ gather, const int* __restrict__ mcount, int M,
                                             const float* __restrict__ W, int ldw, int N, int K, float* __restrict__ C, int ldc) {
    __shared__ float As[128][17];
    __shared__ float Bs[16][132];
    if (mcount) { const int mc = *mcount; M = mc < M ? mc : M; }
    const int bm = blockIdx.y * 128, bn = blockIdx.x * 128;
    if (bm >= M) return;
    const int tid = threadIdx.x, lane = tid & 63, w = tid >> 6, wr = w >> 1, wc = w & 1;
    const int ar = tid >> 1, ak = (tid & 1) * 8;
    const int arow = bm + ar; const bool aok = arow < M;
    const int asrc = aok ? (gather ? gather[arow] : arow) : 0;
    const float* ap = A + (size_t)asrc * lda + ak;
    const int bk = tid >> 4, bc = (tid & 15) * 8;
    const bool bok = (bn + bc + 8) <= N;
    const float* bp = W + (size_t)bk * ldw + bn + bc;
    f32x16 acc[2][2];
#pragma unroll
    for (int i = 0; i < 2; ++i)
#pragma unroll
        for (int j = 0; j < 2; ++j)
#pragma unroll
            for (int r = 0; r < 16; ++r) acc[i][j][r] = 0.f;
    for (int k0 = 0; k0 < K; k0 += 16) {
        float4 a0 = make_float4(0.f, 0.f, 0.f, 0.f), a1 = a0, b0 = a0, b1 = a0;
        if (aok) { a0 = *(const float4*)(ap + k0); a1 = *(const float4*)(ap + k0 + 4); }
        if (bok) { b0 = *(const float4*)(bp + (size_t)k0 * ldw); b1 = *(const float4*)(bp + (size_t)k0 * ldw + 4); }
        __syncthreads();
        As[ar][ak + 0] = a0.x; As[ar][ak + 1] = a0.y; As[ar][ak + 2] = a0.z; As[ar][ak + 3] = a0.w;
        As[ar][ak + 4] = a1.x; As[ar][ak + 5] = a1.y; As[ar][ak + 6] = a1.z; As[ar][ak + 7] = a1.w;
        *(float4*)&Bs[bk][bc] = b0; *(float4*)&Bs[bk][bc + 4] = b1;
        __syncthreads();
#pragma unroll
        for (int kk = 0; kk < 16; kk += 2) {
            float a[2], b[2];
#pragma unroll
            for (int i = 0; i < 2; ++i) a[i] = As[wr * 64 + i * 32 + (lane & 31)][kk + (lane >> 5)];
#pragma unroll
            for (int j = 0; j < 2; ++j) b[j] = Bs[kk + (lane >> 5)][wc * 64 + j * 32 + (lane & 31)];
#pragma unroll
            for (int i = 0; i < 2; ++i)
#pragma unroll
                for (int j = 0; j < 2; ++j) acc[i][j] = __builtin_amdgcn_mfma_f32_32x32x2f32(a[i], b[j], acc[i][j], 0, 0, 0);
        }
    }
#pragma unroll
    for (int i = 0; i < 2; ++i)
#pragma unroll
        for (int j = 0; j < 2; ++j)
#pragma unroll
            for (int r = 0; r < 16; ++r) {
                const int row = bm + wr * 64 + i * 32 + (r & 3) + 8 * (r >> 2) + 4 * (lane >> 5);
                const int col = bn + wc * 64 + j * 32 + (lane & 31);
                if (row < M && col < N) C[(size_t)row * ldc + col] = acc[i][j][r];
            }
}

__global__ void n_glu(const float* __restrict__ t, float* __restrict__ u, int rows) {
    const size_t i = (size_t)blockIdx.x * blockDim.x + threadIdx.x; if (i >= (size_t)rows * DM) return;
    const size_t m = i / DM; const int c = (int)(i % DM);
    u[i] = t[m * 2 * DM + c] * sigmoidf_(t[m * 2 * DM + DM + c]);
}
__global__ __launch_bounds__(256) void n_conf_dw(const float* __restrict__ u, const float* __restrict__ wdw, const float* __restrict__ bdw, const float* __restrict__ g, const float* __restrict__ bb, float* __restrict__ out) {
    __shared__ float red[8];
    const int m = blockIdx.x, t = m % SEQ, c = threadIdx.x * 4;
    float4 acc = *(const float4*)(bdw + c);
    for (int k = 0; k < CONV_K; ++k) { const int tt = t - (CONV_K - 1) + k; if (tt < 0) continue;
        const float4 w = *(const float4*)(wdw + k * DM + c), x = *(const float4*)(u + (size_t)(m - t + tt) * DM + c);
        acc.x += w.x * x.x; acc.y += w.y * x.y; acc.z += w.z * x.z; acc.w += w.w * x.w; }
    const float mean = block_sum256((acc.x + acc.y) + (acc.z + acc.w), red) * (1.0f / DM);
    const float dx = acc.x - mean, dy = acc.y - mean, dz = acc.z - mean, dw = acc.w - mean;
    const float var = block_sum256((dx * dx + dy * dy) + (dz * dz + dw * dw), red) * (1.0f / DM);
    const float rstd = 1.0f / sqrtf(var + LN_EPS);
    const float4 gg = *(const float4*)(g + c), b4 = *(const float4*)(bb + c);
    float4 o; o.x = siluf_(dx * rstd * gg.x + b4.x); o.y = siluf_(dy * rstd * gg.y + b4.y); o.z = siluf_(dz * rstd * gg.z + b4.z); o.w = siluf_(dw * rstd * gg.w + b4.w);
    *(float4*)(out + (size_t)m * DM + c) = o;
}
__global__ __launch_bounds__(256) void n_ln_res(const float* __restrict__ x, const float* __restrict__ mix, const float* __restrict__ g, const float* __restrict__ bb, float* __restrict__ xo) {
    __shared__ float red[8];
    const int m = blockIdx.x, c = threadIdx.x * 4;
    const float4 xv = *(const float4*)(x + (size_t)m * DM + c), mv = *(const float4*)(mix + (size_t)m * DM + c);
    float4 v; v.x = ALPHA_F * xv.x + mv.x; v.y = ALPHA_F * xv.y + mv.y; v.z = ALPHA_F * xv.z + mv.z; v.w = ALPHA_F * xv.w + mv.w;
    const float mean = block_sum256((v.x + v.y) + (v.z + v.w), red) * (1.0f / DM);
    const float dx = v.x - mean, dy = v.y - mean, dz = v.z - mean, dw = v.w - mean;
    const float var = block_sum256((dx * dx + dy * dy) + (dz * dz + dw * dw), red) * (1.0f / DM);
    const float rstd = 1.0f / sqrtf(var + LN_EPS);
    const float4 gg = *(const float4*)(g + c), b4 = *(const float4*)(bb + c);
    float4 o; o.x = dx * rstd * gg.x + b4.x; o.y = dy * rstd * gg.y + b4.y; o.z = dz * rstd * gg.z + b4.z; o.w = dw * rstd * gg.w + b4.w;
    *(float4*)(xo + (size_t)m * DM + c) = o;
}
__global__ void n_swiglu(const float* __restrict__ g, const float* __restrict__ u, float* __restrict__ h, const int* __restrict__ mcount, int rows, int n) {
    if (mcount) { const int mc = *mcount; rows = mc < rows ? mc : rows; }
    const size_t i = (size_t)blockIdx.x * blockDim.x + threadIdx.x; if (i >= (size_t)rows * n) return;
    h[i] = siluf_(g[i]) * u[i];
}
__global__ void n_shortconv(const float* __restrict__ t, const float* __restrict__ w, float* __restrict__ y, int rows) {
    const size_t i = (size_t)blockIdx.x * blockDim.x + threadIdx.x; if (i >= (size_t)rows * DM) return;
    const int m = (int)(i / DM), c = (int)(i % DM), tt = m % SEQ;
    float acc = 0.f;
    for (int k = 0; k < SHORT_K; ++k) { const int ts = tt - (SHORT_K - 1) + k; if (ts < 0) continue;
        const float* r = t + (size_t)(m - tt + ts) * 3 * DM; acc += w[k * DM + c] * (r[DM + c] * r[2 * DM + c]); }
    y[i] = t[(size_t)m * 3 * DM + c] * acc;
}

__global__ __launch_bounds__(128) void n_compress(const float* __restrict__ T, const float* __restrict__ pek, const float* __restrict__ pev, const float* __restrict__ wk1, const float* __restrict__ wk2,
                                                  const float* __restrict__ wv1, const float* __restrict__ wv2, float* __restrict__ cmp) {
    __shared__ float in[CMP_BLOCK * HD]; __shared__ float hid[PHI];
    const int c = blockIdx.x, bh = blockIdx.y, kv = blockIdx.z, b = bh / NKV, hk = bh % NKV, tid = threadIdx.x;
    const float* pe = kv ? pev : pek; const float* w1 = kv ? wv1 : wk1; const float* w2 = kv ? wv2 : wk2;
    const int col0 = NH * HD + kv * NKV * HD + hk * HD;
    for (int i = tid; i < CMP_BLOCK * HD; i += 128) { const int j = i / HD, d = i % HD; in[i] = T[(size_t)(b * SEQ + c * CMP_STRIDE + j) * NSA_COLS + col0 + d] + pe[i]; }
    __syncthreads();
    float a = 0.f;
    for (int i = 0; i < CMP_BLOCK * HD; ++i) a += in[i] * w1[(size_t)i * PHI + tid];
    hid[tid] = gelu_tanh(a);
    __syncthreads();
    if (tid < HD) { float o = 0.f; for (int j = 0; j < PHI; ++j) o += hid[j] * w2[j * HD + tid]; cmp[((size_t)(kv * gridDim.y + bh) * 128 + c) * HD + tid] = o; }
}

#define NATT_TILE 32
__device__ __forceinline__ void natt_load_tile(float (*Kt)[HD], float (*Vt)[HD], const float* kp, const float* vp, size_t stride, int nrows) {
    __syncthreads();
    for (int i = threadIdx.x; i < NATT_TILE * HD / 4; i += 256) { const int r = i / (HD / 4), d4 = (i % (HD / 4)) * 4;
        float4 kx = make_float4(0.f, 0.f, 0.f, 0.f), vx = kx;
        if (r < nrows) { kx = *(const float4*)(kp + (size_t)r * stride + d4); vx = *(const float4*)(vp + (size_t)r * stride + d4); }
        *(float4*)&Kt[r][d4] = kx; *(float4*)&Vt[r][d4] = vx; }
    __syncthreads();
}
__global__ __launch_bounds__(256) void n_nsa_attn(const float* __restrict__ T, const float* __restrict__ cmp, float* __restrict__ O) {
    __shared__ float Kt[NATT_TILE][HD]; __shared__ float Vt[NATT_TILE][HD];
    __shared__ float impS[64][NG][NSLC]; __shared__ float scS[64][NSLC + 1];
    const int qi = blockIdx.x, bh = blockIdx.y, b = bh / NKV, hk = bh % NKV, tid = threadIdx.x, g = tid >> 6, tl = tid & 63, t = qi * 64 + tl;
    const size_t mrow = (size_t)b * SEQ + t; const int hcol = (hk * NG + g) * HD;
    float q[HD];
#pragma unroll
    for (int d = 0; d < HD; ++d) q[d] = T[mrow * NSA_COLS + hcol + d] * 0.125f;
    const float* gp = T + mrow * NSA_COLS + (NH * HD + 6 * NKV * HD) + hk * 12 + g * 3;
    const float g0 = sigmoidf_(gp[0]), g1 = sigmoidf_(gp[1]), g2 = sigmoidf_(gp[2]);
    float acc[HD]; float mx, l;
#define NATT_RESET() do { mx = -1e30f; l = 0.f; _Pragma("unroll") for (int d = 0; d < HD; ++d) acc[d] = 0.f; } while (0)
#define NATT_DOT(s, kk) do { s = 0.f; _Pragma("unroll") for (int d = 0; d < HD; d += 4) { const float4 kx = *(const float4*)&Kt[kk][d]; s += q[d] * kx.x + q[d + 1] * kx.y + q[d + 2] * kx.z + q[d + 3] * kx.w; } } while (0)
#define NATT_UPD(s, kk) do { const float mn = fmaxf(mx, s), sc = expf(mx - mn), p = expf(s - mn); l = l * sc + p; mx = mn; \
        _Pragma("unroll") for (int d = 0; d < HD; d += 4) { const float4 vx = *(const float4*)&Vt[kk][d]; acc[d] = acc[d] * sc + p * vx.x; acc[d + 1] = acc[d + 1] * sc + p * vx.y; acc[d + 2] = acc[d + 2] * sc + p * vx.z; acc[d + 3] = acc[d + 3] * sc + p * vx.w; } } while (0)
    float* op = O + mrow * DM + hcol;
    const float* kc = cmp + (size_t)bh * 128 * HD; const float* vc = cmp + (size_t)(gridDim.y + bh) * 128 * HD;
    NATT_RESET();
    for (int c0 = 0; c0 < NCMP; c0 += NATT_TILE) {
        natt_load_tile(Kt, Vt, kc + (size_t)c0 * HD, vc + (size_t)c0 * HD, HD, NCMP - c0 < NATT_TILE ? NCMP - c0 : NATT_TILE);
        for (int kk = 0; kk < NATT_TILE; ++kk) { const int c = c0 + kk; if (c < NCMP && c * CMP_STRIDE + CMP_BLOCK - 1 <= t) { float s; NATT_DOT(s, kk); NATT_UPD(s, kk); } }
    }
    { const float inv = g0 / fmaxf(l, 1e-30f);
#pragma unroll
      for (int d = 0; d < HD; d += 4) *(float4*)(op + d) = make_float4(acc[d] * inv, acc[d + 1] * inv, acc[d + 2] * inv, acc[d + 3] * inv); }
    { const float invl = 1.0f / fmaxf(l, 1e-30f); float cur = 0.f, nxt = 0.f;
      for (int c0 = 0; c0 < 128; c0 += NATT_TILE) {
        natt_load_tile(Kt, Vt, kc + (size_t)c0 * HD, vc + (size_t)c0 * HD, HD, NCMP - c0 < NATT_TILE ? NCMP - c0 : NATT_TILE);
        for (int kk = 0; kk < NATT_TILE; ++kk) { const int c = c0 + kk; float p = 0.f;
            if (c < NCMP && c * CMP_STRIDE + CMP_BLOCK - 1 <= t) { float s; NATT_DOT(s, kk); p = expf(s - mx) * invl; }
            cur += p; if ((c & 3) == 3) { nxt = p; impS[tl][g][c >> 2] = cur; cur = nxt; } }
      } }
    __syncthreads();
    if (g == 0) { for (int n = 0; n < NSLC; ++n) { const float imp = (impS[tl][0][n] + impS[tl][1][n]) + (impS[tl][2][n] + impS[tl][3][n]);
        const bool forced = (n == 0) || (n == qi) || (n == qi - 1); const bool valid = n <= qi;
        scS[tl][n] = forced ? 1e4f : (valid ? imp : -1e30f); } }
    __syncthreads();
    unsigned selmask = 0u;
    for (int n = 0; n < NSLC; ++n) { const float sn = scS[tl][n]; int rank = 0;
        for (int m2 = 0; m2 < NSLC; ++m2) { const float sm = scS[tl][m2]; rank += (sm > sn || (sm == sn && m2 < n)) ? 1 : 0; }
        if (rank < TOPN) selmask |= (1u << n); }
    NATT_RESET();
    for (int j = 0; j <= qi; ++j)
        for (int hf = 0; hf < 2; ++hf) { const int p0 = j * 64 + hf * 32;
            const float* kp = T + ((size_t)b * SEQ + p0) * NSA_COLS + (NH * HD + 2 * NKV * HD) + hk * HD; const float* vp = kp + NKV * HD;
            natt_load_tile(Kt, Vt, kp, vp, NSA_COLS, NATT_TILE);
            if ((selmask >> j) & 1u) for (int kk = 0; kk < NATT_TILE; ++kk) if (p0 + kk <= t) { float s; NATT_DOT(s, kk); NATT_UPD(s, kk); } }
    { const float inv = g1 / fmaxf(l, 1e-30f);
#pragma unroll
      for (int d = 0; d < HD; d += 4) { float4 o = *(float4*)(op + d); o.x += acc[d] * inv; o.y += acc[d + 1] * inv; o.z += acc[d + 2] * inv; o.w += acc[d + 3] * inv; *(float4*)(op + d) = o; } }
    NATT_RESET();
    for (int j = (qi >= 8 ? qi - 8 : 0); j <= qi; ++j)
        for (int hf = 0; hf < 2; ++hf) { const int p0 = j * 64 + hf * 32;
            const float* kp = T + ((size_t)b * SEQ + p0) * NSA_COLS + (NH * HD + 4 * NKV * HD) + hk * HD; const float* vp = kp + NKV * HD;
            natt_load_tile(Kt, Vt, kp, vp, NSA_COLS, NATT_TILE);
            for (int kk = 0; kk < NATT_TILE; ++kk) { const int df = t - (p0 + kk); if (df >= 0 && df < WINDOW) { float s; NATT_DOT(s, kk); NATT_UPD(s, kk); } } }
    { const float inv = g2 / fmaxf(l, 1e-30f);
#pragma unroll
      for (int d = 0; d < HD; d += 4) { float4 o = *(float4*)(op + d); o.x += acc[d] * inv; o.y += acc[d + 1] * inv; o.z += acc[d + 2] * inv; o.w += acc[d + 3] * inv; *(float4*)(op + d) = o; } }
#undef NATT_RESET
#undef NATT_DOT
#undef NATT_UPD
}

constexpr int MOE_CAP = 6144;
__global__ __launch_bounds__(256) void n_router(const float* __restrict__ x, const float* __restrict__ wr, int* __restrict__ cnt, int* __restrict__ list, int* __restrict__ tsel, float* __restrict__ twt) {
    const int m = blockIdx.x * 4 + (threadIdx.x >> 6), lane = threadIdx.x & 63;
    float lg[NEXP];
#pragma unroll
    for (int e = 0; e < NEXP; ++e) lg[e] = 0.f;
    for (int k = lane; k < DM; k += 64) { const float xv = x[(size_t)m * DM + k];
#pragma unroll
        for (int e = 0; e < NEXP; ++e) lg[e] += xv * wr[k * NEXP + e]; }
#pragma unroll
    for (int e = 0; e < NEXP; ++e) lg[e] = wave_sum(lg[e]);
    if (lane == 0) {
        int e1 = 0; float v1 = lg[0];
#pragma unroll
        for (int e = 1; e < NEXP; ++e) if (lg[e] > v1) { v1 = lg[e]; e1 = e; }
        int e2 = -1; float v2 = -3.4e38f;
#pragma unroll
        for (int e = 0; e < NEXP; ++e) if (e != e1 && lg[e] > v2) { v2 = lg[e]; e2 = e; }
        const float p2 = expf(v2 - v1), w1 = 1.0f / (1.0f + p2), w2 = p2 / (1.0f + p2);
        const int s1 = atomicAdd(cnt + e1, 1), s2 = atomicAdd(cnt + e2, 1);
        if (s1 < MOE_CAP) list[e1 * MOE_CAP + s1] = m;
        if (s2 < MOE_CAP) list[e2 * MOE_CAP + s2] = m;
        tsel[m * 4 + 0] = e1; tsel[m * 4 + 1] = s1; tsel[m * 4 + 2] = e2; tsel[m * 4 + 3] = s2; twt[m * 2] = w1; twt[m * 2 + 1] = w2;
    }
}
__global__ __launch_bounds__(256) void n_moe_scatter(const float* __restrict__ Y, const int* __restrict__ cnt, const int* __restrict__ list, const int* __restrict__ tsel, const float* __restrict__ twt, int e, float* __restrict__ F) {
    const int slot = blockIdx.x; int c = cnt[e]; c = c < MOE_CAP ? c : MOE_CAP; if (slot >= c) return;
    const int m = list[e * MOE_CAP + slot]; const float w = (tsel[m * 4] == e) ? twt[m * 2] : twt[m * 2 + 1];
    const int col = threadIdx.x * 4; const float4 y = *(const float4*)(Y + (size_t)slot * DM + col); float4 f = *(float4*)(F + (size_t)m * DM + col);
    f.x += w * y.x; f.y += w * y.y; f.z += w * y.z; f.w += w * y.w; *(float4*)(F + (size_t)m * DM + col) = f;
}


enum { I_X = 0, I_LMG, I_LMB, I_LFG, I_LFB, I_CWIN, I_CWDW, I_CBDW, I_CLNG, I_CLNB, I_CWOUT, I_SWIN, I_SWCONV, I_SWOUT, I_NWIN, I_NPEK, I_NPEV, I_NWK1, I_NWK2, I_NWV1, I_NWV2, I_NWOUT,
       I_FWG, I_FWU, I_FWD, I_MWR, I_MWG, I_MWU, I_MWD };

#define GAS __attribute__((address_space(1)))
#define LAS __attribute__((address_space(3)))
typedef unsigned short bf16;
typedef unsigned v4u __attribute__((ext_vector_type(4)));
typedef unsigned v2u __attribute__((ext_vector_type(2)));
typedef float f32x4 __attribute__((ext_vector_type(4)));
typedef float f32x2 __attribute__((ext_vector_type(2)));
typedef short bf16x8 __attribute__((ext_vector_type(8)));
typedef short s16x4 __attribute__((ext_vector_type(4)));
typedef GAS unsigned gu32;
#define RLX_AGENT __ATOMIC_RELAXED, __HIP_MEMORY_SCOPE_AGENT
#define LDS_WAIT() asm volatile("s_waitcnt lgkmcnt(0)" ::: "memory")
#define VM_WAIT() asm volatile("s_waitcnt vmcnt(0)" ::: "memory")
constexpr int NWAVES = 8, NTHR = NWAVES * 64;
__device__ __forceinline__ unsigned f2bf(float f) { unsigned u = __builtin_bit_cast(unsigned, f); return (u + 0x7fffu + ((u >> 16) & 1u)) >> 16; }
__device__ __forceinline__ unsigned pk2(float lo, float hi) { return f2bf(lo) | (f2bf(hi) << 16); }
typedef __bf16 bf16x2_t __attribute__((ext_vector_type(2)));
__device__ __forceinline__ unsigned cvt_pk_bf16(float lo, float hi) { f32x2 v = {lo, hi}; bf16x2_t b = __builtin_convertvector(v, bf16x2_t); return __builtin_bit_cast(unsigned, b); }
__device__ __forceinline__ float bf_lo(unsigned u) { return __builtin_bit_cast(float, u << 16); }
__device__ __forceinline__ float bf_hi(unsigned u) { return __builtin_bit_cast(float, u & 0xffff0000u); }
__device__ __forceinline__ float fast_sigmoid(float x) { return __builtin_amdgcn_rcpf(1.0f + __builtin_amdgcn_exp2f(-1.4426950408889634f * x)); }
__device__ __forceinline__ float fast_silu(float x) { return x * fast_sigmoid(x); }

#define XB_TMO      128
#define XB_XCNT(j)  (256  + 64 * (j))
#define XB_XSUB(j)  (1280 + 64 * (j))
#define XB_XGEN(j)  (2304 + 64 * (j))
#define XB_TOP      3328
#define XB_TOPGEN   3392
#define XCD_BAR_WORDS 3456
#define XB_SPIN_CAP (1u << 18)
__device__ __forceinline__ unsigned xb_ld(unsigned* p)              { return __hip_atomic_load(p, __ATOMIC_RELAXED, __HIP_MEMORY_SCOPE_AGENT); }
__device__ __forceinline__ unsigned xb_add(unsigned* p, unsigned v) { return __hip_atomic_fetch_add(p, v, __ATOMIC_RELAXED, __HIP_MEMORY_SCOPE_AGENT); }
__device__ __forceinline__ unsigned xb_xcc_id() { return (unsigned)__builtin_amdgcn_s_getreg((3 << 11) | 20) & 0xFu; }
#define XB_SPIN(cond, bar) do { unsigned _sp = 0; while (cond) { __builtin_amdgcn_s_sleep(1); \
    if ((++_sp & 255u) == 0u) { if (xb_ld(&(bar)[XB_TMO])) break; if (_sp > XB_SPIN_CAP) { atomicAdd(&(bar)[XB_TMO], 1u); break; } } } } while (0)
struct XcdBarrier { unsigned* bar; unsigned x; volatile LAS unsigned* st; };
__device__ __forceinline__ XcdBarrier xcd_barrier_post(unsigned* bar, volatile LAS unsigned* st) {
    XcdBarrier b; b.bar = bar; b.x = xb_xcc_id(); b.st = st;
    if (threadIdx.x == 0) (void)xb_add(&bar[XB_XCNT(b.x)], 1u);
    return b;
}
__device__ __forceinline__ void xcd_barrier_complete(unsigned* bar, unsigned x, unsigned& nloc, unsigned& nx) {
    const unsigned G = gridDim.x * gridDim.y * gridDim.z;
    unsigned sum, cnt, mine, sp = 0u;
    for (;;) {
        sum = 0u; cnt = 0u; mine = 0u;
#pragma unroll
        for (unsigned j = 0; j < 16; ++j) { const unsigned c = xb_ld(&bar[XB_XCNT(j)]); sum += c; cnt += (c > 0u) ? 1u : 0u; mine = (j == x) ? c : mine; }
        if (sum == G) break;
        __builtin_amdgcn_s_sleep(1);
        if ((++sp & 255u) == 0u) { if (xb_ld(&bar[XB_TMO])) break; if (sp > XB_SPIN_CAP) { atomicAdd(&bar[XB_TMO], 1u); break; } }
    }
    nloc = mine > 0u ? mine : 1u; nx = cnt > 0u ? cnt : 1u;
}
__device__ __forceinline__ void xcd_barrier(const XcdBarrier& b) {
    asm volatile("s_waitcnt vmcnt(0)" ::: "memory");
    __syncthreads();
    if (threadIdx.x == 0) {
        unsigned* bar = b.bar;
        __builtin_amdgcn_s_waitcnt(0);
        unsigned nloc = b.st[0], nx = b.st[1];
        if (nloc == 0u) { xcd_barrier_complete(bar, b.x, nloc, nx); b.st[0] = nloc; b.st[1] = nx; }
        const unsigned old = xb_add(&bar[XB_XSUB(b.x)], 1u);
        const unsigned gen = old / nloc;
        if (old + 1u == (gen + 1u) * nloc) {
            __builtin_amdgcn_fence(__ATOMIC_RELEASE, "agent");
            asm volatile("s_waitcnt vmcnt(0)" ::: "memory");
            const unsigned og = xb_add(&bar[XB_TOP], 1u);
            const unsigned tg = og / nx;
            if (og + 1u == (tg + 1u) * nx) xb_add(&bar[XB_TOPGEN], 1u);
            else XB_SPIN(xb_ld(&bar[XB_TOPGEN]) == tg, bar);
            __builtin_amdgcn_fence(__ATOMIC_ACQUIRE, "agent");
            xb_add(&bar[XB_XGEN(b.x)], 1u);
            asm volatile("s_waitcnt vmcnt(0)" ::: "memory");
        } else {
            XB_SPIN(xb_ld(&bar[XB_XGEN(b.x)]) == gen, bar);
            __builtin_amdgcn_fence(__ATOMIC_ACQUIRE, "agent");
            asm volatile("s_waitcnt vmcnt(0)" ::: "memory");
        }
    }
    __syncthreads();
}

namespace pg8 {
#define PG8_LAS __attribute__((address_space(3)))
typedef unsigned short bf16_t;
constexpr int BM = 256, BK = 64, HALF = 128, HTB = HALF * BK * 2  , STAGE_BYTES = 8 * HTB, NXCD = 8, WGM = 8;
__host__ __device__ __forceinline__ int lds_byte(int r, int c) { const int st = (r >> 4) * 2 + (c >> 5), rr = r & 15, cc = c & 31, ob = rr * 64 + cc * 2; return st * 1024 + (ob ^ (((ob >> 9) & 1) << 5)); }
__host__ __device__ __forceinline__ void stage_rc(int b, int& R, int& C) { const int st = b / 1024, sb = b % 1024, swz = sb ^ (((sb >> 9) & 1) << 5); R = (st >> 1) * 16 + swz / 64; C = (st & 1) * 32 + (swz % 64) / 2; }
__host__ __device__ __forceinline__ int perm32(int rho) { const int n = rho >> 4, i = rho & 15; return 8 * (i >> 2) + 4 * n + (i & 3); }

struct Unit { int pm, pn, eb, kh; };
struct Gemm { const bf16_t* A; const bf16_t* Bt; int lda, ldb, K; size_t bexp; };

struct StaticOrder {
    int nM, nN, nwg, G, c;
    __host__ __device__ void init(int nM_, int nN_, int G_, int c_) { nM = nM_; nN = nN_; nwg = nM * nN; G = G_; c = c_; }
    __host__ __device__ bool next(int i, Unit& u) const {
        const long L = (long)i * G + c; if (L >= nwg) return false;
        int wgid = (int)L; { const int q = nwg / NXCD, r = nwg % NXCD, xcd = wgid % NXCD, off = wgid / NXCD; wgid = (xcd < r ? xcd * (q + 1) : r * (q + 1) + (xcd - r) * q) + off; }
        const int nig = WGM * nN, gid = wgid / nig, fm = gid * WGM, gsz = (nM - fm) < WGM ? (nM - fm) : WGM;
        u.pm = fm + ((wgid % nig) % gsz); u.pn = (wgid % nig) / gsz; u.eb = 0; u.kh = 0; return true;
    }
    __device__ __forceinline__ void a_ready(const Unit&) const {}
    __device__ __forceinline__ void done(const Unit&) const {}
};
struct GroupedOrder : StaticOrder {
    int pb[9];
    __device__ __forceinline__ bool next(int i, Unit& u) const {
        if (!StaticOrder::next(i, u)) return false;
        int e = 0;
#pragma unroll
        for (int k = 1; k < 8; ++k) e += (u.pm >= pb[k]) ? 1 : 0;
        u.eb = e; u.kh = u.pn >> 2; u.pn &= 3; return true;
    }
};
struct GroupedOrderWide : StaticOrder {
    int pb[9];
    __device__ __forceinline__ bool next(int i, Unit& u) const {
        if (!StaticOrder::next(i, u)) return false;
        int e = 0;
#pragma unroll
        for (int k = 1; k < 8; ++k) e += (u.pm >= pb[k]) ? 1 : 0;
        u.eb = e; return true;
    }
};

template <class Epi, class Sched, bool ALIGN_EPI = false, bool SP2 = false>
__device__ __forceinline__ void gemm_phase(PG8_LAS unsigned char* lds, const Gemm g, const Sched& S, const Epi& E) {
    const int tid = threadIdx.x, wid = __builtin_amdgcn_readfirstlane(tid >> 6), lane = tid & 63, wr = wid >> 2, wc = wid & 3, fr = lane & 15, fq = lane >> 4;
    const int K = g.K, nt = K / BK;
    unsigned voffA[2], voffB[2];
#pragma unroll
    for (int i = 0; i < 2; ++i) { int R, C; stage_rc(tid * 16 + i * 8192, R, C); const int Rb = Epi::PERM ? ((R & ~31) + perm32(R & 31)) : R;
        voffA[i] = (unsigned)(R * g.lda + C) * 2u; voffB[i] = (unsigned)(Rb * g.ldb + C) * 2u; }
    const size_t kstep = (size_t)(BK * 2);
    const size_t hstepA = (size_t)HALF * g.lda * 2, hstepB = (size_t)HALF * g.ldb * 2;
    const size_t tstepA = 2 * hstepA, tstepB = 2 * hstepB;
    const unsigned ldsw = (unsigned)wid * 1024u;
    const int aoff = lds_byte(wr * 64 + fr, fq * 8), boff = lds_byte(wc * 32 + fr, fq * 8);
#define PG8_SA(b, h) (((b) * 2 + (h)) * HTB)
#define PG8_SB(b, h) ((4 + (b) * 2 + (h)) * HTB)
#define PG8_STAGE(bufoff, gbase, voff) do { _Pragma("unroll") for (int _i = 0; _i < 2; ++_i) \
        __builtin_amdgcn_global_load_lds((const unsigned*)((const char*)(gbase) + (voff)[_i]), (PG8_LAS unsigned*)(lds + (bufoff) + ldsw + _i * 8192), 16, 0, 0); } while (0)
#define PG8_LDA(dst, b, h) do { _Pragma("unroll") for (int m = 0; m < 4; ++m) _Pragma("unroll") for (int k = 0; k < 2; ++k) dst[m][k] = *(const PG8_LAS bf16x8*)(lds + PG8_SA(b, h) + aoff + m * 2048 + k * 1024); } while (0)
#define PG8_LDB(dst, b, h) do { _Pragma("unroll") for (int n = 0; n < 2; ++n) _Pragma("unroll") for (int k = 0; k < 2; ++k) dst[n][k] = *(const PG8_LAS bf16x8*)(lds + PG8_SB(b, h) + boff + n * 2048 + k * 1024); } while (0)
#define PG8_MMA(ai, bj, At, Bt) do { __builtin_amdgcn_s_setprio(1); _Pragma("unroll") for (int m = 0; m < 4; ++m) _Pragma("unroll") for (int n = 0; n < 2; ++n) _Pragma("unroll") for (int k = 0; k < 2; ++k) \
        acc[ai][bj][m][n] = __builtin_amdgcn_mfma_f32_16x16x32_bf16(Bt[n][k], At[m][k], acc[ai][bj][m][n], 0, 0, 0); __builtin_amdgcn_s_setprio(0); } while (0)
#define PG8_WAIT_V(n) asm volatile("s_waitcnt vmcnt(" #n ")" ::: "memory")
#define PG8_WAIT_L(n) asm volatile("s_waitcnt lgkmcnt(" #n ")" ::: "memory")
#define PG8_BAR __builtin_amdgcn_s_barrier()
#define PG8_SCHED __builtin_amdgcn_sched_barrier(0)
    Unit cur, nxt; int ui = 0;
    if (!S.next(0, cur)) return;
    f32x4 acc[2][2][4][2];
#pragma unroll
    for (int a = 0; a < 2; ++a)
#pragma unroll
        for (int b = 0; b < 2; ++b)
#pragma unroll
            for (int m = 0; m < 4; ++m)
#pragma unroll
                for (int n = 0; n < 2; ++n) acc[a][b][m][n] = (f32x4){0.f, 0.f, 0.f, 0.f};
    bf16x8 At[4][2], B0[2][2], B1[2][2];
    const size_t kslice = (size_t)K * 2;
    const char* cA = (const char*)g.A + (size_t)cur.pm * tstepA + (size_t)cur.kh * kslice; const char* cB = (const char*)g.Bt + (size_t)cur.eb * g.bexp + (size_t)cur.pn * tstepB + (size_t)cur.kh * kslice;
    S.a_ready(cur);
    if constexpr (SP2) {
        PG8_STAGE(PG8_SB(0, 0), cB, voffB); PG8_STAGE(PG8_SB(0, 1), cB + hstepB, voffB); PG8_STAGE(PG8_SA(0, 0), cA, voffA); PG8_STAGE(PG8_SA(0, 1), cA + hstepA, voffA);
        if (wr == 1) PG8_BAR;
        PG8_WAIT_V(2); PG8_BAR;
        PG8_STAGE(PG8_SB(1, 0), cB + kstep, voffB); PG8_STAGE(PG8_SA(1, 0), cA + kstep, voffA); PG8_STAGE(PG8_SB(1, 1), cB + hstepB + kstep, voffB);
        PG8_WAIT_V(6); PG8_BAR;
    } else {
        PG8_STAGE(PG8_SB(0, 0), cB, voffB); PG8_STAGE(PG8_SA(0, 0), cA, voffA); PG8_STAGE(PG8_SB(0, 1), cB + hstepB, voffB); PG8_STAGE(PG8_SA(0, 1), cA + hstepA, voffA);
        if (wr == 1) PG8_BAR;
        PG8_WAIT_V(4); PG8_BAR;
        PG8_STAGE(PG8_SB(1, 0), cB + kstep, voffB); PG8_STAGE(PG8_SA(1, 0), cA + kstep, voffA); PG8_STAGE(PG8_SB(1, 1), cB + hstepB + kstep, voffB);
        PG8_WAIT_V(6); PG8_BAR;
    }
    for (;;) {
        const bool has_next = S.next(ui + 1, nxt);
        const char* nA = has_next ? (const char*)g.A + (size_t)nxt.pm * tstepA + (size_t)nxt.kh * kslice : cA; const char* nB = has_next ? (const char*)g.Bt + (size_t)nxt.eb * g.bexp + (size_t)nxt.pn * tstepB + (size_t)nxt.kh * kslice : cB;
        for (int t = 0; t < nt; t += 2) {
            const bool last = (t == nt - 2);
            const char* a1 = cA + (size_t)(t + 1) * kstep;
            const char* a2 = last ? nA : cA + (size_t)(t + 2) * kstep; const char* b2 = last ? nB : cB + (size_t)(t + 2) * kstep;
            const char* a3 = a2 + kstep; const char* b3 = b2 + kstep;
            if (last && has_next) S.a_ready(nxt);
            if constexpr (SP2) {
            PG8_LDB(B0, 0, 0); PG8_LDB(B1, 0, 1); PG8_SCHED; PG8_LDA(At, 0, 0); PG8_STAGE(PG8_SA(1, 1), a1 + hstepA, voffA);
            PG8_WAIT_V(8); PG8_WAIT_L(0); PG8_BAR; PG8_MMA(0, 0, At, B0); PG8_MMA(0, 1, At, B1); PG8_BAR; PG8_SCHED;
            PG8_LDA(At, 0, 1); PG8_STAGE(PG8_SB(0, 0), b2, voffB); PG8_STAGE(PG8_SB(0, 1), b2 + hstepB, voffB); PG8_STAGE(PG8_SA(0, 0), a2, voffA);
            PG8_WAIT_V(8); PG8_WAIT_L(0); PG8_BAR; PG8_MMA(1, 0, At, B0); PG8_MMA(1, 1, At, B1); PG8_BAR; PG8_SCHED;
            PG8_LDB(B0, 1, 0); PG8_LDB(B1, 1, 1); PG8_SCHED; PG8_LDA(At, 1, 0); PG8_STAGE(PG8_SA(0, 1), a2 + hstepA, voffA);
            PG8_WAIT_V(8); PG8_WAIT_L(0); PG8_BAR; PG8_MMA(0, 0, At, B0); PG8_MMA(0, 1, At, B1); PG8_BAR; PG8_SCHED;
            PG8_LDA(At, 1, 1); PG8_STAGE(PG8_SB(1, 0), b3, voffB); PG8_STAGE(PG8_SB(1, 1), b3 + hstepB, voffB); PG8_STAGE(PG8_SA(1, 0), a3, voffA);
            PG8_WAIT_V(8); PG8_WAIT_L(0); PG8_BAR; PG8_MMA(1, 0, At, B0); PG8_MMA(1, 1, At, B1); PG8_BAR; PG8_SCHED;
            } else {
            PG8_LDB(B0, 0, 0); PG8_SCHED; PG8_LDA(At, 0, 0); PG8_STAGE(PG8_SA(1, 1), a1 + hstepA, voffA);
            PG8_WAIT_L(8); PG8_BAR; PG8_WAIT_L(0); PG8_MMA(0, 0, At, B0); PG8_BAR; PG8_SCHED;
            PG8_LDB(B1, 0, 1); PG8_STAGE(PG8_SB(0, 0), b2, voffB);
            PG8_BAR; PG8_WAIT_L(0); PG8_MMA(0, 1, At, B1); PG8_BAR;
            PG8_LDA(At, 0, 1); PG8_STAGE(PG8_SA(0, 0), a2, voffA);
            PG8_BAR; PG8_WAIT_L(0); PG8_MMA(1, 0, At, B0); PG8_BAR; PG8_SCHED;
            PG8_STAGE(PG8_SB(0, 1), b2 + hstepB, voffB);
            PG8_WAIT_V(6); PG8_BAR; PG8_MMA(1, 1, At, B1); PG8_BAR;
            PG8_LDB(B0, 1, 0); PG8_SCHED; PG8_LDA(At, 1, 0); PG8_STAGE(PG8_SA(0, 1), a2 + hstepA, voffA);
            PG8_WAIT_L(8); PG8_BAR; PG8_WAIT_L(0); PG8_MMA(0, 0, At, B0); PG8_BAR; PG8_SCHED;
            PG8_LDB(B1, 1, 1); PG8_STAGE(PG8_SB(1, 0), b3, voffB);
            PG8_BAR; PG8_WAIT_L(0); PG8_MMA(0, 1, At, B1); PG8_BAR;
            PG8_LDA(At, 1, 1); PG8_STAGE(PG8_SA(1, 0), a3, voffA);
            PG8_BAR; PG8_WAIT_L(0); PG8_MMA(1, 0, At, B0); PG8_BAR; PG8_SCHED;
            PG8_STAGE(PG8_SB(1, 1), b3 + hstepB, voffB);
            PG8_WAIT_V(6); PG8_BAR; PG8_MMA(1, 1, At, B1); PG8_BAR;
            }
        }
        if constexpr (ALIGN_EPI) { if (wr == 0) PG8_BAR; }
        E(acc, cur, wr, wc, fr, fq); S.done(cur);
        if (!has_next) break;
#pragma unroll
        for (int a = 0; a < 2; ++a)
#pragma unroll
            for (int b = 0; b < 2; ++b)
#pragma unroll
                for (int m = 0; m < 4; ++m)
#pragma unroll
                    for (int n = 0; n < 2; ++n) acc[a][b][m][n] = (f32x4){0.f, 0.f, 0.f, 0.f};
        cur = nxt; cA = nA; cB = nB; ++ui;
        if constexpr (ALIGN_EPI) { if (wr == 1) PG8_BAR; }
    }
    PG8_WAIT_V(0);
    if constexpr (!ALIGN_EPI) { if (wr == 0) PG8_BAR; }
    PG8_BAR;
#undef PG8_SA
#undef PG8_SB
#undef PG8_STAGE
#undef PG8_LDA
#undef PG8_LDB
#undef PG8_MMA
#undef PG8_WAIT_V
#undef PG8_WAIT_L
#undef PG8_BAR
#undef PG8_SCHED
}

template <int MODE> struct EpiPair {
    static constexpr bool PERM = true;
    bf16_t* O; int ldc;
    __device__ __forceinline__ void operator()(const f32x4 (&acc)[2][2][4][2], const Unit& u, int wr, int wc, int fr, int fq) const {
        const int row0 = u.pm * BM + wr * 64 + fr, col0 = u.pn * HALF + wc * 32 + 8 * fq;
#pragma unroll
        for (int ai = 0; ai < 2; ++ai)
#pragma unroll
            for (int m = 0; m < 4; ++m) { bf16_t* p = O + (size_t)(row0 + ai * HALF + m * 16) * ldc + col0; float r[8];
#pragma unroll
                for (int n = 0; n < 2; ++n)
#pragma unroll
                    for (int j = 0; j < 4; ++j) { const float x0 = acc[ai][0][m][n][j], x1 = acc[ai][1][m][n][j];
                        r[n * 4 + j] = MODE == 0 ? x0 * fast_sigmoid(x1) : (MODE == 1 ? fast_silu(x0) * x1 : x0 * x1); }
                v4u w; w.x = cvt_pk_bf16(r[0], r[1]); w.y = cvt_pk_bf16(r[2], r[3]); w.z = cvt_pk_bf16(r[4], r[5]); w.w = cvt_pk_bf16(r[6], r[7]);
                *(v4u*)p = w; }
    }
};
struct EpiBf16 {
    static constexpr bool PERM = true;
    bf16_t* O; int ldc; float scale; size_t slab;
    __device__ __forceinline__ void operator()(const f32x4 (&acc)[2][2][4][2], const Unit& u, int wr, int wc, int fr, int fq) const {
        const int row0 = u.pm * BM + wr * 64 + fr, col0 = u.pn * BM + wc * 32 + 8 * fq;
#pragma unroll
        for (int ai = 0; ai < 2; ++ai)
#pragma unroll
            for (int m = 0; m < 4; ++m) { bf16_t* rowp = O + (size_t)u.kh * slab + (size_t)(row0 + ai * HALF + m * 16) * ldc + col0;
#pragma unroll
                for (int bj = 0; bj < 2; ++bj) { const f32x4 v0 = acc[ai][bj][m][0] * scale, v1 = acc[ai][bj][m][1] * scale;
                    v4u w; w.x = cvt_pk_bf16(v0[0], v0[1]); w.y = cvt_pk_bf16(v0[2], v0[3]); w.z = cvt_pk_bf16(v1[0], v1[1]); w.w = cvt_pk_bf16(v1[2], v1[3]);
                    *(v4u*)(rowp + bj * HALF) = w; } }
    }
};
struct EpiResid {
    static constexpr bool PERM = true;
    bf16_t* XB; int ldc;
    __device__ __forceinline__ void operator()(const f32x4 (&acc)[2][2][4][2], const Unit& u, int wr, int wc, int fr, int fq) const {
        const int row0 = u.pm * BM + wr * 64 + fr, col0 = u.pn * BM + wc * 32 + 8 * fq;
#pragma unroll
        for (int ai = 0; ai < 2; ++ai)
#pragma unroll
            for (int m = 0; m < 4; ++m) { bf16_t* rowp = XB + (size_t)(row0 + ai * HALF + m * 16) * ldc + col0;
#pragma unroll
                for (int bj = 0; bj < 2; ++bj) { const v4u r = *(const v4u*)(rowp + bj * HALF); const f32x4 a0 = acc[ai][bj][m][0], a1 = acc[ai][bj][m][1];
                    v4u w; w.x = cvt_pk_bf16(bf_lo(r.x) * ALPHA_F + a0[0], bf_hi(r.x) * ALPHA_F + a0[1]); w.y = cvt_pk_bf16(bf_lo(r.y) * ALPHA_F + a0[2], bf_hi(r.y) * ALPHA_F + a0[3]);
                    w.z = cvt_pk_bf16(bf_lo(r.z) * ALPHA_F + a1[0], bf_hi(r.z) * ALPHA_F + a1[1]); w.w = cvt_pk_bf16(bf_lo(r.w) * ALPHA_F + a1[2], bf_hi(r.w) * ALPHA_F + a1[3]);
                    *(v4u*)(rowp + bj * HALF) = w; } }
    }
};
}
namespace pg8 {
struct EpiSC {
    static constexpr bool PERM = true;
    bf16_t* CH; bf16_t* BG;
    __device__ __forceinline__ void operator()(const f32x4 (&acc)[2][2][4][2], const Unit& u, int wr, int wc, int fr, int fq) const {
        if (u.pn < 8) { EpiPair<2> e{CH, DM}; e(acc, u, wr, wc, fr, fq); }
        else { Unit u2 = u; u2.pn = u.pn - 8; EpiBf16 e{BG, DM, 1.0f, 0}; e(acc, u2, wr, wc, fr, fq); }
    }
};
}
namespace pg8 {
struct EpiNSA {
    static constexpr bool PERM = true;
    bf16_t* Q; bf16_t* KV; float* GATE;
    __device__ __forceinline__ void operator()(const f32x4 (&acc)[2][2][4][2], const Unit& u, int wr, int wc, int fr, int fq) const {
        const int b = u.pm >> 3, tb = (u.pm & 7) * 256 + wr * 64 + fr, d0 = 32 * (wc & 1) + 8 * fq;
        if (u.pn < 4) {
            const float sc = 0.125f * 1.4426950408889634f;
#pragma unroll
            for (int ai = 0; ai < 2; ++ai)
#pragma unroll
                for (int m = 0; m < 4; ++m) { const int t = tb + ai * HALF + m * 16;
#pragma unroll
                    for (int bj = 0; bj < 2; ++bj) { const int h = u.pn * 4 + 2 * bj + (wc >> 1); const f32x4 v0 = acc[ai][bj][m][0] * sc, v1 = acc[ai][bj][m][1] * sc;
                        v4u w; w.x = cvt_pk_bf16(v0[0], v0[1]); w.y = cvt_pk_bf16(v0[2], v0[3]); w.z = cvt_pk_bf16(v1[0], v1[1]); w.w = cvt_pk_bf16(v1[2], v1[3]);
                        *(v4u*)(Q + (((size_t)(b * NH + h) * SEQ + t) * HD + d0)) = w; } }
        } else if (u.pn < 10) {
            const int ti = u.pn - 4; bf16_t* base = KV + (size_t)ti * (4u << 20);
            const bool tr = (ti == 3) || (ti == 5);
#pragma unroll
            for (int ai = 0; ai < 2; ++ai)
#pragma unroll
                for (int m = 0; m < 4; ++m) { const int t = tb + ai * HALF + m * 16;
#pragma unroll
                    for (int bj = 0; bj < 2; ++bj) { const int hk = 2 * bj + (wc >> 1); const f32x4 v0 = acc[ai][bj][m][0], v1 = acc[ai][bj][m][1];
                        if (!tr) { v4u w; w.x = cvt_pk_bf16(v0[0], v0[1]); w.y = cvt_pk_bf16(v0[2], v0[3]); w.z = cvt_pk_bf16(v1[0], v1[1]); w.w = cvt_pk_bf16(v1[2], v1[3]);
                            *(v4u*)(base + (((size_t)(b * NKV + hk) * SEQ + t) * HD + d0)) = w; }
                        else { bf16_t* p = base + ((size_t)(b * NKV + hk) * HD + d0) * SEQ + t;
#pragma unroll
                            for (int j = 0; j < 4; ++j) { p[(size_t)j * SEQ] = (bf16_t)f2bf(v0[j]); p[(size_t)(4 + j) * SEQ] = (bf16_t)f2bf(v1[j]); } } } }
        } else {
            if (wc < 2 && (wc == 0 || fq < 2)) {
#pragma unroll
                for (int ai = 0; ai < 2; ++ai)
#pragma unroll
                    for (int m = 0; m < 4; ++m) { const size_t row = (size_t)u.pm * BM + wr * 64 + fr + ai * HALF + m * 16; float* p = GATE + row * 48 + 32 * wc + 8 * fq;
                        const f32x4 v0 = acc[ai][0][m][0], v1 = acc[ai][0][m][1];
                        *(f32x4*)p = (f32x4){fast_sigmoid(v0[0]), fast_sigmoid(v0[1]), fast_sigmoid(v0[2]), fast_sigmoid(v0[3])};
                        *(f32x4*)(p + 4) = (f32x4){fast_sigmoid(v1[0]), fast_sigmoid(v1[1]), fast_sigmoid(v1[2]), fast_sigmoid(v1[3])}; }
            }
        }
    }
};
}

constexpr size_t MiB = 1u << 20;
constexpr size_t WS_CTL = 0, CTL_ZERO_BYTES = 1 * MiB;
constexpr size_t WS_X = 1 * MiB;
constexpr size_t WS_XBF = 65 * MiB;
constexpr size_t WS_ACT = 97 * MiB;
constexpr size_t WS_H = 233 * MiB;
constexpr size_t WS_MISC = 471 * MiB;
constexpr size_t WS_W = 475 * MiB;
constexpr size_t W_CONF_IN = WS_W, W_CONF_OUT = W_CONF_IN + 8 * MiB, W_SC_IN = W_CONF_OUT + 4 * MiB, W_SC_OUT = W_SC_IN + 6 * MiB;
constexpr size_t W_NSA_IN = W_SC_OUT + 2 * MiB, W_NSA_OUT = W_NSA_IN + 6 * MiB, W_CMP1 = W_NSA_OUT + 2 * MiB;
constexpr size_t W_FFN_GU = W_CMP1 + 1 * MiB, W_FFN_D = W_FFN_GU + 22 * MiB, W_MOE_GU = W_FFN_D + 11 * MiB, W_MOE_D = W_MOE_GU + 224 * MiB, WS_END = W_MOE_D + 112 * MiB;
static_assert(WS_END <= 896 * MiB, "workspace map");
constexpr size_t A_U = WS_ACT, A_V = WS_ACT + 32 * MiB;
constexpr size_t A_CH = WS_ACT, A_BG = WS_ACT + 32 * MiB, A_YSC = WS_ACT + 64 * MiB;
constexpr size_t A_Q = WS_ACT, A_KC = WS_ACT + 32 * MiB, A_VCT = A_KC + 8 * MiB, A_KS = A_VCT + 8 * MiB, A_VST = A_KS + 8 * MiB, A_KW = A_VST + 8 * MiB, A_VWT = A_KW + 8 * MiB;
constexpr size_t A_O = A_VWT + 8 * MiB, A_GATE = A_O + 32 * MiB, A_KCMP = A_GATE + 4 * MiB, A_VCMPT = A_KCMP + 1 * MiB;
constexpr size_t A_PERM = WS_ACT;
static_assert(A_VCMPT + 1 * MiB <= WS_ACT + 136 * MiB, "ACT map");
constexpr int MOE_ROWS_MAX = 2 * MTOK + NEXP * 256;
constexpr size_t MOE_SLAB = (size_t)MOE_ROWS_MAX * DM;
static_assert((size_t)MOE_ROWS_MAX * DFFE * 2 <= 238 * MiB && 2 * MOE_SLAB * 2 <= 136 * MiB, "MoE buffers");
constexpr size_t MS_LIST = WS_MISC, MS_TSEL = MS_LIST + (size_t)NEXP * MTOK * 4, MS_TWT = MS_TSEL + (size_t)MTOK * 16, MS_END = MS_TWT + (size_t)MTOK * 8;
static_assert(MS_END <= WS_MISC + 4 * MiB, "MISC map");
constexpr int CW_BAR = 4096;
constexpr int CW_MOE = 16384;
constexpr int RING_BYTES = 131072, LDSCTL_OFF = RING_BYTES, LDS_BYTES = 147456;

struct CvtGroup { int in_idx, nmat; size_t src_stride; int ld, col0, K, ncols; size_t dst; size_t dst_stride; int rs, off; };
constexpr int NGROUPS = 17;
__device__ constexpr CvtGroup kGroups[NGROUPS] = {
    {I_CWIN, 2, (size_t)DM * 2 * DM, 2 * DM, 0, DM, DM, W_CONF_IN, 4 * MiB, 256, 0},
    {I_CWIN, 2, (size_t)DM * 2 * DM, 2 * DM, DM, DM, DM, W_CONF_IN, 4 * MiB, 256, 128},
    {I_CWOUT, 2, (size_t)DM * DM, DM, 0, DM, DM, W_CONF_OUT, 2 * MiB, 128, 0},
    {I_SWIN, 1, 0, 3 * DM, 0, DM, DM, W_SC_IN, 0, 128, 2048},
    {I_SWIN, 1, 0, 3 * DM, DM, DM, DM, W_SC_IN, 0, 256, 0},
    {I_SWIN, 1, 0, 3 * DM, 2 * DM, DM, DM, W_SC_IN, 0, 256, 128},
    {I_SWOUT, 1, 0, DM, 0, DM, DM, W_SC_OUT, 0, 128, 0},
    {I_NWIN, 1, 0, NSA_COLS, 0, DM, NSA_COLS, W_NSA_IN, 0, 128, 0},
    {I_NWOUT, 1, 0, DM, 0, DM, DM, W_NSA_OUT, 0, 128, 0},
    {I_NWK1, 1, 0, PHI, 0, CMP_BLOCK * HD, PHI, W_CMP1, 0, 128, 0},
    {I_NWV1, 1, 0, PHI, 0, CMP_BLOCK * HD, PHI, W_CMP1, 0, 128, 128},
    {I_FWG, 2, (size_t)DM * DFF, DFF, 0, DM, DFF, W_FFN_GU, 11 * MiB, 256, 0},
    {I_FWU, 2, (size_t)DM * DFF, DFF, 0, DM, DFF, W_FFN_GU, 11 * MiB, 256, 128},
    {I_FWD, 2, (size_t)DFF * DM, DM, 0, DFF, DM, W_FFN_D, (size_t)DM * DFF * 2, 128, 0},
    {I_MWG, 16, (size_t)DM * DFFE, DFFE, 0, DM, DFFE, W_MOE_GU, (size_t)2 * DFFE * DM * 2, 256, 0},
    {I_MWU, 16, (size_t)DM * DFFE, DFFE, 0, DM, DFFE, W_MOE_GU, (size_t)2 * DFFE * DM * 2, 256, 128},
    {I_MWD, 16, (size_t)DFFE * DM, DM, 0, DFFE, DM, W_MOE_D, (size_t)DM * DFFE * 2, 128, 0},
};
__host__ __device__ constexpr int grp_items_per_mat(int gi) { return (kGroups[gi].K / 64) * ((kGroups[gi].ncols + 31) / 32); }
__host__ __device__ constexpr int grp_items(int gi) { return kGroups[gi].nmat * grp_items_per_mat(gi); }
__host__ __device__ constexpr int grp_total() { int s = 0; for (int i = 0; i < NGROUPS; ++i) s += grp_items(i); return s; }
static_assert(W_FFN_GU + 2 * 11 * MiB == W_FFN_D && (size_t)2 * DFF * DM * 2 == 11 * MiB && (size_t)2 * DFFE * DM * 2 * 16 == 224 * MiB && (size_t)DM * DFFE * 2 * 16 == 112 * MiB, "weight map");

__device__ __forceinline__ void cvt_item(const float* src, int ld, int nvalid, bf16* dst, int Kd, int k0, LAS float* scr, int lane) {
    const int lr = lane >> 3, lc = (lane & 7) * 4;
    f32x4 v[8];
#pragma unroll
    for (int i = 0; i < 8; ++i) v[i] = (lc < nvalid) ? __builtin_nontemporal_load((const GAS f32x4*)(src + (size_t)(i * 8 + lr) * ld + lc)) : (f32x4){0.f, 0.f, 0.f, 0.f};
#pragma unroll
    for (int i = 0; i < 8; ++i) { LAS float* d = scr + (i * 8 + lr) * 33 + lc; d[0] = v[i].x; d[1] = v[i].y; d[2] = v[i].z; d[3] = v[i].w; }
    LDS_WAIT(); asm volatile("" ::: "memory");
    const int c = lane & 7;
#pragma unroll
    for (int j = 0; j < 4; ++j) { const int n = (lane >> 3) + 8 * j; const LAS float* s = scr + (8 * c) * 33 + n;
        v4u o; o.x = pk2(s[0 * 33], s[1 * 33]); o.y = pk2(s[2 * 33], s[3 * 33]); o.z = pk2(s[4 * 33], s[5 * 33]); o.w = pk2(s[6 * 33], s[7 * 33]);
        *(GAS v4u*)(dst + (size_t)n * Kd + k0 + 8 * c) = o; }
    LDS_WAIT(); asm volatile("" ::: "memory");
}
struct FArgs { const float* in[29]; float* out; unsigned char* ws; int ph_lo, ph_hi; };

__device__ __forceinline__ void phase_prologue(const FArgs& a, LAS unsigned char* lds, int gw, int NGW, int wave, int lane) {
    LAS float* scr = (LAS float*)(lds + wave * 16384);
    constexpr int NITEMS = grp_total();
    for (int it = gw; it < NITEMS; it += NGW) {
        int r = it, gi = 0;
#pragma unroll 1
        for (; gi < NGROUPS - 1; ++gi) { const int n = grp_items(gi); if (r < n) break; r -= n; }
        const CvtGroup G = kGroups[gi];
        const int ipm = (G.K / 64) * ((G.ncols + 31) / 32), mat = r / ipm, r2 = r % ipm, nblk = (G.ncols + 31) / 32, kb = r2 / nblk, nb = r2 % nblk;
        const int c0 = nb * 32, k0 = kb * 64, drow = (c0 / 128) * G.rs + (c0 % 128) + G.off;
        const float* src = a.in[G.in_idx] + (size_t)mat * G.src_stride + (size_t)k0 * G.ld + G.col0 + c0;
        bf16* dst = (bf16*)(a.ws + G.dst + (size_t)mat * G.dst_stride) + (size_t)drow * G.K;
        const int nvalid = (G.ncols - c0) < 32 ? (G.ncols - c0) : 32;
        cvt_item(src, G.ld, nvalid, dst, G.K, k0, scr, lane);
    }
    { const float* x = a.in[I_X]; bf16* xb = (bf16*)(a.ws + WS_XBF);
      for (size_t i = (size_t)gw * 64 + lane; i < (size_t)MTOK * DM / 8; i += (size_t)NGW * 64) {
        const f32x4 v0 = *(const GAS f32x4*)(x + i * 8), v1 = *(const GAS f32x4*)(x + i * 8 + 4);
        v4u o; o.x = pk2(v0.x, v0.y); o.y = pk2(v0.z, v0.w); o.z = pk2(v1.x, v1.y); o.w = pk2(v1.z, v1.w); *(GAS v4u*)(xb + i * 8) = o; } }
}

__device__ __forceinline__ void ln_load_row(const bf16* row, int lane, f32x4 (&v)[4]) {
    const GAS v4u* yr = (const GAS v4u*)row + lane;
#pragma unroll
    for (int j = 0; j < 2; ++j) { const v4u r = yr[64 * j]; v[2 * j] = (f32x4){bf_lo(r.x), bf_hi(r.x), bf_lo(r.y), bf_hi(r.y)}; v[2 * j + 1] = (f32x4){bf_lo(r.z), bf_hi(r.z), bf_lo(r.w), bf_hi(r.w)}; }
}
__device__ __forceinline__ void ln_normalize(f32x4 (&v)[4], const f32x4 (&gg)[4], const f32x4 (&bb)[4]) {
    float s = 0.f;
#pragma unroll
    for (int j = 0; j < 4; ++j) s += (v[j].x + v[j].y) + (v[j].z + v[j].w);
    const float mean = wave_sum(s) * (1.f / DM); float s2 = 0.f;
#pragma unroll
    for (int j = 0; j < 4; ++j) { v[j] = v[j] - mean; s2 += (v[j].x * v[j].x + v[j].y * v[j].y) + (v[j].z * v[j].z + v[j].w * v[j].w); }
    const float rstd = 1.f / sqrtf(wave_sum(s2) * (1.f / DM) + LN_EPS);
#pragma unroll
    for (int j = 0; j < 4; ++j) v[j] = v[j] * rstd * gg[j] + bb[j];
}
__device__ __forceinline__ void ln_store_row(bf16* row, float* xo, int lane, const f32x4 (&v)[4]) {
    if (row) { GAS v4u* o = (GAS v4u*)row + lane;
#pragma unroll
        for (int j = 0; j < 2; ++j) { v4u w; w.x = pk2(v[2 * j].x, v[2 * j].y); w.y = pk2(v[2 * j].z, v[2 * j].w); w.z = pk2(v[2 * j + 1].x, v[2 * j + 1].y); w.w = pk2(v[2 * j + 1].z, v[2 * j + 1].w); o[64 * j] = w; } }
    if (xo) { GAS f32x4* o = (GAS f32x4*)xo + 2 * lane;
#pragma unroll
        for (int j = 0; j < 2; ++j) { o[128 * j] = v[2 * j]; o[128 * j + 1] = v[2 * j + 1]; } }
}
__device__ __forceinline__ void ln_load_gb(const float* gam, const float* bet, int lane, f32x4 (&gg)[4], f32x4 (&bb)[4]) {
#pragma unroll
    for (int j = 0; j < 2; ++j) { gg[2 * j] = *(const GAS f32x4*)(gam + 8 * lane + 512 * j); gg[2 * j + 1] = *(const GAS f32x4*)(gam + 8 * lane + 512 * j + 4);
        bb[2 * j] = *(const GAS f32x4*)(bet + 8 * lane + 512 * j); bb[2 * j + 1] = *(const GAS f32x4*)(bet + 8 * lane + 512 * j + 4); }
}
__device__ __forceinline__ void phase_ln(bf16* XB, const float* gam, const float* bet, float* XO, bool keep_bf, int gw, int NGW, int lane) {
    f32x4 gg[4], bb[4]; ln_load_gb(gam, bet, lane, gg, bb);
    for (int m = gw; m < MTOK; m += NGW) {
        f32x4 v[4]; ln_load_row(XB + (size_t)m * DM, lane, v);
        ln_normalize(v, gg, bb);
        ln_store_row(keep_bf ? XB + (size_t)m * DM : (bf16*)nullptr, XO ? XO + (size_t)m * DM : (float*)nullptr, lane, v);
    }
}

constexpr int DWR = 8;
__device__ __forceinline__ void phase_conf_dw(const bf16* U, const float* wdw, const float* bdw, const float* gam, const float* bet, bf16* V, LAS unsigned char* lds, int tid, int wave, int lane) {
    LAS float* redA = (LAS float*)lds; LAS float* redB = redA + 128;
    LAS f32x2* wl = (LAS f32x2*)(lds + 1024);
    const unsigned loff = (unsigned)tid * 4u;
#pragma unroll 1
    for (int k = 0; k < CONV_K; ++k) wl[k * 512 + tid] = *(const GAS f32x2*)(wdw + k * DM + 2 * tid);
    const f32x2 bd = *(const GAS f32x2*)(bdw + 2 * tid), gg = *(const GAS f32x2*)(gam + 2 * tid), bb = *(const GAS f32x2*)(bet + 2 * tid);
    for (int chunk = blockIdx.x; chunk < MTOK / 64; chunk += gridDim.x) {
        const int r0 = chunk * 64, t0 = r0 % SEQ;
        f32x2 a[30 + DWR];
#pragma unroll
        for (int j = 0; j < 30; ++j) { unsigned u = 0u; if (t0 - 30 + j >= 0) u = *(const GAS unsigned*)((const GAS char*)U + (size_t)(r0 - 30 + j) * (DM * 2) + loff); a[j] = (f32x2){bf_lo(u), bf_hi(u)}; }
#pragma unroll 1
        for (int blk = 0; blk < 64 / DWR; ++blk) {
            const int rb = r0 + blk * DWR;
#pragma unroll
            for (int i = 0; i < DWR; ++i) { const unsigned u = *(const GAS unsigned*)((const GAS char*)U + (size_t)(rb + i) * (DM * 2) + loff); a[30 + i] = (f32x2){bf_lo(u), bf_hi(u)}; }
            f32x2 o[DWR]; float s[DWR];
#pragma unroll
            for (int i = 0; i < DWR; ++i) o[i] = bd;
#pragma unroll
            for (int k = 0; k < CONV_K; ++k) { const f32x2 w = wl[k * 512 + tid];
#pragma unroll
                for (int i = 0; i < DWR; ++i) o[i] += w * a[i + k]; }
            float s2[DWR];
#pragma unroll
            for (int i = 0; i < DWR; ++i) { s[i] = wave_sum(o[i].x + o[i].y); s2[i] = wave_sum(o[i].x * o[i].x + o[i].y * o[i].y); }
            LAS float* red = (blk & 1) ? redB : redA;
            if (lane == 0) {
#pragma unroll
                for (int i = 0; i < DWR; ++i) { red[wave * 2 * DWR + 2 * i] = s[i]; red[wave * 2 * DWR + 2 * i + 1] = s2[i]; } }
            __syncthreads();
#pragma unroll
            for (int i = 0; i < DWR; ++i) { float t = 0.f, t2 = 0.f;
#pragma unroll
                for (int w = 0; w < 8; ++w) { t += red[w * 2 * DWR + 2 * i]; t2 += red[w * 2 * DWR + 2 * i + 1]; }
                const float mean = t * (1.f / DM); const float var = fmaxf(t2 * (1.f / DM) - mean * mean, 0.f);
                const float rstd = 1.f / sqrtf(var + LN_EPS);
                const f32x2 y = (o[i] - mean) * rstd * gg + bb;
                *(GAS unsigned*)((GAS char*)V + (size_t)(rb + i) * (DM * 2) + loff) = pk2(fast_silu(y.x), fast_silu(y.y)); }
#pragma unroll
            for (int j = 0; j < 30; ++j) a[j] = a[j + DWR];
        }
    }
}

__device__ __forceinline__ void phase_shortconv(const bf16* CH, const bf16* BG, const float* wc, bf16* Y, int tid) {
    const unsigned loff = (unsigned)tid * 4u;
    const f32x2 w0 = *(const GAS f32x2*)(wc + 0 * DM + 2 * tid), w1 = *(const GAS f32x2*)(wc + 1 * DM + 2 * tid), w2 = *(const GAS f32x2*)(wc + 2 * DM + 2 * tid);
    for (int chunk = blockIdx.x; chunk < MTOK / 64; chunk += gridDim.x) {
        const int r0 = chunk * 64, t0 = r0 % SEQ;
        f32x2 p2 = (f32x2){0.f, 0.f}, p1 = p2;
        if (t0 > 0) { const unsigned ua = *(const GAS unsigned*)((const GAS char*)CH + (size_t)(r0 - 2) * (DM * 2) + loff), ub = *(const GAS unsigned*)((const GAS char*)CH + (size_t)(r0 - 1) * (DM * 2) + loff);
            p2 = (f32x2){bf_lo(ua), bf_hi(ua)}; p1 = (f32x2){bf_lo(ub), bf_hi(ub)}; }
#pragma unroll 8
        for (int i = 0; i < 64; ++i) {
            const unsigned uc = *(const GAS unsigned*)((const GAS char*)CH + (size_t)(r0 + i) * (DM * 2) + loff), ug = *(const GAS unsigned*)((const GAS char*)BG + (size_t)(r0 + i) * (DM * 2) + loff);
            const f32x2 c = (f32x2){bf_lo(uc), bf_hi(uc)}, g = (f32x2){bf_lo(ug), bf_hi(ug)};
            const f32x2 y = g * (w0 * p2 + w1 * p1 + w2 * c);
            *(GAS unsigned*)((GAS char*)Y + (size_t)(r0 + i) * (DM * 2) + loff) = pk2(y.x, y.y);
            p2 = p1; p1 = c; }
    }
}

__device__ __forceinline__ void phase_ln_router(bf16* XB, const float* gam, const float* bet, float* XO, const float* wr, unsigned* cnt, int* list, int* tsel, float* twt,
                                                LAS unsigned char* lds, int gw, int NGW, int tid, int lane) {
    LAS f32x4* wl = (LAS f32x4*)lds;
    for (int i = tid; i < DM * NEXP / 4; i += NTHR) wl[i] = *(const GAS f32x4*)(wr + 4 * i);
    __syncthreads();
    f32x4 gg[4], bb[4]; ln_load_gb(gam, bet, lane, gg, bb);
    for (int m = gw; m < MTOK; m += NGW) {
        f32x4 v[4]; ln_load_row(XB + (size_t)m * DM, lane, v);
        ln_normalize(v, gg, bb);
        ln_store_row(XB + (size_t)m * DM, XO ? XO + (size_t)m * DM : (float*)nullptr, lane, v);
        f32x4 la = (f32x4){0.f, 0.f, 0.f, 0.f}, lb = la;
#pragma unroll
        for (int j = 0; j < 4; ++j)
#pragma unroll
            for (int i = 0; i < 4; ++i) { const int c = 8 * lane + 512 * (j >> 1) + 4 * (j & 1) + i; const f32x4 wa = wl[2 * c], wb = wl[2 * c + 1]; la += wa * v[j][i]; lb += wb * v[j][i]; }
        float lg[NEXP];
#pragma unroll
        for (int e = 0; e < 4; ++e) { lg[e] = wave_sum(la[e]); lg[4 + e] = wave_sum(lb[e]); }
        if (lane == 0) {
            int e1 = 0; float v1 = lg[0];
#pragma unroll
            for (int e = 1; e < NEXP; ++e) if (lg[e] > v1) { v1 = lg[e]; e1 = e; }
            int e2 = -1; float v2 = -3.4e38f;
#pragma unroll
            for (int e = 0; e < NEXP; ++e) if (e != e1 && lg[e] > v2) { v2 = lg[e]; e2 = e; }
            const float p2 = expf(v2 - v1), w1 = 1.0f / (1.0f + p2), w2 = p2 / (1.0f + p2);
            const int s1 = (int)__hip_atomic_fetch_add(cnt + e1, 1u, RLX_AGENT), sl2 = (int)__hip_atomic_fetch_add(cnt + e2, 1u, RLX_AGENT);
            list[e1 * MTOK + s1] = m; list[e2 * MTOK + sl2] = m;
            *(int4*)(tsel + 4 * m) = make_int4(e1, s1, e2, sl2); *(float2*)(twt + 2 * m) = make_float2(w1, w2);
        }
    }
}
__device__ __forceinline__ void moe_panels(const unsigned* cnt, int (&pb)[9]) {
    int acc = 0;
#pragma unroll
    for (int e = 0; e < NEXP; ++e) { pb[e] = acc; const int c = (int)__builtin_amdgcn_readfirstlane((int)cnt[e]); acc += (c + 255) >> 8; }
    pb[NEXP] = acc;
}
__device__ __forceinline__ void phase_moe_permute(const bf16* XB, const unsigned* cnt, const int* list, bf16* AP, int gw, int NGW, int lane) {
    int pb[9]; moe_panels(cnt, pb);
    const int total = pb[NEXP] * 256;
    for (int r = gw; r < total; r += NGW) {
        const int pm = r >> 8; int e = 0;
#pragma unroll
        for (int k = 1; k < NEXP; ++k) e += (pm >= pb[k]) ? 1 : 0;
        const int c = (int)cnt[e]; int slot = r - pb[e] * 256; slot = slot < c ? slot : c - 1;
        const int m = list[e * MTOK + slot];
        const GAS v4u* src = (const GAS v4u*)(XB + (size_t)m * DM) + lane; GAS v4u* dst = (GAS v4u*)(AP + (size_t)r * DM) + lane;
        const v4u a = src[0], b = src[64]; dst[0] = a; dst[64] = b;
    }
}
__device__ __forceinline__ void phase_ln_moe(bf16* XB, const bf16* YM, const unsigned* cnt, const int* tsel, const float* twt, const float* gam, const float* bet, float* XO, bool keep_bf, int gw, int NGW, int lane) {
    int pb[9]; moe_panels(cnt, pb);
    f32x4 gg[4], bb[4]; ln_load_gb(gam, bet, lane, gg, bb);
    for (int m = gw; m < MTOK; m += NGW) {
        const int4 ts = *(const int4*)(tsel + 4 * m); const float2 tw = *(const float2*)(twt + 2 * m);
        int b1 = 0, b2 = 0;
#pragma unroll
        for (int e = 0; e < NEXP; ++e) { b1 = (ts.x == e) ? pb[e] : b1; b2 = (ts.z == e) ? pb[e] : b2; }
        f32x4 v[4], a[4], b[4], a2[4], b2v[4];
        ln_load_row(XB + (size_t)m * DM, lane, v);
        const bf16* y1 = YM + (size_t)(b1 * 256 + ts.y) * DM; const bf16* y2 = YM + (size_t)(b2 * 256 + ts.w) * DM;
        ln_load_row(y1, lane, a); ln_load_row(y2, lane, b); ln_load_row(y1 + MOE_SLAB, lane, a2); ln_load_row(y2 + MOE_SLAB, lane, b2v);
#pragma unroll
        for (int j = 0; j < 4; ++j) v[j] = v[j] * ALPHA_F + (a[j] + a2[j]) * tw.x + (b[j] + b2v[j]) * tw.y;
        ln_normalize(v, gg, bb);
        ln_store_row(keep_bf ? XB + (size_t)m * DM : (bf16*)nullptr, XO ? XO + (size_t)m * DM : (float*)nullptr, lane, v);
    }
}

typedef float f32x16_t __attribute__((ext_vector_type(16)));
__device__ __forceinline__ float gelu_tanh_fast(float x) { const float u = 0.7978845608028654f * (x + 0.044715f * x * x * x); const float e = __builtin_amdgcn_exp2f(2.0f * 1.4426950408889634f * u); return x * (1.0f - __builtin_amdgcn_rcpf(1.0f + e)); }
__device__ __forceinline__ int crow(int r, int hi) { return (r & 3) + 8 * (r >> 2) + 4 * hi; }
__device__ __forceinline__ void phase_compress(const bf16* KC, const bf16* VC, const bf16* W1T, const float* pek, const float* pev, const float* wk2, const float* wv2, bf16* KCMP, bf16* VCMPT,
                                               LAS unsigned char* lds, int tid, int wave, int lane) {
    LAS float* P = (LAS float*)lds;
    const int r32 = lane & 31, hi = lane >> 5;
    for (int unit = blockIdx.x; unit < 2 * BATCH * NKV * 4; unit += gridDim.x) {
        const int kv = unit >> 7, bh = (unit >> 2) & 31, rg = unit & 3;
        const bf16* src = (kv ? VC : KC) + ((size_t)bh * SEQ + 16 * (32 * rg + r32)) * HD;
        const float* pe = kv ? pev : pek;
        const bf16* wb = W1T + (size_t)(kv * PHI + r32) * (CMP_BLOCK * HD);
        f32x16_t acc[4];
#pragma unroll
        for (int nb = 0; nb < 4; ++nb)
#pragma unroll
            for (int q = 0; q < 16; ++q) acc[nb][q] = 0.f;
#pragma unroll 2
        for (int s = 0; s < 16; ++s) {
            const int k0 = (wave * 16 + s) * 16 + 8 * hi;
            const v4u araw = *(const GAS v4u*)(src + k0);
            const f32x4 p0 = *(const GAS f32x4*)(pe + k0), p1 = *(const GAS f32x4*)(pe + k0 + 4);
            v4u af; af.x = pk2(bf_lo(araw.x) + p0.x, bf_hi(araw.x) + p0.y); af.y = pk2(bf_lo(araw.y) + p0.z, bf_hi(araw.y) + p0.w);
            af.z = pk2(bf_lo(araw.z) + p1.x, bf_hi(araw.z) + p1.y); af.w = pk2(bf_lo(araw.w) + p1.z, bf_hi(araw.w) + p1.w);
            const bf16x8 a8 = __builtin_bit_cast(bf16x8, af);
#pragma unroll
            for (int nb = 0; nb < 4; ++nb) { const bf16x8 b8 = __builtin_bit_cast(bf16x8, *(const GAS v4u*)(wb + (size_t)nb * 32 * (CMP_BLOCK * HD) + k0));
                acc[nb] = __builtin_amdgcn_mfma_f32_32x32x16_bf16(a8, b8, acc[nb], 0, 0, 0); }
        }
        __syncthreads();
#pragma unroll
        for (int nb = 0; nb < 4; ++nb)
#pragma unroll
            for (int q = 0; q < 16; ++q) P[(wave * 32 + crow(q, hi)) * 128 + nb * 32 + r32] = acc[nb][q];
        __syncthreads();
#pragma unroll
        for (int i = 0; i < 8; ++i) { const int e = tid + NTHR * i; float t = 0.f;
#pragma unroll
            for (int w = 0; w < 8; ++w) t += P[w * 4096 + e];
            P[e] = gelu_tanh_fast(t); }
        __syncthreads();
        { const int r = tid >> 4, dg = (tid & 15) * 4; const float* w2 = (kv ? wv2 : wk2) + dg; f32x4 o = (f32x4){0.f, 0.f, 0.f, 0.f};
#pragma unroll 8
          for (int jj = 0; jj < PHI; ++jj) o += *(const GAS f32x4*)(w2 + jj * HD) * P[r * 128 + jj];
          const int c = 32 * rg + r;
          if (c == NCMP) o = (f32x4){0.f, 0.f, 0.f, 0.f};
          if (kv == 0) { v2u w; w.x = pk2(o.x, o.y); w.y = pk2(o.z, o.w); *(GAS v2u*)(KCMP + ((size_t)bh * 128 + c) * HD + dg) = w; }
          else {
#pragma unroll
              for (int j = 0; j < 4; ++j) VCMPT[((size_t)bh * HD + dg + j) * 128 + c] = (bf16)f2bf(o[j]); } }
    }
    __syncthreads();
}

#ifndef ATT_LEVEL
#define ATT_LEVEL 4
#endif
constexpr int AT_KP = 144, AT_VP = 136;
constexpr int AT_K = 0, AT_V = 2 * 64 * AT_KP, AT_IMP = AT_V + 2 * 64 * AT_VP, AT_SC = AT_IMP + 4 * 2 * 64 * 33 * 4, AT_SEL = AT_SC + 64 * 33 * 4, AT_WSF = AT_SEL + 512, AT_END = AT_WSF + 8 * 64 * 4;
static_assert(AT_END <= RING_BYTES, "attention LDS map");
struct AttTensors { const bf16 *Q, *KC, *KS, *VST, *KW, *VWT, *KCMP, *VCMPT; const float* GATE; bf16* O; };
__device__ __forceinline__ float swap_max(float v) { auto rr = __builtin_amdgcn_permlane32_swap(__float_as_uint(v), __float_as_uint(v), false, false); return fmaxf(__uint_as_float(rr[0]), __uint_as_float(rr[1])); }
__device__ __forceinline__ float swap_add(float v) { auto rr = __builtin_amdgcn_permlane32_swap(__float_as_uint(v), __float_as_uint(v), false, false); return __uint_as_float(rr[0]) + __uint_as_float(rr[1]); }

__device__ __forceinline__ void phase_nsa_attn(const AttTensors T, LAS unsigned char* lds, int tid, int wave, int lane) {
    const int r32 = lane & 31, hi = lane >> 5, g = wave >> 1, th = wave & 1, tl = 32 * th + r32;
    LAS float* wsf = (LAS float*)(lds + AT_WSF) + wave * 64;
    LAS float* IMP = (LAS float*)(lds + AT_IMP); LAS float* SC = (LAS float*)(lds + AT_SC); LAS unsigned* SEL = (LAS unsigned*)(lds + AT_SEL);
    const int ldrow = tid >> 3, ldch = tid & 7;
    const float NEG = -INFINITY;
    const int vcu = (gridDim.x % 8 == 0) ? (int)((blockIdx.x % 8) * (gridDim.x / 8) + blockIdx.x / 8) : (int)blockIdx.x;
    for (int ui = 0; ; ++ui) {
        int bh, qi;
        if (gridDim.x == 256) { if (ui >= 4) break; const int s = vcu & 7; bh = vcu >> 3; qi = (ui == 0) ? s : (ui == 1) ? 31 - s : (ui == 2) ? 8 + s : 23 - s; }
        else { const int u = blockIdx.x + ui * gridDim.x; if (u >= BATCH * NKV * NSLC) break; bh = u >> 5; qi = u & 31; }
        const int b = bh >> 2, hk = bh & 3, t = qi * 64 + tl;
        const size_t mrow = (size_t)b * SEQ + t;
        bf16x8 qf[4];
        { const bf16* qp = T.Q + (((size_t)(b * NH + hk * NG + g) * SEQ + t) * HD + 8 * hi);
#pragma unroll
          for (int s = 0; s < 4; ++s) qf[s] = __builtin_bit_cast(bf16x8, *(const GAS v4u*)(qp + 16 * s)); }
        const float* gp = T.GATE + mrow * 48 + hk * 12 + g * 3;
        const float g0 = gp[0], g1 = gp[1], g2 = gp[2];
        if (tid < 65) SEL[tid] = 0u;
        f32x16_t ot0, ot1;
#define AT_LOADK(dst, kptr) dst = *(const GAS v4u*)((kptr) + (size_t)ldrow * HD + ldch * 8)
#define AT_LOADV(dst, vptr, vstride) dst = *(const GAS v4u*)((vptr) + (size_t)ldrow * (vstride) + ldch * 8)
#define AT_STORE(buf, kreg, vreg) do { *(LAS v4u*)(lds + AT_K + (buf) * 64 * AT_KP + ldrow * AT_KP + ldch * 16) = kreg; \
        LAS v2u* vd_ = (LAS v2u*)(lds + AT_V + (buf) * 64 * AT_VP + ldrow * AT_VP + ldch * 16); vd_[0] = (v2u){vreg.x, vreg.y}; vd_[1] = (v2u){vreg.z, vreg.w}; } while (0)
#define AT_QK(buf, s0, s1) do { const LAS unsigned char* kb_ = lds + AT_K + (buf) * 64 * AT_KP + r32 * AT_KP + 16 * hi; \
        _Pragma("unroll") for (int r_ = 0; r_ < 16; ++r_) { s0[r_] = 0.f; s1[r_] = 0.f; } \
        _Pragma("unroll") for (int s_ = 0; s_ < 4; ++s_) { const bf16x8 k0_ = *(const LAS bf16x8*)(kb_ + 32 * s_), k1_ = *(const LAS bf16x8*)(kb_ + 32 * AT_KP + 32 * s_); \
            s0 = __builtin_amdgcn_mfma_f32_32x32x16_bf16(k0_, qf[s_], s0, 0, 0, 0); s1 = __builtin_amdgcn_mfma_f32_32x32x16_bf16(k1_, qf[s_], s1, 0, 0, 0); } } while (0)
#define AT_PV(buf, p0, p1, o0, o1) do { \
        v4u pa_[4]; \
        pa_[0] = (v4u){cvt_pk_bf16(p0[0], p0[1]), cvt_pk_bf16(p0[2], p0[3]), cvt_pk_bf16(p0[4], p0[5]), cvt_pk_bf16(p0[6], p0[7])}; \
        pa_[1] = (v4u){cvt_pk_bf16(p0[8], p0[9]), cvt_pk_bf16(p0[10], p0[11]), cvt_pk_bf16(p0[12], p0[13]), cvt_pk_bf16(p0[14], p0[15])}; \
        pa_[2] = (v4u){cvt_pk_bf16(p1[0], p1[1]), cvt_pk_bf16(p1[2], p1[3]), cvt_pk_bf16(p1[4], p1[5]), cvt_pk_bf16(p1[6], p1[7])}; \
        pa_[3] = (v4u){cvt_pk_bf16(p1[8], p1[9]), cvt_pk_bf16(p1[10], p1[11]), cvt_pk_bf16(p1[12], p1[13]), cvt_pk_bf16(p1[14], p1[15])}; \
        const LAS unsigned char* vb_ = lds + AT_V + (buf) * 64 * AT_VP + r32 * AT_VP + 8 * hi; \
        _Pragma("unroll") for (int ks_ = 0; ks_ < 4; ++ks_) { \
            const v2u a0_ = *(const LAS v2u*)(vb_ + 32 * ks_), a1_ = *(const LAS v2u*)(vb_ + 32 * ks_ + 16); \
            const v2u b0_ = *(const LAS v2u*)(vb_ + 32 * AT_VP + 32 * ks_), b1_ = *(const LAS v2u*)(vb_ + 32 * AT_VP + 32 * ks_ + 16); \
            const bf16x8 pf_ = __builtin_bit_cast(bf16x8, pa_[ks_]); \
            o0 = __builtin_amdgcn_mfma_f32_32x32x16_bf16(pf_, __builtin_bit_cast(bf16x8, ((v4u){a0_.x, a0_.y, a1_.x, a1_.y})), o0, 0, 0, 0); \
            o1 = __builtin_amdgcn_mfma_f32_32x32x16_bf16(pf_, __builtin_bit_cast(bf16x8, ((v4u){b0_.x, b0_.y, b1_.x, b1_.y})), o1, 0, 0, 0); } } while (0)
#define AT_ROWSCALE_LOAD(f) do { if (hi == 0) wsf[r32] = (f); asm volatile("s_waitcnt lgkmcnt(0)" ::: "memory"); } while (0)
#define AT_ROWF(r_) wsf[crow(r_, hi)]

        { v4u k0, v0, k1, v1;
          const bf16* kc = T.KCMP + (size_t)bh * 128 * HD; const bf16* vc = T.VCMPT + (size_t)bh * HD * 128;
          AT_LOADK(k0, kc); AT_LOADV(v0, vc, 128); AT_LOADK(k1, kc + 64 * HD); AT_LOADV(v1, vc + 64, 128);
          __syncthreads();
          AT_STORE(0, k0, v0); AT_STORE(1, k1, v1);
          __syncthreads(); }
        {
          f32x16_t s0, s1, s2, s3;
          AT_QK(0, s0, s1); AT_QK(1, s2, s3);
          float mx = NEG;
#pragma unroll
          for (int r = 0; r < 16; ++r) { const int c = crow(r, hi);
              s0[r] = (16 * c + 31 <= t) ? s0[r] : NEG; s1[r] = (16 * (c + 32) + 31 <= t) ? s1[r] : NEG; s2[r] = (16 * (c + 64) + 31 <= t) ? s2[r] : NEG; s3[r] = (16 * (c + 96) + 31 <= t) ? s3[r] : NEG;
              mx = fmaxf(fmaxf(mx, s0[r]), fmaxf(fmaxf(s1[r], s2[r]), s3[r])); }
          mx = fmaxf(swap_max(mx), -1e30f);
          float l = 0.f;
#pragma unroll
          for (int r = 0; r < 16; ++r) { s0[r] = __builtin_amdgcn_exp2f(s0[r] - mx); s1[r] = __builtin_amdgcn_exp2f(s1[r] - mx); s2[r] = __builtin_amdgcn_exp2f(s2[r] - mx); s3[r] = __builtin_amdgcn_exp2f(s3[r] - mx);
              l += (s0[r] + s1[r]) + (s2[r] + s3[r]); }
          l = swap_add(l);
          const float inv = 1.0f / fmaxf(l, 1e-30f);
#pragma unroll
          for (int r = 0; r < 16; ++r) { s0[r] *= inv; s1[r] *= inv; s2[r] *= inv; s3[r] *= inv; }
          { LAS float* I0 = IMP + ((g * 2 + 0) * 64 + tl) * 33; LAS float* I1 = IMP + ((g * 2 + 1) * 64 + tl) * 33;
#pragma unroll
            for (int a = 0; a < 4; ++a) { const int n = 2 * a + hi;
                I0[n] = (s0[4 * a] + s0[4 * a + 1]) + (s0[4 * a + 2] + s0[4 * a + 3]); I1[n + 1] = s0[4 * a + 3];
                I0[n + 8] = (s1[4 * a] + s1[4 * a + 1]) + (s1[4 * a + 2] + s1[4 * a + 3]); I1[n + 9] = s1[4 * a + 3];
                I0[n + 16] = (s2[4 * a] + s2[4 * a + 1]) + (s2[4 * a + 2] + s2[4 * a + 3]); I1[n + 17] = s2[4 * a + 3];
                I0[n + 24] = (s3[4 * a] + s3[4 * a + 1]) + (s3[4 * a + 2] + s3[4 * a + 3]); if (n + 25 < 33) I1[n + 25] = s3[4 * a + 3]; } }
          f32x16_t o0, o1;
#pragma unroll
          for (int r = 0; r < 16; ++r) { o0[r] = 0.f; o1[r] = 0.f; }
          AT_PV(0, s0, s1, o0, o1); AT_PV(1, s2, s3, o0, o1);
          AT_ROWSCALE_LOAD(g0);
#pragma unroll
          for (int r = 0; r < 16; ++r) { const float f = AT_ROWF(r); ot0[r] = o0[r] * f; ot1[r] = o1[r] * f; }
        }
        __syncthreads();
        { const int st = tid >> 3, grp = tid & 7;
#pragma unroll
          for (int i = 0; i < 4; ++i) { const int n = 4 * grp + i; float imp = 0.f;
#pragma unroll
              for (int gg = 0; gg < 4; ++gg) { imp += IMP[((gg * 2 + 0) * 64 + st) * 33 + n]; if (n > 0) imp += IMP[((gg * 2 + 1) * 64 + st) * 33 + n]; }
              const bool forced = (n == 0) || (n == qi) || (n == qi - 1);
              SC[st * 33 + n] = forced ? 1e4f : ((n <= qi) ? imp : -1e30f); }
          __syncthreads();
          unsigned bits = 0u;
#pragma unroll
          for (int i = 0; i < 4; ++i) { const int n = 4 * grp + i; const float sn = SC[st * 33 + n]; int rank = 0;
#pragma unroll 8
              for (int m2 = 0; m2 < NSLC; ++m2) { const float sm = SC[st * 33 + m2]; rank += (sm > sn || (sm == sn && m2 < n)) ? 1 : 0; }
              if (rank < TOPN && n <= qi) bits |= 1u << n; }
          if (bits) { __hip_atomic_fetch_or(SEL + st, bits, __ATOMIC_RELAXED, __HIP_MEMORY_SCOPE_WORKGROUP); __hip_atomic_fetch_or(SEL + 64, bits, __ATOMIC_RELAXED, __HIP_MEMORY_SCOPE_WORKGROUP); }
          __syncthreads(); }
        const unsigned selmask = SEL[tl]; const unsigned selunion = SEL[64];
#pragma unroll 1
        for (int mode = 0; mode < (ATT_LEVEL >= 4 ? 2 : (ATT_LEVEL == 3 ? 1 : 0)); ++mode) {
            const bf16* Kb = (mode == 0 ? T.KS : T.KW) + (size_t)bh * SEQ * HD; const bf16* Vb = (mode == 0 ? T.VST : T.VWT) + (size_t)bh * HD * SEQ;
            const int jlo = qi >= 8 ? qi - 8 : 0;
            unsigned todo = (mode == 0) ? selunion : (((2u << qi) - 1u) & ~((1u << jlo) - 1u));
            float m = -1e30f, l = 0.f; f32x16_t o0, o1;
#pragma unroll
            for (int r = 0; r < 16; ++r) { o0[r] = 0.f; o1[r] = 0.f; }
            int cur = 0;
            { const int j = __builtin_ctz(todo); v4u kr, vr; AT_LOADK(kr, Kb + (size_t)j * 64 * HD); AT_LOADV(vr, Vb + j * 64, SEQ); AT_STORE(0, kr, vr); }
            __syncthreads();
#pragma unroll 1
            while (todo) {
                const int j = __builtin_ctz(todo); todo &= todo - 1u;
                v4u kr, vr;
                if (todo) { const int jn = __builtin_ctz(todo); AT_LOADK(kr, Kb + (size_t)jn * 64 * HD); AT_LOADV(vr, Vb + jn * 64, SEQ); }
                const bool mine = (mode == 0) ? ((selmask >> j) & 1u) != 0u : true;
                if (__any(mine)) {
                    f32x16_t s0, s1;
                    AT_QK(cur, s0, s1);
                    float mx = NEG;
                    const bool diag = (j == qi), tail = (mode == 1 && j == qi - 8);
#pragma unroll
                    for (int r = 0; r < 16; ++r) { const int k0 = crow(r, hi), k1 = k0 + 32;
                        bool v0 = mine, v1 = mine;
                        if (diag) { v0 = v0 && (k0 <= tl); v1 = v1 && (k1 <= tl); }
                        if (tail) { v0 = v0 && (k0 > tl); v1 = v1 && (k1 > tl); }
                        s0[r] = v0 ? s0[r] : NEG; s1[r] = v1 ? s1[r] : NEG; mx = fmaxf(mx, fmaxf(s0[r], s1[r])); }
                    mx = swap_max(mx);
                    const float mn = fmaxf(m, mx);
                    if (__any(mn > m)) { const float f = __builtin_amdgcn_exp2f(m - mn); l *= f; m = mn; AT_ROWSCALE_LOAD(f);
#pragma unroll
                        for (int r = 0; r < 16; ++r) { const float fr_ = AT_ROWF(r); o0[r] *= fr_; o1[r] *= fr_; } }
                    float ls = 0.f;
#pragma unroll
                    for (int r = 0; r < 16; ++r) { s0[r] = __builtin_amdgcn_exp2f(s0[r] - m); s1[r] = __builtin_amdgcn_exp2f(s1[r] - m); ls += s0[r] + s1[r]; }
                    l += ls;
                    AT_PV(cur, s0, s1, o0, o1);
                }
                if (todo) AT_STORE(cur ^ 1, kr, vr);
                __syncthreads();
                cur ^= 1;
            }
            l = swap_add(l);
            AT_ROWSCALE_LOAD((mode == 0 ? g1 : g2) / fmaxf(l, 1e-30f));
#pragma unroll
            for (int r = 0; r < 16; ++r) { const float f = AT_ROWF(r); ot0[r] += o0[r] * f; ot1[r] += o1[r] * f; }
        }
        { bf16* ob = T.O + ((size_t)b * SEQ + qi * 64 + 32 * th) * DM + (hk * NG + g) * HD + r32;
#pragma unroll
          for (int r = 0; r < 16; ++r) { bf16* p = ob + (size_t)crow(r, hi) * DM; if (ATT_LEVEL < 2) { ot0[r] = 0.f; ot1[r] = 0.f; } p[0] = (bf16)f2bf(ot0[r]); p[32] = (bf16)f2bf(ot1[r]); } }
#undef AT_LOADK
#undef AT_LOADV
#undef AT_STORE
#undef AT_QK
#undef AT_PV
#undef AT_ROWSCALE_LOAD
#undef AT_ROWF
    }
    __syncthreads();
}

enum { PH_PRO = 0,
       PH0_WIN, PH0_DW, PH0_WOUT, PH0_LN1, PH0_GU, PH0_DOWN, PH0_LN2,
       PH1_WIN, PH1_CONV, PH1_WOUT, PH1_LN1, PH1_PERM, PH1_MGU, PH1_MDOWN, PH1_LN2,
       PH2_WIN, PH2_CMP, PH2_ATT, PH2_WOUT, PH2_LN1, PH2_GU, PH2_DOWN, PH2_LN2,
       PH3_WIN, PH3_DW, PH3_WOUT, PH3_LN1, PH3_PERM, PH3_MGU, PH3_MDOWN, PH3_LN2, PH_END };

#ifndef FAST_PREFIX
#define FAST_PREFIX 2
#endif
#ifndef ONE_LAUNCH
#define ONE_LAUNCH 0
#endif
constexpr int kSubEnd[8] = {PH0_LN1, PH0_LN2, PH1_LN1, PH1_LN2, PH2_LN1, PH2_LN2, PH3_LN1, PH3_LN2};
constexpr int FAST_END = FAST_PREFIX == 0 ? 0 : kSubEnd[FAST_PREFIX - 1] + 1;

struct Ctx { LAS unsigned char* lds; int tid, lane, wave, G, bx, gw, NGW, lo, hi; XcdBarrier bar; };
#define IN(k) (c.lo <= (k) && (k) < c.hi)
#define SEAM(k) do { if (IN(k) && IN((k) + 1)) xcd_barrier(c.bar); } while (0)
#define WSP(T, off) ((T*)(a.ws + (off)))

template <int L, int PH, bool FFN_SIDE> __device__ __forceinline__ void ln_plain(const FArgs& a, const Ctx& c) {
    if (IN(PH)) { const float* g = a.in[FFN_SIDE ? I_LFG : I_LMG] + L * DM; const float* b = a.in[FFN_SIDE ? I_LFB : I_LMB] + L * DM;
        constexpr bool LAST = FFN_SIDE && L == DEPTH - 1; constexpr bool HANDOFF = (PH + 1 == FAST_END) && !LAST;
        phase_ln(WSP(bf16, WS_XBF), g, b, LAST ? a.out : (HANDOFF ? WSP(float, WS_X) : (float*)nullptr), !LAST, c.gw, c.NGW, c.lane); }
    SEAM(PH);
}
template <int L, int PH> __device__ __forceinline__ void ln_router(const FArgs& a, const Ctx& c) {
    constexpr int f = L / 2; constexpr bool HANDOFF = (PH + 1 == FAST_END);
    if (IN(PH)) phase_ln_router(WSP(bf16, WS_XBF), a.in[I_LMG] + L * DM, a.in[I_LMB] + L * DM, HANDOFF ? WSP(float, WS_X) : (float*)nullptr, a.in[I_MWR] + (size_t)f * DM * NEXP,
                                (unsigned*)WSP(unsigned, WS_CTL) + CW_MOE + 64 * f, WSP(int, MS_LIST), WSP(int, MS_TSEL), WSP(float, MS_TWT), c.lds, c.gw, c.NGW, c.tid, c.lane);
    SEAM(PH);
}
template <int L, int PH> __device__ __forceinline__ void conformer_mixer(const FArgs& a, const Ctx& c) {
    constexpr int j = L / 3;
    bf16* U = WSP(bf16, A_U); bf16* V = WSP(bf16, A_V);
    if (IN(PH)) { pg8::Gemm g{WSP(bf16, WS_XBF), WSP(bf16, W_CONF_IN + (size_t)j * 4 * MiB), DM, DM, DM, 0}; pg8::StaticOrder S; S.init(MTOK / 256, 8, c.G, c.bx);
        pg8::EpiPair<0> E{U, DM}; pg8::gemm_phase<pg8::EpiPair<0>, pg8::StaticOrder, true, true>(c.lds, g, S, E); } SEAM(PH);
    if (IN(PH + 1)) phase_conf_dw(U, a.in[I_CWDW] + (size_t)j * CONV_K * DM, a.in[I_CBDW] + j * DM, a.in[I_CLNG] + j * DM, a.in[I_CLNB] + j * DM, V, c.lds, c.tid, c.wave, c.lane);
    SEAM(PH + 1);
    if (IN(PH + 2)) { pg8::Gemm g{V, WSP(bf16, W_CONF_OUT + (size_t)j * 2 * MiB), DM, DM, DM, 0}; pg8::StaticOrder S; S.init(MTOK / 256, 4, c.G, c.bx);
        pg8::EpiResid E{WSP(bf16, WS_XBF), DM}; pg8::gemm_phase<pg8::EpiResid, pg8::StaticOrder, true, true>(c.lds, g, S, E); } SEAM(PH + 2);
}
template <int L, int PH> __device__ __forceinline__ void sc_mixer(const FArgs& a, const Ctx& c) {
    constexpr int j = L / 3;
    bf16* CH = WSP(bf16, A_CH); bf16* BG = WSP(bf16, A_BG); bf16* YS = WSP(bf16, A_YSC);
    if (IN(PH)) { pg8::Gemm g{WSP(bf16, WS_XBF), WSP(bf16, W_SC_IN), DM, DM, DM, 0}; pg8::StaticOrder S; S.init(MTOK / 256, 12, c.G, c.bx);
        pg8::EpiSC E{CH, BG}; pg8::gemm_phase<pg8::EpiSC, pg8::StaticOrder, true, true>(c.lds, g, S, E); } SEAM(PH);
    if (IN(PH + 1)) phase_shortconv(CH, BG, a.in[I_SWCONV] + (size_t)j * SHORT_K * DM, YS, c.tid);
    SEAM(PH + 1);
    if (IN(PH + 2)) { pg8::Gemm g{YS, WSP(bf16, W_SC_OUT), DM, DM, DM, 0}; pg8::StaticOrder S; S.init(MTOK / 256, 4, c.G, c.bx);
        pg8::EpiResid E{WSP(bf16, WS_XBF), DM}; pg8::gemm_phase<pg8::EpiResid, pg8::StaticOrder, true, true>(c.lds, g, S, E); } SEAM(PH + 2);
}
template <int L, int PH> __device__ __forceinline__ void dense_ffn(const FArgs& a, const Ctx& c) {
    constexpr int f = L / 2;
    bf16* HB = WSP(bf16, WS_H);
    if (IN(PH)) { pg8::Gemm g{WSP(bf16, WS_XBF), WSP(bf16, W_FFN_GU + (size_t)f * 11 * MiB), DM, DM, DM, 0}; pg8::StaticOrder S; S.init(MTOK / 256, DFF / 128, c.G, c.bx);
        pg8::EpiPair<1> E{HB, DFF}; pg8::gemm_phase<pg8::EpiPair<1>, pg8::StaticOrder, true, true>(c.lds, g, S, E); } SEAM(PH);
    if (IN(PH + 1)) { pg8::Gemm g{HB, WSP(bf16, W_FFN_D + (size_t)f * DM * DFF * 2), DFF, DFF, DFF, 0}; pg8::StaticOrder S; S.init(MTOK / 256, 4, c.G, c.bx);
        pg8::EpiResid E{WSP(bf16, WS_XBF), DM}; pg8::gemm_phase<pg8::EpiResid, pg8::StaticOrder, true, true>(c.lds, g, S, E); } SEAM(PH + 1);
}
template <int L, int PH> __device__ __forceinline__ void moe_ffn(const FArgs& a, const Ctx& c) {
    constexpr int f = L / 2;
    const unsigned* cnt = (const unsigned*)WSP(unsigned, WS_CTL) + CW_MOE + 64 * f;
    bf16* AP = WSP(bf16, A_PERM); bf16* HB = WSP(bf16, WS_H);
    if (IN(PH)) phase_moe_permute(WSP(bf16, WS_XBF), cnt, WSP(int, MS_LIST), AP, c.gw, c.NGW, c.lane);
    SEAM(PH);
    if (IN(PH + 1)) { pg8::Gemm g{AP, WSP(bf16, W_MOE_GU + (size_t)f * 112 * MiB), DM, DM, DM, (size_t)14 * MiB}; pg8::GroupedOrderWide S; moe_panels(cnt, S.pb); S.init(S.pb[NEXP], DFFE / 128, c.G, c.bx);
        pg8::EpiPair<1> E{HB, DFFE}; pg8::gemm_phase<pg8::EpiPair<1>, pg8::GroupedOrderWide, true, true>(c.lds, g, S, E); } SEAM(PH + 1);
    if (IN(PH + 2)) { pg8::Gemm g{HB, WSP(bf16, W_MOE_D + (size_t)f * 56 * MiB), DFFE, DFFE, DFFE / 2, (size_t)7 * MiB}; pg8::GroupedOrder S; moe_panels(cnt, S.pb); S.init(S.pb[NEXP], 8, c.G, c.bx);
        pg8::EpiBf16 E{AP, DM, 1.0f, MOE_SLAB}; pg8::gemm_phase<pg8::EpiBf16, pg8::GroupedOrder, true, true>(c.lds, g, S, E); } SEAM(PH + 2);
    if (IN(PH + 3)) { constexpr bool LAST = L == DEPTH - 1; constexpr bool HANDOFF = (PH + 4 == FAST_END) && !LAST;
        phase_ln_moe(WSP(bf16, WS_XBF), AP, cnt, WSP(int, MS_TSEL), WSP(float, MS_TWT), a.in[I_LFG] + L * DM, a.in[I_LFB] + L * DM, LAST ? a.out : (HANDOFF ? WSP(float, WS_X) : (float*)nullptr), !LAST, c.gw, c.NGW, c.lane); }
    SEAM(PH + 3);
}

template <int L, int PH> __device__ __forceinline__ void nsa_mixer(const FArgs& a, const Ctx& c) {
    if (IN(PH)) { pg8::Gemm g{WSP(bf16, WS_XBF), WSP(bf16, W_NSA_IN), DM, DM, DM, 0}; pg8::StaticOrder S; S.init(MTOK / 256, 11, c.G, c.bx);
        pg8::EpiNSA E{WSP(bf16, A_Q), WSP(bf16, A_KC), WSP(float, A_GATE)}; pg8::gemm_phase<pg8::EpiNSA, pg8::StaticOrder, true, true>(c.lds, g, S, E); } SEAM(PH);
    if (IN(PH + 1)) phase_compress(WSP(bf16, A_KC), WSP(bf16, A_VCT), WSP(bf16, W_CMP1), a.in[I_NPEK], a.in[I_NPEV], a.in[I_NWK2], a.in[I_NWV2], WSP(bf16, A_KCMP), WSP(bf16, A_VCMPT), c.lds, c.tid, c.wave, c.lane);
    SEAM(PH + 1);
    if (IN(PH + 2)) { AttTensors T{WSP(bf16, A_Q), WSP(bf16, A_KC), WSP(bf16, A_KS), WSP(bf16, A_VST), WSP(bf16, A_KW), WSP(bf16, A_VWT), WSP(bf16, A_KCMP), WSP(bf16, A_VCMPT), WSP(float, A_GATE), WSP(bf16, A_O)};
        phase_nsa_attn(T, c.lds, c.tid, c.wave, c.lane); }
    SEAM(PH + 2);
    if (IN(PH + 3)) { pg8::Gemm g{WSP(bf16, A_O), WSP(bf16, W_NSA_OUT), DM, DM, DM, 0}; pg8::StaticOrder S; S.init(MTOK / 256, 4, c.G, c.bx);
        pg8::EpiResid E{WSP(bf16, WS_XBF), DM}; pg8::gemm_phase<pg8::EpiResid, pg8::StaticOrder, true, true>(c.lds, g, S, E); } SEAM(PH + 3);
}

__global__ void __launch_bounds__(NTHR, 2) mega(FArgs a) {
    extern __shared__ __attribute__((aligned(16))) unsigned char lds_raw[];
    Ctx c; c.lds = (LAS unsigned char*)lds_raw;
    c.tid = threadIdx.x; c.lane = c.tid & 63; c.wave = __builtin_amdgcn_readfirstlane(c.tid >> 6);
    c.G = gridDim.x; c.bx = blockIdx.x; const int vcu = (c.G % 8 == 0) ? (c.bx % 8) * (c.G / 8) + c.bx / 8 : c.bx;
    c.gw = vcu * NWAVES + c.wave; c.NGW = c.G * NWAVES; c.lo = a.ph_lo; c.hi = a.ph_hi;
    for (int u = c.tid; u < (LDS_BYTES - LDSCTL_OFF) / 4; u += NTHR) ((LAS unsigned*)(c.lds + LDSCTL_OFF))[u] = 0u;
    __syncthreads();
    c.bar = xcd_barrier_post((unsigned*)(a.ws + WS_CTL) + CW_BAR, (volatile LAS unsigned*)(c.lds + LDSCTL_OFF + 32));

    if (IN(PH_PRO)) phase_prologue(a, c.lds, c.gw, c.NGW, c.wave, c.lane);
    SEAM(PH_PRO);
    conformer_mixer<0, PH0_WIN>(a, c); ln_plain<0, PH0_LN1, false>(a, c); dense_ffn<0, PH0_GU>(a, c); ln_plain<0, PH0_LN2, true>(a, c);
#if FAST_PREFIX > 2
    sc_mixer<1, PH1_WIN>(a, c); ln_router<1, PH1_LN1>(a, c); moe_ffn<1, PH1_PERM>(a, c);
#endif
#if FAST_PREFIX > 4
    nsa_mixer<2, PH2_WIN>(a, c); ln_plain<2, PH2_LN1, false>(a, c); dense_ffn<2, PH2_GU>(a, c); ln_plain<2, PH2_LN2, true>(a, c);
#endif
#if FAST_PREFIX > 6
    conformer_mixer<3, PH3_WIN>(a, c); ln_router<3, PH3_LN1>(a, c); moe_ffn<3, PH3_PERM>(a, c);
#endif
}
#undef IN
#undef SEAM
#undef WSP


#ifndef DEBUG_MODE
#define DEBUG_MODE 0
#endif
__global__ void dbg_sqdiff(const float* a, const float* b, size_t n, float* acc2) {
    float d = 0.f, r = 0.f;
    for (size_t i = (size_t)blockIdx.x * blockDim.x + threadIdx.x; i < n; i += (size_t)gridDim.x * blockDim.x) { const float x = a[i], y = b[i]; const float t = x - y; d += (t == t) ? t * t : 1e6f; r += y * y; }
    d = wave_sum(d); r = wave_sum(r);
    if ((threadIdx.x & 63) == 0) { atomicAdd(acc2, d); atomicAdd(acc2 + 1, r); }
}
__global__ void dbg_scale(float* out, size_t n, const float* acc2) {
    float e = sqrtf(acc2[0] / fmaxf(acc2[1], 1e-30f)); e = e < 10.f ? e : 10.f;
    for (size_t i = (size_t)blockIdx.x * blockDim.x + threadIdx.x; i < n; i += (size_t)gridDim.x * blockDim.x) out[i] *= (1.0f + e);
}

static void gemm(hipStream_t st, const float* A, int lda, const int* gather, const int* mcount, int M, const float* W, int ldw, int N, int K, float* C, int ldc) {
    hipLaunchKernelGGL(ngemm, dim3((N + 127) / 128, (M + 127) / 128), dim3(256), 0, st, A, lda, gather, mcount, M, W, ldw, N, K, C, ldc);
}
struct NaiveBufs { float *BA, *BB, *BC, *BD; int *cnt, *list, *tsel; float *twt, *cmp; };
static void naive_sublayer(hipStream_t stream, const float* const* in, int s, const float* x, float* xo, const NaiveBufs& nb) {
    const int i = s / 2, kind = i % 3, j = i / 3, f = i / 2, EW = 256;
    constexpr int CR = MTOK / 2, CB = BATCH / 2;
    float *BA = nb.BA, *BB = nb.BB, *BC = nb.BC, *BD = nb.BD;
    for (int c = 0; c < 2; ++c) {
        const float* xc = x + (size_t)c * CR * DM; float* xoc = xo + (size_t)c * CR * DM;
        if ((s & 1) == 0) {
            if (kind == 0) {
                gemm(stream, xc, DM, nullptr, nullptr, CR, in[I_CWIN] + (size_t)j * DM * 2 * DM, 2 * DM, 2 * DM, DM, BA, 2 * DM);
                hipLaunchKernelGGL(n_glu, dim3(CR * DM / EW), dim3(EW), 0, stream, BA, BB, CR);
                hipLaunchKernelGGL(n_conf_dw, dim3(CR), dim3(256), 0, stream, BB, in[I_CWDW] + (size_t)j * CONV_K * DM, in[I_CBDW] + j * DM, in[I_CLNG] + j * DM, in[I_CLNB] + j * DM, BD);
                gemm(stream, BD, DM, nullptr, nullptr, CR, in[I_CWOUT] + (size_t)j * DM * DM, DM, DM, DM, BC, DM);
            } else if (kind == 1) {
                gemm(stream, xc, DM, nullptr, nullptr, CR, in[I_SWIN] + (size_t)j * DM * 3 * DM, 3 * DM, 3 * DM, DM, BA, 3 * DM);
                hipLaunchKernelGGL(n_shortconv, dim3(CR * DM / EW), dim3(EW), 0, stream, BA, in[I_SWCONV] + (size_t)j * SHORT_K * DM, BD, CR);
                gemm(stream, BD, DM, nullptr, nullptr, CR, in[I_SWOUT] + (size_t)j * DM * DM, DM, DM, DM, BC, DM);
            } else {
                gemm(stream, xc, DM, nullptr, nullptr, CR, in[I_NWIN] + (size_t)j * DM * NSA_COLS, NSA_COLS, NSA_COLS, DM, BA, NSA_COLS);
                hipLaunchKernelGGL(n_compress, dim3(NCMP, CB * NKV, 2), dim3(128), 0, stream, BA, in[I_NPEK] + j * CMP_BLOCK * HD, in[I_NPEV] + j * CMP_BLOCK * HD,
                                   in[I_NWK1] + (size_t)j * CMP_BLOCK * HD * PHI, in[I_NWK2] + j * PHI * HD, in[I_NWV1] + (size_t)j * CMP_BLOCK * HD * PHI, in[I_NWV2] + j * PHI * HD, nb.cmp);
                hipLaunchKernelGGL(n_nsa_attn, dim3(SEQ / 64, CB * NKV), dim3(256), 0, stream, BA, nb.cmp, BD);
                gemm(stream, BD, DM, nullptr, nullptr, CR, in[I_NWOUT] + (size_t)j * DM * DM, DM, DM, DM, BC, DM);
            }
            hipLaunchKernelGGL(n_ln_res, dim3(CR), dim3(256), 0, stream, xc, BC, in[I_LMG] + i * DM, in[I_LMB] + i * DM, xoc);
        } else {
            if (i % 2 == 0) {
                gemm(stream, xc, DM, nullptr, nullptr, CR, in[I_FWG] + (size_t)f * DM * DFF, DFF, DFF, DM, BA, DFF);
                gemm(stream, xc, DM, nullptr, nullptr, CR, in[I_FWU] + (size_t)f * DM * DFF, DFF, DFF, DM, BB, DFF);
                hipLaunchKernelGGL(n_swiglu, dim3((unsigned)(((size_t)CR * DFF + EW - 1) / EW)), dim3(EW), 0, stream, BA, BB, BA, (const int*)nullptr, CR, DFF);
                gemm(stream, BA, DFF, nullptr, nullptr, CR, in[I_FWD] + (size_t)f * DFF * DM, DM, DM, DFF, BC, DM);
            } else {
                (void)hipMemsetAsync(nb.cnt, 0, 256, stream);
                (void)hipMemsetAsync(BC, 0, (size_t)CR * DM * 4, stream);
                hipLaunchKernelGGL(n_router, dim3(CR / 4), dim3(256), 0, stream, xc, in[I_MWR] + (size_t)f * DM * NEXP, nb.cnt, nb.list, nb.tsel, nb.twt);
                for (int e = 0; e < NEXP; ++e) {
                    const size_t wo = ((size_t)f * NEXP + e) * DM * DFFE;
                    gemm(stream, xc, DM, nb.list + e * MOE_CAP, nb.cnt + e, MOE_CAP, in[I_MWG] + wo, DFFE, DFFE, DM, BA, DFFE);
                    gemm(stream, xc, DM, nb.list + e * MOE_CAP, nb.cnt + e, MOE_CAP, in[I_MWU] + wo, DFFE, DFFE, DM, BB, DFFE);
                    hipLaunchKernelGGL(n_swiglu, dim3((unsigned)(((size_t)MOE_CAP * DFFE + EW - 1) / EW)), dim3(EW), 0, stream, BA, BB, BA, (const int*)(nb.cnt + e), MOE_CAP, DFFE);
                    gemm(stream, BA, DFFE, nullptr, nb.cnt + e, MOE_CAP, in[I_MWD] + wo, DM, DM, DFFE, BD, DM);
                    hipLaunchKernelGGL(n_moe_scatter, dim3(MOE_CAP), dim3(256), 0, stream, BD, nb.cnt, nb.list, nb.tsel, nb.twt, e, BC);
                }
            }
            hipLaunchKernelGGL(n_ln_res, dim3(CR), dim3(256), 0, stream, xc, BC, in[I_LFG] + i * DM, in[I_LFB] + i * DM, xoc);
        }
    }
}

extern "C" void kernel_launch(void* const* d_in, const int* in_sizes, int n_in, void* d_out, int out_size, void* d_ws, size_t ws_size, hipStream_t stream) {
    (void)in_sizes; (void)out_size;
    static int grid = 0;
    if (grid == 0) {
        if (n_in != 29 || ws_size < WS_END) { fprintf(stderr, "kernel_launch: unexpected n_in %d / ws_size %zu (need %zu)\n", n_in, ws_size, (size_t)WS_END); grid = -1; return; }
        int dev = 0, cus = 0, per_cu = 0;
        if (hipGetDevice(&dev) != hipSuccess || hipDeviceGetAttribute(&cus, hipDeviceAttributeMultiprocessorCount, dev) != hipSuccess) { grid = -1; return; }
        if (hipFuncSetAttribute((const void*)mega, hipFuncAttributeMaxDynamicSharedMemorySize, LDS_BYTES) != hipSuccess) { fprintf(stderr, "kernel_launch: hipFuncSetAttribute failed\n"); grid = -1; return; }
        if (hipOccupancyMaxActiveBlocksPerMultiprocessor(&per_cu, (const void*)mega, NTHR, LDS_BYTES) != hipSuccess || per_cu < 1) { fprintf(stderr, "kernel_launch: occupancy query says %d\n", per_cu); }
        (void)hipGetLastError();
        grid = cus;
    }
    if (grid < 0) return;
    unsigned char* ws = (unsigned char*)d_ws;
    const float* in[29]; for (int i = 0; i < 29; ++i) in[i] = (const float*)d_in[i];
    auto run_fast = [&]() {
        (void)hipMemsetAsync(ws + WS_CTL, 0, CTL_ZERO_BYTES, stream);
        FArgs a{}; for (int i = 0; i < 29; ++i) a.in[i] = in[i];
        a.out = (float*)d_out; a.ws = ws;
        if (ONE_LAUNCH) { a.ph_lo = 0; a.ph_hi = FAST_END; hipLaunchKernelGGL(mega, dim3(grid), dim3(NTHR), LDS_BYTES, stream, a); }
        else for (int p = 0; p < FAST_END; ++p) { a.ph_lo = p; a.ph_hi = p + 1;
#ifdef REP_PHASE
            const int nrep = (p == REP_PHASE) ? 1 + REP_N : 1;
#else
            const int nrep = 1;
#endif
            for (int r = 0; r < nrep; ++r) hipLaunchKernelGGL(mega, dim3(grid), dim3(NTHR), LDS_BYTES, stream, a); }
    };
    NaiveBufs nb; unsigned char* nbase = ws + WS_ACT;
    nb.BA = (float*)nbase; nb.BB = (float*)(nbase + 96 * MiB); nb.BC = (float*)(nbase + 192 * MiB); nb.BD = (float*)(nbase + 224 * MiB);
    unsigned char* sm = nbase + 256 * MiB; nb.cnt = (int*)sm; nb.list = nb.cnt + 64; nb.tsel = nb.list + NEXP * MOE_CAP; nb.twt = (float*)(nb.tsel + (MTOK / 2) * 4); nb.cmp = (float*)(sm + 2 * MiB);
    float* X = (float*)(ws + WS_X);
#if DEBUG_MODE
    static_assert(FAST_PREFIX >= 1 && FAST_PREFIX <= 6 && !ONE_LAUNCH, "debug builds compare a fast prefix that leaves its result in X");
    float* XF1 = (float*)(ws + W_MOE_GU + 112 * MiB);
    float* acc2 = (float*)(sm + 1 * MiB);
    run_fast();
    (void)hipMemcpyAsync(XF1, X, (size_t)MTOK * DM * 4, hipMemcpyDeviceToDevice, stream);
    (void)hipMemsetAsync(acc2, 0, 64, stream);
    if (DEBUG_MODE == 2) { run_fast(); hipLaunchKernelGGL(dbg_sqdiff, dim3(2048), dim3(256), 0, stream, (const float*)X, (const float*)XF1, (size_t)MTOK * DM, acc2); }
    { const float* x = in[I_X];
      for (int s = 0; s < 8; ++s) { float* xo = (s == 7) ? (float*)d_out : X; naive_sublayer(stream, in, s, x, xo, nb); x = xo;
          if (DEBUG_MODE == 1 && s == FAST_PREFIX - 1) hipLaunchKernelGGL(dbg_sqdiff, dim3(2048), dim3(256), 0, stream, (const float*)XF1, (const float*)X, (size_t)MTOK * DM, acc2); } }
    hipLaunchKernelGGL(dbg_scale, dim3(2048), dim3(256), 0, stream, (float*)d_out, (size_t)MTOK * DM, (const float*)acc2);
#else
    if (FAST_END > 0) run_fast();
    if (FAST_PREFIX < 8) {
        const float* x = FAST_PREFIX == 0 ? in[I_X] : (const float*)X;
        for (int s = FAST_PREFIX; s < 8; ++s) { float* xo = (s == 7) ? (float*)d_out : X; naive_sublayer(stream, in, s, x, xo, nb); x = xo; }
    }
#endif
}
```

```cpp
#define FAST_PREFIX 8
#define ONE_LAUNCH 1
#include <hip/hip_runtime.h>
#include <cstdio>
#include <cstdint>

constexpr int BATCH = 8, SEQ = 2048, DM = 1024, MTOK = BATCH * SEQ, DEPTH = 4;
constexpr int CONV_K = 31, SHORT_K = 3;
constexpr int NH = 16, NKV = 4, NG = 4, HD = 64;
constexpr int CMP_BLOCK = 32, CMP_STRIDE = 16, NCMP = (SEQ - CMP_BLOCK) / CMP_STRIDE + 1;
constexpr int SLC_BLOCK = 64, NSLC = SEQ / SLC_BLOCK, TOPN = 16, WINDOW = 512, PHI = 128;
constexpr int NSA_COLS = NH * HD + 6 * NKV * HD + 3 * NH;
constexpr int DFF = 2816, NEXP = 8, DFFE = 3584;
constexpr float LN_EPS = 1e-5f;
#define ALPHA_F 1.681792830507429f

typedef float f32x16 __attribute__((ext_vector_type(16)));

__device__ __forceinline__ float wave_sum(float v) {
#pragma unroll
    for (int o = 1; o < 64; o <<= 1) v += __shfl_xor(v, o);
    return v;
}
__device__ __forceinline__ float block_sum256(float v, float* red) {
    v = wave_sum(v);
    __syncthreads();
    if ((threadIdx.x & 63) == 0) red[threadIdx.x >> 6] = v;
    __syncthreads();
    return (red[0] + red[1]) + (red[2] + red[3]);
}
__device__ __forceinline__ float sigmoidf_(float x) { return 1.0f / (1.0f + expf(-x)); }
__device__ __forceinline__ float siluf_(float x) { return x / (1.0f + expf(-x)); }
__device__ __forceinline__ float gelu_tanh(float x) { return 0.5f * x * (1.0f + tanhf(0.7978845608028654f * (x + 0.044715f * x * x * x))); }

__global__ __launch_bounds__(256) void ngemm(const float* __restrict__ A, int lda, const int* __restrict__ gather, const int* __restrict__ mcount, int M,
                                             const float* __restrict__ W, int ldw, int N, int K, float* __restrict__ C, int ldc) {
    __shared__ float As[128][17];
    __shared__ float Bs[16][132];
    if (mcount) { const int mc = *mcount; M = mc < M ? mc : M; }
    const int bm = blockIdx.y * 128, bn = blockIdx.x * 128;
    if (bm >= M) return;
    const int tid = threadIdx.x, lane = tid & 63, w = tid >> 6, wr = w >> 1, wc = w & 1;
    const int ar = tid >> 1, ak = (tid & 1) * 8;
    const int arow = bm + ar; const bool aok = arow < M;
    const int asrc = aok ? (gather ? gather[arow] : arow) : 0;
    const float* ap = A + (size_t)asrc * lda + ak;
    const int bk = tid >> 4, bc = (tid & 15) * 8;
    const bool bok = (bn + bc + 8) <= N;
    const float* bp = W + (size_t)bk * ldw + bn + bc;
    f32x16 acc[2][2];
#pragma unroll
    for (int i = 0; i < 2; ++i)
#pragma unroll
        for (int j = 0; j < 2; ++j)
#pragma unroll
            for (int r = 0; r < 16; ++r) acc[i][j][r] = 0.f;
    for (int k0 = 0; k0 < K; k0 += 16) {
        float4 a0 = make_float4(0.f, 0.f, 0.f, 0.f), a1 = a0, b0 = a0, b1 = a0;
        if (aok) { a0 = *(const float4*)(ap + k0); a1 = *(const float4*)(ap + k0 + 4); }
        if (bok) { b0 = *(const float4*)(bp + (size_t)k0 * ldw); b1 = *(const float4*)(bp + (size_t)k0 * ldw + 4); }
        __syncthreads();
        As[ar][ak + 0] = a0.x; As[ar][ak + 1] = a0.y; As[ar][ak + 2] = a0.z; As[ar][ak + 3] = a0.w;
        As[ar][ak + 4] = a1.x; As[ar][ak + 5] = a1.y; As[ar][ak + 6] = a1.z; As[ar][ak + 7] = a1.w;
        *(float4*)&Bs[bk][bc] = b0; *(float4*)&Bs[bk][bc + 4] = b1;
        __syncthreads();
#pragma unroll
        for (int kk = 0; kk < 16; kk += 2) {
            float a[2], b[2];
#pragma unroll
            for (int i = 0; i < 2; ++i) a[i] = As[wr * 64 + i * 32 + (lane & 31)][kk + (lane >> 5)];
#pragma unroll
            for (int j = 0; j < 2; ++j) b[j] = Bs[kk + (lane >> 5)][wc * 64 + j * 32 + (lane & 31)];
#pragma unroll
            for (int i = 0; i < 2; ++i)
#pragma unroll
                for (int j = 0; j < 2; ++j) acc[i][j] = __builtin_amdgcn_mfma_f32_32x32x2f32(a[i], b[j], acc[i][j], 0, 0, 0);
        }
    }
#pragma unroll
    for (int i = 0; i < 2; ++i)
#pragma unroll
        for (int j = 0; j < 2; ++j)
#pragma unroll
            for (int r = 0; r < 16; ++r) {
                const int row = bm + wr * 64 + i * 32 + (r & 3) + 8 * (r >> 2) + 4 * (lane >> 5);
                const int col = bn + wc * 64 + j * 32 + (lane & 31);
                if (row < M && col < N) C[(size_t)row * ldc + col] = acc[i][j][r];
            }
}

__global__ void n_glu(const float* __restrict__ t, float* __restrict__ u, int rows) {
    const size_t i = (size_t)blockIdx.x * blockDim.x + threadIdx.x; if (i >= (size_t)rows * DM) return;
    const size_t m = i / DM; const int c = (int)(i % DM);
    u[i] = t[m * 2 * DM + c] * sigmoidf_(t[m * 2 * DM + DM + c]);
}
__global__ __launch_bounds__(256) void n_conf_dw(const float* __restrict__ u, const float* __restrict__ wdw, const float* __restrict__ bdw, const float* __restrict__ g, const float* __restrict__ bb, float* __restrict__ out) {
    __shared__ float red[8];
    const int m = blockIdx.x, t = m % SEQ, c = threadIdx.x * 4;
    float4 acc = *(const float4*)(bdw + c);
    for (int k = 0; k < CONV_K; ++k) { const int tt = t - (CONV_K - 1) + k; if (tt < 0) continue;
        const float4 w = *(const float4*)(wdw + k * DM + c), x = *(const float4*)(u + (size_t)(m - t + tt) * DM + c);
        acc.x += w.x * x.x; acc.y += w.y * x.y; acc.z += w.z * x.z; acc.w += w.w * x.w; }
    const float mean = block_sum256((acc.x + acc.y) + (acc.z + acc.w), red) * (1.0f / DM);
    const float dx = acc.x - mean, dy = acc.y - mean, dz = acc.z - mean, dw = acc.w - mean;
    const float var = block_sum256((dx * dx + dy * dy) + (dz * dz + dw * dw), red) * (1.0f / DM);
    const float rstd = 1.0f / sqrtf(var + LN_EPS);
    const float4 gg = *(const float4*)(g + c), b4 = *(const float4*)(bb + c);
    float4 o; o.x = siluf_(dx * rstd * gg.x + b4.x); o.y = siluf_(dy * rstd * gg.y + b4.y); o.z = siluf_(dz * rstd * gg.z + b4.z); o.w = siluf_(dw * rstd * gg.w + b4.w);
    *(float4*)(out + (size_t)m * DM + c) = o;
}
__global__ __launch_bounds__(256) void n_ln_res(const float* __restrict__ x, const float* __restrict__ mix, const float* __restrict__ g, const float* __restrict__ bb, float* __restrict__ xo) {
    __shared__ float red[8];
    const int m = blockIdx.x, c = threadIdx.x * 4;
    const float4 xv = *(const float4*)(x + (size_t)m * DM + c), mv = *(const float4*)(mix + (size_t)m * DM + c);
    float4 v; v.x = ALPHA_F * xv.x + mv.x; v.y = ALPHA_F * xv.y + mv.y; v.z = ALPHA_F * xv.z + mv.z; v.w = ALPHA_F * xv.w + mv.w;
    const float mean = block_sum256((v.x + v.y) + (v.z + v.w), red) * (1.0f / DM);
    const float dx = v.x - mean, dy = v.y - mean, dz = v.z - mean, dw = v.w - mean;
    const float var = block_sum256((dx * dx + dy * dy) + (dz * dz + dw * dw), red) * (1.0f / DM);
    const float rstd = 1.0f / sqrtf(var + LN_EPS);
    const float4 gg = *(const float4*)(g + c), b4 = *(const float4*)(bb + c);
    float4 o; o.x = dx * rstd * gg.x + b4.x; o.y = dy * rstd * gg.y + b4.y; o.z = dz * rstd * gg.z + b4.z; o.w = dw * rstd * gg.w + b4.w;
    *(float4*)(xo + (size_t)m * DM + c) = o;
}
__global__ void n_swiglu(const float* __restrict__ g, const float* __restrict__ u, float* __restrict__ h, const int* __restrict__ mcount, int rows, int n) {
    if (mcount) { const int mc = *mcount; rows = mc < rows ? mc : rows; }
    const size_t i = (size_t)blockIdx.x * blockDim.x + threadIdx.x; if (i >= (size_t)rows * n) return;
    h[i] = siluf_(g[i]) * u[i];
}
__global__ void n_shortconv(const float* __restrict__ t, const float* __restrict__ w, float* __restrict__ y, int rows) {
    const size_t i = (size_t)blockIdx.x * blockDim.x + threadIdx.x; if (i >= (size_t)rows * DM) return;
    const int m = (int)(i / DM), c = (int)(i % DM), tt = m % SEQ;
    float acc = 0.f;
    for (int k = 0; k < SHORT_K; ++k) { const int ts = tt - (SHORT_K - 1) + k; if (ts < 0) continue;
        const float* r = t + (size_t)(m - tt + ts) * 3 * DM; acc += w[k * DM + c] * (r[DM + c] * r[2 * DM + c]); }
    y[i] = t[(size_t)m * 3 * DM + c] * acc;
}

__global__ __launch_bounds__(128) void n_compress(const float* __restrict__ T, const float* __restrict__ pek, const float* __restrict__ pev, const float* __restrict__ wk1, const float* __restrict__ wk2,
                                                  const float* __restrict__ wv1, const float* __restrict__ wv2, float* __restrict__ cmp) {
    __shared__ float in[CMP_BLOCK * HD]; __shared__ float hid[PHI];
    const int c = blockIdx.x, bh = blockIdx.y, kv = blockIdx.z, b = bh / NKV, hk = bh % NKV, tid = threadIdx.x;
    const float* pe = kv ? pev : pek; const float* w1 = kv ? wv1 : wk1; const float* w2 = kv ? wv2 : wk2;
    const int col0 = NH * HD + kv * NKV * HD + hk * HD;
    for (int i = tid; i < CMP_BLOCK * HD; i += 128) { const int j = i / HD, d = i % HD; in[i] = T[(size_t)(b * SEQ + c * CMP_STRIDE + j) * NSA_COLS + col0 + d] + pe[i]; }
    __syncthreads();
    float a = 0.f;
    for (int i = 0; i < CMP_BLOCK * HD; ++i) a += in[i] * w1[(size_t)i * PHI + tid];
    hid[tid] = gelu_tanh(a);
    __syncthreads();
    if (tid < HD) { float o = 0.f; for (int j = 0; j < PHI; ++j) o += hid[j] * w2[j * HD + tid]; cmp[((size_t)(kv * gridDim.y + bh) * 128 + c) * HD + tid] = o; }
}

#define NATT_TILE 32
__device__ __forceinline__ void natt_load_tile(float (*Kt)[HD], float (*Vt)[HD], const float* kp, const float* vp, size_t stride, int nrows) {
    __syncthreads();
    for (int i = threadIdx.x; i < NATT_TILE * HD / 4; i += 256) { const int r = i / (HD / 4), d4 = (i % (HD / 4)) * 4;
        float4 kx = make_float4(0.f, 0.f, 0.f, 0.f), vx = kx;
        if (r < nrows) { kx = *(const float4*)(kp + (size_t)r * stride + d4); vx = *(const float4*)(vp + (size_t)r * stride + d4); }
        *(float4*)&Kt[r][d4] = kx; *(float4*)&Vt[r][d4] = vx; }
    __syncthreads();
}
__global__ __launch_bounds__(256) void n_nsa_attn(const float* __restrict__ T, const float* __restrict__ cmp, float* __restrict__ O) {
    __shared__ float Kt[NATT_TILE][HD]; __shared__ float Vt[NATT_TILE][HD];
    __shared__ float impS[64][NG][NSLC]; __shared__ float scS[64][NSLC + 1];
    const int qi = blockIdx.x, bh = blockIdx.y, b = bh / NKV, hk = bh % NKV, tid = threadIdx.x, g = tid >> 6, tl = tid & 63, t = qi * 64 + tl;
    const size_t mrow = (size_t)b * SEQ + t; const int hcol = (hk * NG + g) * HD;
    float q[HD];
#pragma unroll
    for (int d = 0; d < HD; ++d) q[d] = T[mrow * NSA_COLS + hcol + d] * 0.125f;
    const float* gp = T + mrow * NSA_COLS + (NH * HD + 6 * NKV * HD) + hk * 12 + g * 3;
    const float g0 = sigmoidf_(gp[0]), g1 = sigmoidf_(gp[1]), g2 = sigmoidf_(gp[2]);
    float acc[HD]; float mx, l;
#define NATT_RESET() do { mx = -1e30f; l = 0.f; _Pragma("unroll") for (int d = 0; d < HD; ++d) acc[d] = 0.f; } while (0)
#define NATT_DOT(s, kk) do { s = 0.f; _Pragma("unroll") for (int d = 0; d < HD; d += 4) { const float4 kx = *(const float4*)&Kt[kk][d]; s += q[d] * kx.x + q[d + 1] * kx.y + q[d + 2] * kx.z + q[d + 3] * kx.w; } } while (0)
#define NATT_UPD(s, kk) do { const float mn = fmaxf(mx, s), sc = expf(mx - mn), p = expf(s - mn); l = l * sc + p; mx = mn; \
        _Pragma("unroll") for (int d = 0; d < HD; d += 4) { const float4 vx = *(const float4*)&Vt[kk][d]; acc[d] = acc[d] * sc + p * vx.x; acc[d + 1] = acc[d + 1] * sc + p * vx.y; acc[d + 2] = acc[d + 2] * sc + p * vx.z; acc[d + 3] = acc[d + 3] * sc + p * vx.w; } } while (0)
    float* op = O + mrow * DM + hcol;
    const float* kc = cmp + (size_t)bh * 128 * HD; const float* vc = cmp + (size_t)(gridDim.y + bh) * 128 * HD;
    NATT_RESET();
    for (int c0 = 0; c0 < NCMP; c0 += NATT_TILE) {
        natt_load_tile(Kt, Vt, kc + (size_t)c0 * HD, vc + (size_t)c0 * HD, HD, NCMP - c0 < NATT_TILE ? NCMP - c0 : NATT_TILE);
        for (int kk = 0; kk < NATT_TILE; ++kk) { const int c = c0 + kk; if (c < NCMP && c * CMP_STRIDE + CMP_BLOCK - 1 <= t) { float s; NATT_DOT(s, kk); NATT_UPD(s, kk); } }
    }
    { const float inv = g0 / fmaxf(l, 1e-30f);
#pragma unroll
      for (int d = 0; d < HD; d += 4) *(float4*)(op + d) = make_float4(acc[d] * inv, acc[d + 1] * inv, acc[d + 2] * inv, acc[d + 3] * inv); }
    { const float invl = 1.0f / fmaxf(l, 1e-30f); float cur = 0.f, nxt = 0.f;
      for (int c0 = 0; c0 < 128; c0 += NATT_TILE) {
        natt_load_tile(Kt, Vt, kc + (size_t)c0 * HD, vc + (size_t)c0 * HD, HD, NCMP - c0 < NATT_TILE ? NCMP - c0 : NATT_TILE);
        for (int kk = 0; kk < NATT_TILE; ++kk) { const int c = c0 + kk; float p = 0.f;
            if (c < NCMP && c * CMP_STRIDE + CMP_BLOCK - 1 <= t) { float s; NATT_DOT(s, kk); p = expf(s - mx) * invl; }
            cur += p; if ((c & 3) == 3) { nxt = p; impS[tl][g][c >> 2] = cur; cur = nxt; } }
      } }
    __syncthreads();
    if (g == 0) { for (int n = 0; n < NSLC; ++n) { const float imp = (impS[tl][0][n] + impS[tl][1][n]) + (impS[tl][2][n] + impS[tl][3][n]);
        const bool forced = (n == 0) || (n == qi) || (n == qi - 1); const bool valid = n <= qi;
        scS[tl][n] = forced ? 1e4f : (valid ? imp : -1e30f); } }
    __syncthreads();
    unsigned selmask = 0u;
    for (int n = 0; n < NSLC; ++n) { const float sn = scS[tl][n]; int rank = 0;
        for (int m2 = 0; m2 < NSLC; ++m2) { const float sm = scS[tl][m2]; rank += (sm > sn || (sm == sn && m2 < n)) ? 1 : 0; }
        if (rank < TOPN) selmask |= (1u << n); }
    NATT_RESET();
    for (int j = 0; j <= qi; ++j)
        for (int hf = 0; hf < 2; ++hf) { const int p0 = j * 64 + hf * 32;
            const float* kp = T + ((size_t)b * SEQ + p0) * NSA_COLS + (NH * HD + 2 * NKV * HD) + hk * HD; const float* vp = kp + NKV * HD;
            natt_load_tile(Kt, Vt, kp, vp, NSA_COLS, NATT_TILE);
            if ((selmask >> j) & 1u) for (int kk = 0; kk < NATT_TILE; ++kk) if (p0 + kk <= t) { float s; NATT_DOT(s, kk); NATT_UPD(s, kk); } }
    { const float inv = g1 / fmaxf(l, 1e-30f);
#pragma unroll
      for (int d = 0; d < HD; d += 4) { float4 o = *(float4*)(op + d); o.x += acc[d] * inv; o.y += acc[d + 1] * inv; o.z += acc[d + 2] * inv; o.w += acc[d + 3] * inv; *(float4*)(op + d) = o; } }
    NATT_RESET();
    for (int j = (qi >= 8 ? qi - 8 : 0); j <= qi; ++j)
        for (int hf = 0; hf < 2; ++hf) { const int p0 = j * 64 + hf * 32;
            const float* kp = T + ((size_t)b * SEQ + p0) * NSA_COLS + (NH * HD + 4 * NKV * HD) + hk * HD; const float* vp = kp + NKV * HD;
            natt_load_tile(Kt, Vt, kp, vp, NSA_COLS, NATT_TILE);
            for (int kk = 0; kk < NATT_TILE; ++kk) { const int df = t - (p0 + kk); if (df >= 0 && df < WINDOW) { float s; NATT_DOT(s, kk); NATT_UPD(s, kk); } } }
    { const float inv = g2 / fmaxf(l, 1e-30f);
#pragma unroll
      for (int d = 0; d < HD; d += 4) { float4 o = *(float4*)(op + d); o.x += acc[d] * inv; o.y += acc[d + 1] * inv; o.z += acc[d + 2] * inv; o.w += acc[d + 3] * inv; *(float4*)(op + d) = o; } }
#undef NATT_RESET
#undef NATT_DOT
#undef NATT_UPD
}

constexpr int MOE_CAP = 6144;
__global__ __launch_bounds__(256) void n_router(const float* __restrict__ x, const float* __restrict__ wr, int* __restrict__ cnt, int* __restrict__ list, int* __restrict__ tsel, float* __restrict__ twt) {
    const int m = blockIdx.x * 4 + (threadIdx.x >> 6), lane = threadIdx.x & 63;
    float lg[NEXP];
#pragma unroll
    for (int e = 0; e < NEXP; ++e) lg[e] = 0.f;
    for (int k = lane; k < DM; k += 64) { const float xv = x[(size_t)m * DM + k];
#pragma unroll
        for (int e = 0; e < NEXP; ++e) lg[e] += xv * wr[k * NEXP + e]; }
#pragma unroll
    for (int e = 0; e < NEXP; ++e) lg[e] = wave_sum(lg[e]);
    if (lane == 0) {
        int e1 = 0; float v1 = lg[0];
#pragma unroll
        for (int e = 1; e < NEXP; ++e) if (lg[e] > v1) { v1 = lg[e]; e1 = e; }
        int e2 = -1; float v2 = -3.4e38f;
#pragma unroll
        for (int e = 0; e < NEXP; ++e) if (e != e1 && lg[e] > v2) { v2 = lg[e]; e2 = e; }
        const float p2 = expf(v2 - v1), w1 = 1.0f / (1.0f + p2), w2 = p2 / (1.0f + p2);
        const int s1 = atomicAdd(cnt + e1, 1), s2 = atomicAdd(cnt + e2, 1);
        if (s1 < MOE_CAP) list[e1 * MOE_CAP + s1] = m;
        if (s2 < MOE_CAP) list[e2 * MOE_CAP + s2] = m;
        tsel[m * 4 + 0] = e1; tsel[m * 4 + 1] = s1; tsel[m * 4 + 2] = e2; tsel[m * 4 + 3] = s2; twt[m * 2] = w1; twt[m * 2 + 1] = w2;
    }
}
__global__ __launch_bounds__(256) void n_moe_scatter(const float* __restrict__ Y, const int* __restrict__ cnt, const int* __restrict__ list, const int* __restrict__ tsel, const float* __restrict__ twt, int e, float* __restrict__ F) {
    const int slot = blockIdx.x; int c = cnt[e]; c = c < MOE_CAP ? c : MOE_CAP; if (slot >= c) return;
    const int m = list[e * MOE_CAP + slot]; const float w = (tsel[m * 4] == e) ? twt[m * 2] : twt[m * 2 + 1];
    const int col = threadIdx.x * 4; const float4 y = *(const float4*)(Y + (size_t)slot * DM + col); float4 f = *(float4*)(F + (size_t)m * DM + col);
    f.x += w * y.x; f.y += w * y.y; f.z += w * y.z; f.w += w * y.w; *(float4*)(F + (size_t)m * DM + col) = f;
}


enum { I_X = 0, I_LMG, I_LMB, I_LFG, I_LFB, I_CWIN, I_CWDW, I_CBDW, I_CLNG, I_CLNB, I_CWOUT, I_SWIN, I_SWCONV, I_SWOUT, I_NWIN, I_NPEK, I_NPEV, I_NWK1, I_NWK2, I_NWV1, I_NWV2, I_NWOUT,
       I_FWG, I_FWU, I_FWD, I_MWR, I_MWG, I_MWU, I_MWD };

#define GAS __attribute__((address_space(1)))
#define LAS __attribute__((address_space(3)))
typedef unsigned short bf16;
typedef unsigned v4u __attribute__((ext_vector_type(4)));
typedef unsigned v2u __attribute__((ext_vector_type(2)));
typedef float f32x4 __attribute__((ext_vector_type(4)));
typedef float f32x2 __attribute__((ext_vector_type(2)));
typedef short bf16x8 __attribute__((ext_vector_type(8)));
typedef short s16x4 __attribute__((ext_vector_type(4)));
typedef GAS unsigned gu32;
#define RLX_AGENT __ATOMIC_RELAXED, __HIP_MEMORY_SCOPE_AGENT
#define LDS_WAIT() asm volatile("s_waitcnt lgkmcnt(0)" ::: "memory")
#define VM_WAIT() asm volatile("s_waitcnt vmcnt(0)" ::: "memory")
constexpr int NWAVES = 8, NTHR = NWAVES * 64;
__device__ __forceinline__ unsigned f2bf(float f) { unsigned u = __builtin_bit_cast(unsigned, f); return (u + 0x7fffu + ((u >> 16) & 1u)) >> 16; }
__device__ __forceinline__ unsigned pk2(float lo, float hi) { return f2bf(lo) | (f2bf(hi) << 16); }
typedef __bf16 bf16x2_t __attribute__((ext_vector_type(2)));
__device__ __forceinline__ unsigned cvt_pk_bf16(float lo, float hi) { f32x2 v = {lo, hi}; bf16x2_t b = __builtin_convertvector(v, bf16x2_t); return __builtin_bit_cast(unsigned, b); }
__device__ __forceinline__ float bf_lo(unsigned u) { return __builtin_bit_cast(float, u << 16); }
__device__ __forceinline__ float bf_hi(unsigned u) { return __builtin_bit_cast(float, u & 0xffff0000u); }
__device__ __forceinline__ float fast_sigmoid(float x) { return __builtin_amdgcn_rcpf(1.0f + __builtin_amdgcn_exp2f(-1.4426950408889634f * x)); }
__device__ __forceinline__ float fast_silu(float x) { return x * fast_sigmoid(x); }

#define XB_TMO      128
#define XB_XCNT(j)  (256  + 64 * (j))
#define XB_XSUB(j)  (1280 + 64 * (j))
#define XB_XGEN(j)  (2304 + 64 * (j))
#define XB_TOP      3328
#define XB_TOPGEN   3392
#define XCD_BAR_WORDS 3456
#define XB_SPIN_CAP (1u << 18)
__device__ __forceinline__ unsigned xb_ld(unsigned* p)              { return __hip_atomic_load(p, __ATOMIC_RELAXED, __HIP_MEMORY_SCOPE_AGENT); }
__device__ __forceinline__ unsigned xb_add(unsigned* p, unsigned v) { return __hip_atomic_fetch_add(p, v, __ATOMIC_RELAXED, __HIP_MEMORY_SCOPE_AGENT); }
__device__ __forceinline__ unsigned xb_xcc_id() { return (unsigned)__builtin_amdgcn_s_getreg((3 << 11) | 20) & 0xFu; }
#define XB_SPIN(cond, bar) do { unsigned _sp = 0; while (cond) { __builtin_amdgcn_s_sleep(1); \
    if ((++_sp & 255u) == 0u) { if (xb_ld(&(bar)[XB_TMO])) break; if (_sp > XB_SPIN_CAP) { atomicAdd(&(bar)[XB_TMO], 1u); break; } } } } while (0)
struct XcdBarrier { unsigned* bar; unsigned x; volatile LAS unsigned* st; };
__device__ __forceinline__ XcdBarrier xcd_barrier_post(unsigned* bar, volatile LAS unsigned* st) {
    XcdBarrier b; b.bar = bar; b.x = xb_xcc_id(); b.st = st;
    if (threadIdx.x == 0) (void)xb_add(&bar[XB_XCNT(b.x)], 1u);
    return b;
}
__device__ __forceinline__ void xcd_barrier_complete(unsigned* bar, unsigned x, unsigned& nloc, unsigned& nx) {
    const unsigned G = gridDim.x * gridDim.y * gridDim.z;
    unsigned sum, cnt, mine, sp = 0u;
    for (;;) {
        sum = 0u; cnt = 0u; mine = 0u;
#pragma unroll
        for (unsigned j = 0; j < 16; ++j) { const unsigned c = xb_ld(&bar[XB_XCNT(j)]); sum += c; cnt += (c > 0u) ? 1u : 0u; mine = (j == x) ? c : mine; }
        if (sum == G) break;
        __builtin_amdgcn_s_sleep(1);
        if ((++sp & 255u) == 0u) { if (xb_ld(&bar[XB_TMO])) break; if (sp > XB_SPIN_CAP) { atomicAdd(&bar[XB_TMO], 1u); break; } }
    }
    nloc = mine > 0u ? mine : 1u; nx = cnt > 0u ? cnt : 1u;
}
__device__ __forceinline__ void xcd_barrier(const XcdBarrier& b) {
    asm volatile("s_waitcnt vmcnt(0)" ::: "memory");
    __syncthreads();
    if (threadIdx.x == 0) {
        unsigned* bar = b.bar;
        __builtin_amdgcn_s_waitcnt(0);
        unsigned nloc = b.st[0], nx = b.st[1];
        if (nloc == 0u) { xcd_barrier_complete(bar, b.x, nloc, nx); b.st[0] = nloc; b.st[1] = nx; }
        const unsigned old = xb_add(&bar[XB_XSUB(b.x)], 1u);
        const unsigned gen = old / nloc;
        if (old + 1u == (gen + 1u) * nloc) {
            __builtin_amdgcn_fence(__ATOMIC_RELEASE, "agent");
            asm volatile("s_waitcnt vmcnt(0)" ::: "memory");
            const unsigned og = xb_add(&bar[XB_TOP], 1u);
            const unsigned tg = og / nx;
            if (og + 1u == (tg + 1u) * nx) xb_add(&bar[XB_TOPGEN], 1u);
            else XB_SPIN(xb_ld(&bar[XB_TOPGEN]) == tg, bar);
            __builtin_amdgcn_fence(__ATOMIC_ACQUIRE, "agent");
            xb_add(&bar[XB_XGEN(b.x)], 1u);
            asm volatile("s_waitcnt vmcnt(0)" ::: "memory");
        } else {
            XB_SPIN(xb_ld(&bar[XB_XGEN(b.x)]) == gen, bar);
            __builtin_amdgcn_fence(__ATOMIC_ACQUIRE, "agent");
            asm volatile("s_waitcnt vmcnt(0)" ::: "memory");
        }
    }
    __syncthreads();
}

namespace pg8 {
#define PG8_LAS __attribute__((address_space(3)))
typedef unsigned short bf16_t;
constexpr int BM = 256, BK = 64, HALF = 128, HTB = HALF * BK * 2  , STAGE_BYTES = 8 * HTB, NXCD = 8, WGM = 8;
__host__ __device__ __forceinline__ int lds_byte(int r, int c) { const int st = (r >> 4) * 2 + (c >> 5), rr = r & 15, cc = c & 31, ob = rr * 64 + cc * 2; return st * 1024 + (ob ^ (((ob >> 9) & 1) << 5)); }
__host__ __device__ __forceinline__ void stage_rc(int b, int& R, int& C) { const int st = b / 1024, sb = b % 1024, swz = sb ^ (((sb >> 9) & 1) << 5); R = (st >> 1) * 16 + swz / 64; C = (st & 1) * 32 + (swz % 64) / 2; }
__host__ __device__ __forceinline__ int perm32(int rho) { const int n = rho >> 4, i = rho & 15; return 8 * (i >> 2) + 4 * n + (i & 3); }

struct Unit { int pm, pn, eb, kh; };
struct Gemm { const bf16_t* A; const bf16_t* Bt; int lda, ldb, K; size_t bexp; };

struct StaticOrder {
    int nM, nN, nwg, G, c;
    __host__ __device__ void init(int nM_, int nN_, int G_, int c_) { nM = nM_; nN = nN_; nwg = nM * nN; G = G_; c = c_; }
    __host__ __device__ bool next(int i, Unit& u) const {
        const long L = (long)i * G + c; if (L >= nwg) return false;
        int wgid = (int)L; { const int q = nwg / NXCD, r = nwg % NXCD, xcd = wgid % NXCD, off = wgid / NXCD; wgid = (xcd < r ? xcd * (q + 1) : r * (q + 1) + (xcd - r) * q) + off; }
        const int nig = WGM * nN, gid = wgid / nig, fm = gid * WGM, gsz = (nM - fm) < WGM ? (nM - fm) : WGM;
        u.pm = fm + ((wgid % nig) % gsz); u.pn = (wgid % nig) / gsz; u.eb = 0; u.kh = 0; return true;
    }
    __device__ __forceinline__ void a_ready(const Unit&) const {}
    __device__ __forceinline__ void done(const Unit&) const {}
};
struct GroupedOrder : StaticOrder {
    int pb[9];
    __device__ __forceinline__ bool next(int i, Unit& u) const {
        if (!StaticOrder::next(i, u)) return false;
        int e = 0;
#pragma unroll
        for (int k = 1; k < 8; ++k) e += (u.pm >= pb[k]) ? 1 : 0;
        u.eb = e; u.kh = u.pn >> 2; u.pn &= 3; return true;
    }
};
struct GroupedOrderWide : StaticOrder {
    int pb[9]; int pin;
    __device__ __forceinline__ bool next(int i, Unit& u) const {
        if (!StaticOrder::next(i, u)) return false;
        if (pin) { u.pm = 0; u.pn = 0; u.eb = 0; return true; }
        int e = 0;
#pragma unroll
        for (int k = 1; k < 8; ++k) e += (u.pm >= pb[k]) ? 1 : 0;
        u.eb = e; return true;
    }
};

template <class Epi, class Sched, bool ALIGN_EPI = false, bool SP2 = false, bool GATHER = false>
__device__ __forceinline__ void gemm_phase(PG8_LAS unsigned char* lds, const Gemm g, const Sched& S, const Epi& E, const PG8_LAS int* gidx = nullptr) {
    const int tid = threadIdx.x, wid = __builtin_amdgcn_readfirstlane(tid >> 6), lane = tid & 63, wr = wid >> 2, wc = wid & 3, fr = lane & 15, fq = lane >> 4;
    const int K = g.K, nt = K / BK;
    unsigned voffA[2], voffB[2];
#pragma unroll
    for (int i = 0; i < 2; ++i) { int R, C; stage_rc(tid * 16 + i * 8192, R, C); const int Rb = Epi::PERM ? ((R & ~31) + perm32(R & 31)) : R;
        voffA[i] = (unsigned)(R * g.lda + C) * 2u; voffB[i] = (unsigned)(Rb * g.ldb + C) * 2u; }
    unsigned vA0[2], vA1[2], vN0[2], vN1[2];
#define PG8_GLOAD(d0, d1, ui_) do { _Pragma("unroll") for (int _i = 0; _i < 2; ++_i) { int R_, C_; stage_rc(tid * 16 + _i * 8192, R_, C_); \
        d0[_i] = (unsigned)(gidx[(ui_) * 256 + R_] * g.lda + C_) * 2u; d1[_i] = (unsigned)(gidx[(ui_) * 256 + HALF + R_] * g.lda + C_) * 2u; } } while (0)
    const size_t kstep = (size_t)(BK * 2);
    const size_t hstepA = GATHER ? (size_t)0 : (size_t)HALF * g.lda * 2, hstepB = (size_t)HALF * g.ldb * 2;
    const size_t tstepA = 2 * hstepA, tstepB = 2 * hstepB;
    const unsigned ldsw = (unsigned)wid * 1024u;
    const int aoff = lds_byte(wr * 64 + fr, fq * 8), boff = lds_byte(wc * 32 + fr, fq * 8);
#define PG8_SA(b, h) (((b) * 2 + (h)) * HTB)
#define PG8_SB(b, h) ((4 + (b) * 2 + (h)) * HTB)
#define PG8_STAGE(bufoff, gbase, voff) do { _Pragma("unroll") for (int _i = 0; _i < 2; ++_i) \
        __builtin_amdgcn_global_load_lds((const unsigned*)((const char*)(gbase) + (voff)[_i]), (PG8_LAS unsigned*)(lds + (bufoff) + ldsw + _i * 8192), 16, 0, 0); } while (0)
#define PG8_STAGE_A0(bufoff, gbase, nx) do { if constexpr (GATHER) { if (nx) PG8_STAGE(bufoff, gbase, vN0); else PG8_STAGE(bufoff, gbase, vA0); } else PG8_STAGE(bufoff, gbase, voffA); } while (0)
#define PG8_STAGE_A1(bufoff, gbase, nx) do { if constexpr (GATHER) { if (nx) PG8_STAGE(bufoff, gbase, vN1); else PG8_STAGE(bufoff, gbase, vA1); } else PG8_STAGE(bufoff, (gbase) + hstepA, voffA); } while (0)
#define PG8_LDA(dst, b, h) do { _Pragma("unroll") for (int m = 0; m < 4; ++m) _Pragma("unroll") for (int k = 0; k < 2; ++k) dst[m][k] = *(const PG8_LAS bf16x8*)(lds + PG8_SA(b, h) + aoff + m * 2048 + k * 1024); } while (0)
#define PG8_LDB(dst, b, h) do { _Pragma("unroll") for (int n = 0; n < 2; ++n) _Pragma("unroll") for (int k = 0; k < 2; ++k) dst[n][k] = *(const PG8_LAS bf16x8*)(lds + PG8_SB(b, h) + boff + n * 2048 + k * 1024); } while (0)
#define PG8_MMA(ai, bj, At, Bt) do { __builtin_amdgcn_s_setprio(1); _Pragma("unroll") for (int m = 0; m < 4; ++m) _Pragma("unroll") for (int n = 0; n < 2; ++n) _Pragma("unroll") for (int k = 0; k < 2; ++k) \
        acc[ai][bj][m][n] = __builtin_amdgcn_mfma_f32_16x16x32_bf16(Bt[n][k], At[m][k], acc[ai][bj][m][n], 0, 0, 0); __builtin_amdgcn_s_setprio(0); } while (0)
#define PG8_WAIT_V(n) asm volatile("s_waitcnt vmcnt(" #n ")" ::: "memory")
#define PG8_WAIT_L(n) asm volatile("s_waitcnt lgkmcnt(" #n ")" ::: "memory")
#define PG8_BAR __builtin_amdgcn_s_barrier()
#define PG8_SCHED __builtin_amdgcn_sched_barrier(0)
    Unit cur, nxt; int ui = 0;
    if (!S.next(0, cur)) return;
    f32x4 acc[2][2][4][2];
#pragma unroll
    for (int a = 0; a < 2; ++a)
#pragma unroll
        for (int b = 0; b < 2; ++b)
#pragma unroll
            for (int m = 0; m < 4; ++m)
#pragma unroll
                for (int n = 0; n < 2; ++n) acc[a][b][m][n] = (f32x4){0.f, 0.f, 0.f, 0.f};
    bf16x8 At[4][2], B0[2][2], B1[2][2];
    const size_t kslice = (size_t)K * 2;
    const char* cA = (const char*)g.A + (GATHER ? (size_t)0 : (size_t)cur.pm * tstepA) + (size_t)cur.kh * kslice; const char* cB = (const char*)g.Bt + (size_t)cur.eb * g.bexp + (size_t)cur.pn * tstepB + (size_t)cur.kh * kslice;
    S.a_ready(cur);
    if constexpr (GATHER) { PG8_GLOAD(vA0, vA1, 0); }
    if constexpr (SP2) {
        PG8_STAGE(PG8_SB(0, 0), cB, voffB); PG8_STAGE(PG8_SB(0, 1), cB + hstepB, voffB); PG8_STAGE_A0(PG8_SA(0, 0), cA, false); PG8_STAGE_A1(PG8_SA(0, 1), cA, false);
        if (wr == 1) PG8_BAR;
        PG8_WAIT_V(2); PG8_BAR;
        PG8_STAGE(PG8_SB(1, 0), cB + kstep, voffB); PG8_STAGE_A0(PG8_SA(1, 0), cA + kstep, false); PG8_STAGE(PG8_SB(1, 1), cB + hstepB + kstep, voffB);
        PG8_WAIT_V(6); PG8_BAR;
    } else {
        PG8_STAGE(PG8_SB(0, 0), cB, voffB); PG8_STAGE_A0(PG8_SA(0, 0), cA, false); PG8_STAGE(PG8_SB(0, 1), cB + hstepB, voffB); PG8_STAGE_A1(PG8_SA(0, 1), cA, false);
        if (wr == 1) PG8_BAR;
        PG8_WAIT_V(4); PG8_BAR;
        PG8_STAGE(PG8_SB(1, 0), cB + kstep, voffB); PG8_STAGE_A0(PG8_SA(1, 0), cA + kstep, false); PG8_STAGE(PG8_SB(1, 1), cB + hstepB + kstep, voffB);
        PG8_WAIT_V(6); PG8_BAR;
    }
    for (;;) {
        const bool has_next = S.next(ui + 1, nxt);
        const char* nA = has_next ? (const char*)g.A + (GATHER ? (size_t)0 : (size_t)nxt.pm * tstepA) + (size_t)nxt.kh * kslice : cA; const char* nB = has_next ? (const char*)g.Bt + (size_t)nxt.eb * g.bexp + (size_t)nxt.pn * tstepB + (size_t)nxt.kh * kslice : cB;
        for (int t = 0; t < nt; t += 2) {
            const bool last = (t == nt - 2);
            const char* a1 = cA + (size_t)(t + 1) * kstep;
            const char* a2 = last ? nA : cA + (size_t)(t + 2) * kstep; const char* b2 = last ? nB : cB + (size_t)(t + 2) * kstep;
            const char* a3 = a2 + kstep; const char* b3 = b2 + kstep;
            const bool lastn = last && has_next;
            if (lastn) { S.a_ready(nxt); if constexpr (GATHER) PG8_GLOAD(vN0, vN1, ui + 1); }
            if constexpr (SP2) {
            PG8_LDB(B0, 0, 0); PG8_LDB(B1, 0, 1); PG8_SCHED; PG8_LDA(At, 0, 0); PG8_STAGE_A1(PG8_SA(1, 1), a1, false);
            PG8_WAIT_V(8); PG8_WAIT_L(0); PG8_BAR; PG8_MMA(0, 0, At, B0); PG8_MMA(0, 1, At, B1); PG8_BAR; PG8_SCHED;
            PG8_LDA(At, 0, 1); PG8_STAGE(PG8_SB(0, 0), b2, voffB); PG8_STAGE(PG8_SB(0, 1), b2 + hstepB, voffB); PG8_STAGE_A0(PG8_SA(0, 0), a2, lastn);
            PG8_WAIT_V(8); PG8_WAIT_L(0); PG8_BAR; PG8_MMA(1, 0, At, B0); PG8_MMA(1, 1, At, B1); PG8_BAR; PG8_SCHED;
            PG8_LDB(B0, 1, 0); PG8_LDB(B1, 1, 1); PG8_SCHED; PG8_LDA(At, 1, 0); PG8_STAGE_A1(PG8_SA(0, 1), a2, lastn);
            PG8_WAIT_V(8); PG8_WAIT_L(0); PG8_BAR; PG8_MMA(0, 0, At, B0); PG8_MMA(0, 1, At, B1); PG8_BAR; PG8_SCHED;
            PG8_LDA(At, 1, 1); PG8_STAGE(PG8_SB(1, 0), b3, voffB); PG8_STAGE(PG8_SB(1, 1), b3 + hstepB, voffB); PG8_STAGE_A0(PG8_SA(1, 0), a3, lastn);
            PG8_WAIT_V(8); PG8_WAIT_L(0); PG8_BAR; PG8_MMA(1, 0, At, B0); PG8_MMA(1, 1, At, B1); PG8_BAR; PG8_SCHED;
            } else {
            PG8_LDB(B0, 0, 0); PG8_SCHED; PG8_LDA(At, 0, 0); PG8_STAGE_A1(PG8_SA(1, 1), a1, false);
            PG8_WAIT_L(8); PG8_BAR; PG8_WAIT_L(0); PG8_MMA(0, 0, At, B0); PG8_BAR; PG8_SCHED;
            PG8_LDB(B1, 0, 1); PG8_STAGE(PG8_SB(0, 0), b2, voffB);
            PG8_BAR; PG8_WAIT_L(0); PG8_MMA(0, 1, At, B1); PG8_BAR;
            PG8_LDA(At, 0, 1); PG8_STAGE_A0(PG8_SA(0, 0), a2, lastn);
            PG8_BAR; PG8_WAIT_L(0); PG8_MMA(1, 0, At, B0); PG8_BAR; PG8_SCHED;
            PG8_STAGE(PG8_SB(0, 1), b2 + hstepB, voffB);
            PG8_WAIT_V(6); PG8_BAR; PG8_MMA(1, 1, At, B1); PG8_BAR;
            PG8_LDB(B0, 1, 0); PG8_SCHED; PG8_LDA(At, 1, 0); PG8_STAGE_A1(PG8_SA(0, 1), a2, lastn);
            PG8_WAIT_L(8); PG8_BAR; PG8_WAIT_L(0); PG8_MMA(0, 0, At, B0); PG8_BAR; PG8_SCHED;
            PG8_LDB(B1, 1, 1); PG8_STAGE(PG8_SB(1, 0), b3, voffB);
            PG8_BAR; PG8_WAIT_L(0); PG8_MMA(0, 1, At, B1); PG8_BAR;
            PG8_LDA(At, 1, 1); PG8_STAGE_A0(PG8_SA(1, 0), a3, lastn);
            PG8_BAR; PG8_WAIT_L(0); PG8_MMA(1, 0, At, B0); PG8_BAR; PG8_SCHED;
            PG8_STAGE(PG8_SB(1, 1), b3 + hstepB, voffB);
            PG8_WAIT_V(6); PG8_BAR; PG8_MMA(1, 1, At, B1); PG8_BAR;
            }
        }
        if constexpr (ALIGN_EPI) { if (wr == 0) PG8_BAR; }
        E(acc, cur, wr, wc, fr, fq); S.done(cur);
        if (!has_next) break;
#pragma unroll
        for (int a = 0; a < 2; ++a)
#pragma unroll
            for (int b = 0; b < 2; ++b)
#pragma unroll
                for (int m = 0; m < 4; ++m)
#pragma unroll
                    for (int n = 0; n < 2; ++n) acc[a][b][m][n] = (f32x4){0.f, 0.f, 0.f, 0.f};
        cur = nxt; cA = nA; cB = nB; ++ui;
        if constexpr (GATHER) { vA0[0] = vN0[0]; vA0[1] = vN0[1]; vA1[0] = vN1[0]; vA1[1] = vN1[1]; }
        if constexpr (ALIGN_EPI) { if (wr == 1) PG8_BAR; }
    }
    PG8_WAIT_V(0);
    if constexpr (!ALIGN_EPI) { if (wr == 0) PG8_BAR; }
    PG8_BAR;
#undef PG8_SA
#undef PG8_SB
#undef PG8_STAGE
#undef PG8_STAGE_A0
#undef PG8_STAGE_A1
#undef PG8_GLOAD
#undef PG8_LDA
#undef PG8_LDB
#undef PG8_MMA
#undef PG8_WAIT_V
#undef PG8_WAIT_L
#undef PG8_BAR
#undef PG8_SCHED
}

template <int MODE> struct EpiPair {
    static constexpr bool PERM = true;
    bf16_t* O; int ldc;
    __device__ __forceinline__ void operator()(const f32x4 (&acc)[2][2][4][2], const Unit& u, int wr, int wc, int fr, int fq) const {
        const int row0 = u.pm * BM + wr * 64 + fr, col0 = u.pn * HALF + wc * 32 + 8 * fq;
#pragma unroll
        for (int ai = 0; ai < 2; ++ai)
#pragma unroll
            for (int m = 0; m < 4; ++m) { bf16_t* p = O + (size_t)(row0 + ai * HALF + m * 16) * ldc + col0; float r[8];
#pragma unroll
                for (int n = 0; n < 2; ++n)
#pragma unroll
                    for (int j = 0; j < 4; ++j) { const float x0 = acc[ai][0][m][n][j], x1 = acc[ai][1][m][n][j];
                        r[n * 4 + j] = MODE == 0 ? x0 * fast_sigmoid(x1) : (MODE == 1 ? fast_silu(x0) * x1 : x0 * x1); }
                v4u w; w.x = cvt_pk_bf16(r[0], r[1]); w.y = cvt_pk_bf16(r[2], r[3]); w.z = cvt_pk_bf16(r[4], r[5]); w.w = cvt_pk_bf16(r[6], r[7]);
                *(v4u*)p = w; }
    }
};
struct EpiBf16 {
    static constexpr bool PERM = true;
    bf16_t* O; int ldc; float scale; size_t slab;
    __device__ __forceinline__ void operator()(const f32x4 (&acc)[2][2][4][2], const Unit& u, int wr, int wc, int fr, int fq) const {
        const int row0 = u.pm * BM + wr * 64 + fr, col0 = u.pn * BM + wc * 32 + 8 * fq;
#pragma unroll
        for (int ai = 0; ai < 2; ++ai)
#pragma unroll
            for (int m = 0; m < 4; ++m) { bf16_t* rowp = O + (size_t)u.kh * slab + (size_t)(row0 + ai * HALF + m * 16) * ldc + col0;
#pragma unroll
                for (int bj = 0; bj < 2; ++bj) { const f32x4 v0 = acc[ai][bj][m][0] * scale, v1 = acc[ai][bj][m][1] * scale;
                    v4u w; w.x = cvt_pk_bf16(v0[0], v0[1]); w.y = cvt_pk_bf16(v0[2], v0[3]); w.z = cvt_pk_bf16(v1[0], v1[1]); w.w = cvt_pk_bf16(v1[2], v1[3]);
                    *(v4u*)(rowp + bj * HALF) = w; } }
    }
};
struct EpiResid {
    static constexpr bool PERM = true;
    bf16_t* XB; int ldc;
    __device__ __forceinline__ void operator()(const f32x4 (&acc)[2][2][4][2], const Unit& u, int wr, int wc, int fr, int fq) const {
        const int row0 = u.pm * BM + wr * 64 + fr, col0 = u.pn * BM + wc * 32 + 8 * fq;
#pragma unroll
        for (int ai = 0; ai < 2; ++ai)
#pragma unroll
            for (int m = 0; m < 4; ++m) { bf16_t* rowp = XB + (size_t)(row0 + ai * HALF + m * 16) * ldc + col0;
#pragma unroll
                for (int bj = 0; bj < 2; ++bj) { const v4u r = *(const v4u*)(rowp + bj * HALF); const f32x4 a0 = acc[ai][bj][m][0], a1 = acc[ai][bj][m][1];
                    v4u w; w.x = cvt_pk_bf16(bf_lo(r.x) * ALPHA_F + a0[0], bf_hi(r.x) * ALPHA_F + a0[1]); w.y = cvt_pk_bf16(bf_lo(r.y) * ALPHA_F + a0[2], bf_hi(r.y) * ALPHA_F + a0[3]);
                    w.z = cvt_pk_bf16(bf_lo(r.z) * ALPHA_F + a1[0], bf_hi(r.z) * ALPHA_F + a1[1]); w.w = cvt_pk_bf16(bf_lo(r.w) * ALPHA_F + a1[2], bf_hi(r.w) * ALPHA_F + a1[3]);
                    *(v4u*)(rowp + bj * HALF) = w; } }
    }
};
}
namespace pg8 {
struct EpiSC {
    static constexpr bool PERM = true;
    bf16_t* CH; bf16_t* BG;
    __device__ __forceinline__ void operator()(const f32x4 (&acc)[2][2][4][2], const Unit& u, int wr, int wc, int fr, int fq) const {
        if (u.pn < 8) { EpiPair<2> e{CH, DM}; e(acc, u, wr, wc, fr, fq); }
        else { Unit u2 = u; u2.pn = u.pn - 8; EpiBf16 e{BG, DM, 1.0f, 0}; e(acc, u2, wr, wc, fr, fq); }
    }
};
}
namespace pg8 {
struct EpiNSA {
    static constexpr bool PERM = true;
    bf16_t* Q; bf16_t* KV; float* GATE;
    __device__ __forceinline__ void operator()(const f32x4 (&acc)[2][2][4][2], const Unit& u, int wr, int wc, int fr, int fq) const {
        const int b = u.pm >> 3, tb = (u.pm & 7) * 256 + wr * 64 + fr, d0 = 32 * (wc & 1) + 8 * fq;
        if (u.pn < 4) {
            const float sc = 0.125f * 1.4426950408889634f;
#pragma unroll
            for (int ai = 0; ai < 2; ++ai)
#pragma unroll
                for (int m = 0; m < 4; ++m) { const int t = tb + ai * HALF + m * 16;
#pragma unroll
                    for (int bj = 0; bj < 2; ++bj) { const int h = u.pn * 4 + 2 * bj + (wc >> 1); const f32x4 v0 = acc[ai][bj][m][0] * sc, v1 = acc[ai][bj][m][1] * sc;
                        v4u w; w.x = cvt_pk_bf16(v0[0], v0[1]); w.y = cvt_pk_bf16(v0[2], v0[3]); w.z = cvt_pk_bf16(v1[0], v1[1]); w.w = cvt_pk_bf16(v1[2], v1[3]);
                        *(v4u*)(Q + (((size_t)(b * NH + h) * SEQ + t) * HD + d0)) = w; } }
        } else if (u.pn < 10) {
            const int ti = u.pn - 4; bf16_t* base = KV + (size_t)ti * (4u << 20);
            const bool tr = (ti == 3) || (ti == 5);
#pragma unroll
            for (int ai = 0; ai < 2; ++ai)
#pragma unroll
                for (int m = 0; m < 4; ++m) { const int t = tb + ai * HALF + m * 16;
#pragma unroll
                    for (int bj = 0; bj < 2; ++bj) { const int hk = 2 * bj + (wc >> 1); const f32x4 v0 = acc[ai][bj][m][0], v1 = acc[ai][bj][m][1];
                        if (!tr) { v4u w; w.x = cvt_pk_bf16(v0[0], v0[1]); w.y = cvt_pk_bf16(v0[2], v0[3]); w.z = cvt_pk_bf16(v1[0], v1[1]); w.w = cvt_pk_bf16(v1[2], v1[3]);
                            *(v4u*)(base + (((size_t)(b * NKV + hk) * SEQ + t) * HD + d0)) = w; }
                        else { bf16_t* p = base + ((size_t)(b * NKV + hk) * HD + d0) * SEQ + t;
#pragma unroll
                            for (int j = 0; j < 4; ++j) { p[(size_t)j * SEQ] = (bf16_t)f2bf(v0[j]); p[(size_t)(4 + j) * SEQ] = (bf16_t)f2bf(v1[j]); } } } }
        } else {
            if (wc < 2 && (wc == 0 || fq < 2)) {
#pragma unroll
                for (int ai = 0; ai < 2; ++ai)
#pragma unroll
                    for (int m = 0; m < 4; ++m) { const size_t row = (size_t)u.pm * BM + wr * 64 + fr + ai * HALF + m * 16; float* p = GATE + row * 48 + 32 * wc + 8 * fq;
                        const f32x4 v0 = acc[ai][0][m][0], v1 = acc[ai][0][m][1];
                        *(f32x4*)p = (f32x4){fast_sigmoid(v0[0]), fast_sigmoid(v0[1]), fast_sigmoid(v0[2]), fast_sigmoid(v0[3])};
                        *(f32x4*)(p + 4) = (f32x4){fast_sigmoid(v1[0]), fast_sigmoid(v1[1]), fast_sigmoid(v1[2]), fast_sigmoid(v1[3])}; }
            }
        }
    }
};
}

constexpr size_t MiB = 1u << 20;
constexpr size_t WS_CTL = 0, CTL_ZERO_BYTES = 1 * MiB;
constexpr size_t WS_X = 1 * MiB;
constexpr size_t WS_XBF = 65 * MiB;
constexpr size_t WS_ACT = 97 * MiB;
constexpr size_t WS_H = 233 * MiB;
constexpr size_t WS_MISC = 471 * MiB;
constexpr size_t WS_W = 475 * MiB;
constexpr size_t W_CONF_IN = WS_W, W_CONF_OUT = W_CONF_IN + 8 * MiB, W_SC_IN = W_CONF_OUT + 4 * MiB, W_SC_OUT = W_SC_IN + 6 * MiB;
constexpr size_t W_NSA_IN = W_SC_OUT + 2 * MiB, W_NSA_OUT = W_NSA_IN + 6 * MiB, W_CMP1 = W_NSA_OUT + 2 * MiB;
constexpr size_t W_FFN_GU = W_CMP1 + 1 * MiB, W_FFN_D = W_FFN_GU + 22 * MiB, W_MOE_GU = W_FFN_D + 11 * MiB, W_MOE_D = W_MOE_GU + 224 * MiB, WS_END = W_MOE_D + 112 * MiB;
static_assert(WS_END <= 896 * MiB, "workspace map");
constexpr size_t A_U = WS_ACT, A_V = WS_ACT + 32 * MiB;
constexpr size_t A_CH = WS_ACT, A_BG = WS_ACT + 32 * MiB, A_YSC = WS_ACT + 64 * MiB;
constexpr size_t A_Q = WS_ACT, A_KC = WS_ACT + 32 * MiB, A_VCT = A_KC + 8 * MiB, A_KS = A_VCT + 8 * MiB, A_VST = A_KS + 8 * MiB, A_KW = A_VST + 8 * MiB, A_VWT = A_KW + 8 * MiB;
constexpr size_t A_O = A_VWT + 8 * MiB, A_GATE = A_O + 32 * MiB, A_KCMP = A_GATE + 4 * MiB, A_VCMPT = A_KCMP + 1 * MiB;
constexpr size_t A_PERM = WS_ACT;
static_assert(A_VCMPT + 1 * MiB <= WS_ACT + 136 * MiB, "ACT map");
constexpr int MOE_ROWS_MAX = 2 * MTOK + NEXP * 256;
constexpr size_t MOE_SLAB = (size_t)MOE_ROWS_MAX * DM;
static_assert((size_t)MOE_ROWS_MAX * DFFE * 2 <= 238 * MiB && 2 * MOE_SLAB * 2 <= 136 * MiB, "MoE buffers");
constexpr size_t MS_LIST = WS_MISC, MS_TSEL = MS_LIST + (size_t)NEXP * MTOK * 4, MS_TWT = MS_TSEL + (size_t)MTOK * 16, MS_END = MS_TWT + (size_t)MTOK * 8;
static_assert(MS_END <= WS_MISC + 4 * MiB, "MISC map");
constexpr int CW_BAR = 4096;
constexpr int CW_MOE = 16384;
constexpr int RING_BYTES = 131072, LDSCTL_OFF = RING_BYTES, LDS_BYTES = 163840, GIDX_OFF = LDSCTL_OFF + 1024, GIDX_UNITS = 31;

struct CvtGroup { int in_idx, nmat; size_t src_stride; int ld, col0, K, ncols; size_t dst; size_t dst_stride; int rs, off; };
constexpr int NGROUPS = 17;
__device__ constexpr CvtGroup kGroups[NGROUPS] = {
    {I_CWIN, 2, (size_t)DM * 2 * DM, 2 * DM, 0, DM, DM, W_CONF_IN, 4 * MiB, 256, 0},
    {I_CWIN, 2, (size_t)DM * 2 * DM, 2 * DM, DM, DM, DM, W_CONF_IN, 4 * MiB, 256, 128},
    {I_CWOUT, 2, (size_t)DM * DM, DM, 0, DM, DM, W_CONF_OUT, 2 * MiB, 128, 0},
    {I_SWIN, 1, 0, 3 * DM, 0, DM, DM, W_SC_IN, 0, 128, 2048},
    {I_SWIN, 1, 0, 3 * DM, DM, DM, DM, W_SC_IN, 0, 256, 0},
    {I_SWIN, 1, 0, 3 * DM, 2 * DM, DM, DM, W_SC_IN, 0, 256, 128},
    {I_SWOUT, 1, 0, DM, 0, DM, DM, W_SC_OUT, 0, 128, 0},
    {I_NWIN, 1, 0, NSA_COLS, 0, DM, NSA_COLS, W_NSA_IN, 0, 128, 0},
    {I_NWOUT, 1, 0, DM, 0, DM, DM, W_NSA_OUT, 0, 128, 0},
    {I_NWK1, 1, 0, PHI, 0, CMP_BLOCK * HD, PHI, W_CMP1, 0, 128, 0},
    {I_NWV1, 1, 0, PHI, 0, CMP_BLOCK * HD, PHI, W_CMP1, 0, 128, 128},
    {I_FWG, 2, (size_t)DM * DFF, DFF, 0, DM, DFF, W_FFN_GU, 11 * MiB, 256, 0},
    {I_FWU, 2, (size_t)DM * DFF, DFF, 0, DM, DFF, W_FFN_GU, 11 * MiB, 256, 128},
    {I_FWD, 2, (size_t)DFF * DM, DM, 0, DFF, DM, W_FFN_D, (size_t)DM * DFF * 2, 128, 0},
    {I_MWG, 16, (size_t)DM * DFFE, DFFE, 0, DM, DFFE, W_MOE_GU, (size_t)2 * DFFE * DM * 2, 256, 0},
    {I_MWU, 16, (size_t)DM * DFFE, DFFE, 0, DM, DFFE, W_MOE_GU, (size_t)2 * DFFE * DM * 2, 256, 128},
    {I_MWD, 16, (size_t)DFFE * DM, DM, 0, DFFE, DM, W_MOE_D, (size_t)DM * DFFE * 2, 128, 0},
};
__host__ __device__ constexpr int grp_items_per_mat(int gi) { return (kGroups[gi].K / 64) * ((kGroups[gi].ncols + 31) / 32); }
__host__ __device__ constexpr int grp_items(int gi) { return kGroups[gi].nmat * grp_items_per_mat(gi); }
__host__ __device__ constexpr int grp_total() { int s = 0; for (int i = 0; i < NGROUPS; ++i) s += grp_items(i); return s; }
static_assert(W_FFN_GU + 2 * 11 * MiB == W_FFN_D && (size_t)2 * DFF * DM * 2 == 11 * MiB && (size_t)2 * DFFE * DM * 2 * 16 == 224 * MiB && (size_t)DM * DFFE * 2 * 16 == 112 * MiB, "weight map");

__device__ __forceinline__ void cvt_item(const float* src, int ld, int nvalid, bf16* dst, int Kd, int k0, LAS float* scr, int lane) {
    const int lr = lane >> 3, lc = (lane & 7) * 4;
    f32x4 v[8];
#pragma unroll
    for (int i = 0; i < 8; ++i) v[i] = (lc < nvalid) ? __builtin_nontemporal_load((const GAS f32x4*)(src + (size_t)(i * 8 + lr) * ld + lc)) : (f32x4){0.f, 0.f, 0.f, 0.f};
#pragma unroll
    for (int i = 0; i < 8; ++i) { LAS float* d = scr + (i * 8 + lr) * 33 + lc; d[0] = v[i].x; d[1] = v[i].y; d[2] = v[i].z; d[3] = v[i].w; }
    LDS_WAIT(); asm volatile("" ::: "memory");
    const int c = lane & 7;
#pragma unroll
    for (int j = 0; j < 4; ++j) { const int n = (lane >> 3) + 8 * j; const LAS float* s = scr + (8 * c) * 33 + n;
        v4u o; o.x = pk2(s[0 * 33], s[1 * 33]); o.y = pk2(s[2 * 33], s[3 * 33]); o.z = pk2(s[4 * 33], s[5 * 33]); o.w = pk2(s[6 * 33], s[7 * 33]);
        *(GAS v4u*)(dst + (size_t)n * Kd + k0 + 8 * c) = o; }
    LDS_WAIT(); asm volatile("" ::: "memory");
}
struct FArgs { const float* in[29]; float* out; unsigned char* ws; int ph_lo, ph_hi, dbg, pad; };

__device__ __forceinline__ void phase_prologue(const FArgs& a, LAS unsigned char* lds, int gw, int NGW, int wave, int lane) {
    LAS float* scr = (LAS float*)(lds + wave * 16384);
    constexpr int NITEMS = grp_total();
    for (int it = gw; it < NITEMS; it += NGW) {
        int r = it, gi = 0;
#pragma unroll 1
        for (; gi < NGROUPS - 1; ++gi) { const int n = grp_items(gi); if (r < n) break; r -= n; }
        const CvtGroup G = kGroups[gi];
        const int ipm = (G.K / 64) * ((G.ncols + 31) / 32), mat = r / ipm, r2 = r % ipm, nblk = (G.ncols + 31) / 32, kb = r2 / nblk, nb = r2 % nblk;
        const int c0 = nb * 32, k0 = kb * 64, drow = (c0 / 128) * G.rs + (c0 % 128) + G.off;
        const float* src = a.in[G.in_idx] + (size_t)mat * G.src_stride + (size_t)k0 * G.ld + G.col0 + c0;
        bf16* dst = (bf16*)(a.ws + G.dst + (size_t)mat * G.dst_stride) + (size_t)drow * G.K;
        const int nvalid = (G.ncols - c0) < 32 ? (G.ncols - c0) : 32;
        cvt_item(src, G.ld, nvalid, dst, G.K, k0, scr, lane);
    }
    { const float* x = a.in[I_X]; bf16* xb = (bf16*)(a.ws + WS_XBF);
      for (size_t i = (size_t)gw * 64 + lane; i < (size_t)MTOK * DM / 8; i += (size_t)NGW * 64) {
        const f32x4 v0 = *(const GAS f32x4*)(x + i * 8), v1 = *(const GAS f32x4*)(x + i * 8 + 4);
        v4u o; o.x = pk2(v0.x, v0.y); o.y = pk2(v0.z, v0.w); o.z = pk2(v1.x, v1.y); o.w = pk2(v1.z, v1.w); *(GAS v4u*)(xb + i * 8) = o; } }
}

__device__ __forceinline__ void ln_load_row(const bf16* row, int lane, f32x4 (&v)[4]) {
    const GAS v4u* yr = (const GAS v4u*)row + lane;
#pragma unroll
    for (int j = 0; j < 2; ++j) { const v4u r = yr[64 * j]; v[2 * j] = (f32x4){bf_lo(r.x), bf_hi(r.x), bf_lo(r.y), bf_hi(r.y)}; v[2 * j + 1] = (f32x4){bf_lo(r.z), bf_hi(r.z), bf_lo(r.w), bf_hi(r.w)}; }
}
__device__ __forceinline__ void ln_normalize(f32x4 (&v)[4], const f32x4 (&gg)[4], const f32x4 (&bb)[4]) {
    float s = 0.f;
#pragma unroll
    for (int j = 0; j < 4; ++j) s += (v[j].x + v[j].y) + (v[j].z + v[j].w);
    const float mean = wave_sum(s) * (1.f / DM); float s2 = 0.f;
#pragma unroll
    for (int j = 0; j < 4; ++j) { v[j] = v[j] - mean; s2 += (v[j].x * v[j].x + v[j].y * v[j].y) + (v[j].z * v[j].z + v[j].w * v[j].w); }
    const float rstd = 1.f / sqrtf(wave_sum(s2) * (1.f / DM) + LN_EPS);
#pragma unroll
    for (int j = 0; j < 4; ++j) v[j] = v[j] * rstd * gg[j] + bb[j];
}
__device__ __forceinline__ void ln_store_row(bf16* row, float* xo, int lane, const f32x4 (&v)[4]) {
    if (row) { GAS v4u* o = (GAS v4u*)row + lane;
#pragma unroll
        for (int j = 0; j < 2; ++j) { v4u w; w.x = pk2(v[2 * j].x, v[2 * j].y); w.y = pk2(v[2 * j].z, v[2 * j].w); w.z = pk2(v[2 * j + 1].x, v[2 * j + 1].y); w.w = pk2(v[2 * j + 1].z, v[2 * j + 1].w); o[64 * j] = w; } }
    if (xo) { GAS f32x4* o = (GAS f32x4*)xo + 2 * lane;
#pragma unroll
        for (int j = 0; j < 2; ++j) { o[128 * j] = v[2 * j]; o[128 * j + 1] = v[2 * j + 1]; } }
}
__device__ __forceinline__ void ln_load_gb(const float* gam, const float* bet, int lane, f32x4 (&gg)[4], f32x4 (&bb)[4]) {
#pragma unroll
    for (int j = 0; j < 2; ++j) { gg[2 * j] = *(const GAS f32x4*)(gam + 8 * lane + 512 * j); gg[2 * j + 1] = *(const GAS f32x4*)(gam + 8 * lane + 512 * j + 4);
        bb[2 * j] = *(const GAS f32x4*)(bet + 8 * lane + 512 * j); bb[2 * j + 1] = *(const GAS f32x4*)(bet + 8 * lane + 512 * j + 4); }
}
__device__ __forceinline__ void phase_ln(bf16* XB, const float* gam, const float* bet, float* XO, bool keep_bf, int gw, int NGW, int lane) {
    f32x4 gg[4], bb[4]; ln_load_gb(gam, bet, lane, gg, bb);
    for (int m = gw; m < MTOK; m += NGW) {
        f32x4 v[4]; ln_load_row(XB + (size_t)m * DM, lane, v);
        ln_normalize(v, gg, bb);
        ln_store_row(keep_bf ? XB + (size_t)m * DM : (bf16*)nullptr, XO ? XO + (size_t)m * DM : (float*)nullptr, lane, v);
    }
}

constexpr int DWR = 8;
__device__ __forceinline__ void phase_conf_dw(const bf16* U, const float* wdw, const float* bdw, const float* gam, const float* bet, bf16* V, LAS unsigned char* lds, int tid, int wave, int lane) {
    LAS float* redA = (LAS float*)lds; LAS float* redB = redA + 128;
    LAS f32x2* wl = (LAS f32x2*)(lds + 1024);
    unsigned tl_ = (unsigned)tid; asm volatile("" : "+v"(tl_)); const unsigned loff = tl_ * 4u;
#pragma unroll 1
    for (int k = 0; k < CONV_K; ++k) wl[k * 512 + tid] = *(const GAS f32x2*)(wdw + k * DM + 2 * tid);
    const f32x2 bd = *(const GAS f32x2*)(bdw + 2 * tid), gg = *(const GAS f32x2*)(gam + 2 * tid), bb = *(const GAS f32x2*)(bet + 2 * tid);
    for (int chunk = blockIdx.x; chunk < MTOK / 64; chunk += gridDim.x) {
        const int r0 = chunk * 64, t0 = r0 % SEQ;
        f32x2 a[30 + DWR];
#pragma unroll
        for (int j = 0; j < 30; ++j) { unsigned u = 0u; if (t0 - 30 + j >= 0) u = *(const GAS unsigned*)((const GAS char*)U + (size_t)(r0 - 30 + j) * (DM * 2) + loff); a[j] = (f32x2){bf_lo(u), bf_hi(u)}; }
        unsigned nx[DWR];
#pragma unroll
        for (int i = 0; i < DWR; ++i) nx[i] = *(const GAS unsigned*)((const GAS char*)U + (size_t)(r0 + i) * (DM * 2) + loff);
#pragma unroll 1
        for (int blk = 0; blk < 64 / DWR; ++blk) {
            const int rb = r0 + blk * DWR;
#pragma unroll
            for (int i = 0; i < DWR; ++i) a[30 + i] = (f32x2){bf_lo(nx[i]), bf_hi(nx[i])};
            if (blk + 1 < 64 / DWR) {
#pragma unroll
                for (int i = 0; i < DWR; ++i) nx[i] = *(const GAS unsigned*)((const GAS char*)U + (size_t)(rb + DWR + i) * (DM * 2) + loff); }
            f32x2 o[DWR]; float s[DWR];
#pragma unroll
            for (int i = 0; i < DWR; ++i) o[i] = bd;
#pragma unroll
            for (int k = 0; k < CONV_K; ++k) { const f32x2 w = wl[k * 512 + tid];
#pragma unroll
                for (int i = 0; i < DWR; ++i) o[i] += w * a[i + k]; }
            float s2[DWR];
#pragma unroll
            for (int i = 0; i < DWR; ++i) { s[i] = wave_sum(o[i].x + o[i].y); s2[i] = wave_sum(o[i].x * o[i].x + o[i].y * o[i].y); }
            LAS float* red = (blk & 1) ? redB : redA;
            if (lane == 0) {
#pragma unroll
                for (int i = 0; i < DWR; ++i) { red[wave * 2 * DWR + 2 * i] = s[i]; red[wave * 2 * DWR + 2 * i + 1] = s2[i]; } }
            __syncthreads();
#pragma unroll
            for (int i = 0; i < DWR; ++i) { float t = 0.f, t2 = 0.f;
#pragma unroll
                for (int w = 0; w < 8; ++w) { t += red[w * 2 * DWR + 2 * i]; t2 += red[w * 2 * DWR + 2 * i + 1]; }
                const float mean = t * (1.f / DM); const float var = fmaxf(t2 * (1.f / DM) - mean * mean, 0.f);
                const float rstd = 1.f / sqrtf(var + LN_EPS);
                const f32x2 y = (o[i] - mean) * rstd * gg + bb;
                *(GAS unsigned*)((GAS char*)V + (size_t)(rb + i) * (DM * 2) + loff) = pk2(fast_silu(y.x), fast_silu(y.y)); }
#pragma unroll
            for (int j = 0; j < 30; ++j) a[j] = a[j + DWR];
        }
    }
}

__device__ __forceinline__ void phase_shortconv(const bf16* CH, const bf16* BG, const float* wc, bf16* Y, int tid) {
    unsigned tl_ = (unsigned)tid; asm volatile("" : "+v"(tl_)); const unsigned loff = tl_ * 4u;
    const f32x2 w0 = *(const GAS f32x2*)(wc + 0 * DM + 2 * tid), w1 = *(const GAS f32x2*)(wc + 1 * DM + 2 * tid), w2 = *(const GAS f32x2*)(wc + 2 * DM + 2 * tid);
    for (int chunk = blockIdx.x; chunk < MTOK / 64; chunk += gridDim.x) {
        const int r0 = chunk * 64, t0 = r0 % SEQ;
        f32x2 p2 = (f32x2){0.f, 0.f}, p1 = p2;
        if (t0 > 0) { const unsigned ua = *(const GAS unsigned*)((const GAS char*)CH + (size_t)(r0 - 2) * (DM * 2) + loff), ub = *(const GAS unsigned*)((const GAS char*)CH + (size_t)(r0 - 1) * (DM * 2) + loff);
            p2 = (f32x2){bf_lo(ua), bf_hi(ua)}; p1 = (f32x2){bf_lo(ub), bf_hi(ub)}; }
#pragma unroll 8
        for (int i = 0; i < 64; ++i) {
            const unsigned uc = *(const GAS unsigned*)((const GAS char*)CH + (size_t)(r0 + i) * (DM * 2) + loff), ug = *(const GAS unsigned*)((const GAS char*)BG + (size_t)(r0 + i) * (DM * 2) + loff);
            const f32x2 c = (f32x2){bf_lo(uc), bf_hi(uc)}, g = (f32x2){bf_lo(ug), bf_hi(ug)};
            const f32x2 y = g * (w0 * p2 + w1 * p1 + w2 * c);
            *(GAS unsigned*)((GAS char*)Y + (size_t)(r0 + i) * (DM * 2) + loff) = pk2(y.x, y.y);
            p2 = p1; p1 = c; }
    }
}

__device__ __forceinline__ void phase_ln_router(bf16* XB, const float* gam, const float* bet, float* XO, const float* wr, unsigned* cnt, int* list, int* tsel, float* twt,
                                                LAS unsigned char* lds, int gw, int NGW, int tid, int lane) {
    LAS f32x4* wl = (LAS f32x4*)lds;
    for (int i = tid; i < DM * NEXP / 4; i += NTHR) wl[i] = *(const GAS f32x4*)(wr + 4 * i);
    __syncthreads();
    f32x4 gg[4], bb[4]; ln_load_gb(gam, bet, lane, gg, bb);
    for (int m = gw; m < MTOK; m += NGW) {
        f32x4 v[4]; ln_load_row(XB + (size_t)m * DM, lane, v);
        ln_normalize(v, gg, bb);
        ln_store_row(XB + (size_t)m * DM, XO ? XO + (size_t)m * DM : (float*)nullptr, lane, v);
        f32x4 la = (f32x4){0.f, 0.f, 0.f, 0.f}, lb = la;
#pragma unroll
        for (int j = 0; j < 4; ++j)
#pragma unroll
            for (int i = 0; i < 4; ++i) { const int c = 8 * lane + 512 * (j >> 1) + 4 * (j & 1) + i; const f32x4 wa = wl[2 * c], wb = wl[2 * c + 1]; la += wa * v[j][i]; lb += wb * v[j][i]; }
        float lg[NEXP];
#pragma unroll
        for (int e = 0; e < 4; ++e) { lg[e] = wave_sum(la[e]); lg[4 + e] = wave_sum(lb[e]); }
        if (lane == 0) {
            int e1 = 0; float v1 = lg[0];
#pragma unroll
            for (int e = 1; e < NEXP; ++e) if (lg[e] > v1) { v1 = lg[e]; e1 = e; }
            int e2 = -1; float v2 = -3.4e38f;
#pragma unroll
            for (int e = 0; e < NEXP; ++e) if (e != e1 && lg[e] > v2) { v2 = lg[e]; e2 = e; }
            const float p2 = expf(v2 - v1), w1 = 1.0f / (1.0f + p2), w2 = p2 / (1.0f + p2);
            const int s1 = (int)__hip_atomic_fetch_add(cnt + e1, 1u, RLX_AGENT), sl2 = (int)__hip_atomic_fetch_add(cnt + e2, 1u, RLX_AGENT);
            list[e1 * MTOK + s1] = m; list[e2 * MTOK + sl2] = m;
            *(int4*)(tsel + 4 * m) = make_int4(e1, s1, e2, sl2); *(float2*)(twt + 2 * m) = make_float2(w1, w2);
        }
    }
}
__device__ __forceinline__ void moe_panels(const unsigned* cnt, int (&pb)[9]) {
    int acc = 0;
#pragma unroll
    for (int e = 0; e < NEXP; ++e) { pb[e] = acc; const int c = (int)__builtin_amdgcn_readfirstlane((int)cnt[e]); acc += (c + 255) >> 8; }
    pb[NEXP] = acc;
}
template <class Sched> __device__ __forceinline__ void moe_fill_gidx(const Sched& S, const unsigned* cnt, const int* list, LAS int* gidx, int tid) {
    asm volatile("" : "+v"(tid));
    pg8::Unit u;
    for (int i = 0; i < GIDX_UNITS && S.next(i, u); ++i) {
        int pbe = 0;
#pragma unroll
        for (int k = 0; k < NEXP; ++k) pbe = (u.eb == k) ? S.pb[k] : pbe;
        if (tid < 256) { const int e = u.eb, c = (int)cnt[e]; int slot = (u.pm - pbe) * 256 + tid; slot = slot < c ? slot : c - 1; gidx[i * 256 + tid] = list[e * MTOK + slot]; }
    }
    __syncthreads();
}
__device__ __forceinline__ void phase_ln_moe(bf16* XB, const bf16* YM, const unsigned* cnt, const int* tsel, const float* twt, const float* gam, const float* bet, float* XO, bool keep_bf, int gw, int NGW, int lane) {
    int pb[9]; moe_panels(cnt, pb);
    f32x4 gg[4], bb[4]; ln_load_gb(gam, bet, lane, gg, bb);
    for (int m = gw; m < MTOK; m += NGW) {
        const int4 ts = *(const int4*)(tsel + 4 * m); const float2 tw = *(const float2*)(twt + 2 * m);
        int b1 = 0, b2 = 0;
#pragma unroll
        for (int e = 0; e < NEXP; ++e) { b1 = (ts.x == e) ? pb[e] : b1; b2 = (ts.z == e) ? pb[e] : b2; }
        f32x4 v[4], a[4], b[4], a2[4], b2v[4];
        ln_load_row(XB + (size_t)m * DM, lane, v);
        const bf16* y1 = YM + (size_t)(b1 * 256 + ts.y) * DM; const bf16* y2 = YM + (size_t)(b2 * 256 + ts.w) * DM;
        ln_load_row(y1, lane, a); ln_load_row(y2, lane, b); ln_load_row(y1 + MOE_SLAB, lane, a2); ln_load_row(y2 + MOE_SLAB, lane, b2v);
#pragma unroll
        for (int j = 0; j < 4; ++j) v[j] = v[j] * ALPHA_F + (a[j] + a2[j]) * tw.x + (b[j] + b2v[j]) * tw.y;
        ln_normalize(v, gg, bb);
        ln_store_row(keep_bf ? XB + (size_t)m * DM : (bf16*)nullptr, XO ? XO + (size_t)m * DM : (float*)nullptr, lane, v);
    }
}

typedef float f32x16_t __attribute__((ext_vector_type(16)));
__device__ __forceinline__ float gelu_tanh_fast(float x) { const float u = 0.7978845608028654f * (x + 0.044715f * x * x * x); const float e = __builtin_amdgcn_exp2f(2.0f * 1.4426950408889634f * u); return x * (1.0f - __builtin_amdgcn_rcpf(1.0f + e)); }
__device__ __forceinline__ int crow(int r, int hi) { return (r & 3) + 8 * (r >> 2) + 4 * hi; }
__device__ __forceinline__ void phase_compress(const bf16* KC, const bf16* VC, const bf16* W1T, const float* pek, const float* pev, const float* wk2, const float* wv2, bf16* KCMP, bf16* VCMPT,
                                               LAS unsigned char* lds, int tid, int wave, int lane) {
    LAS float* P = (LAS float*)lds;
    const int r32 = lane & 31, hi = lane >> 5;
    for (int unit = blockIdx.x; unit < 2 * BATCH * NKV * 4; unit += gridDim.x) {
        const int kv = unit >> 7, bh = (unit >> 2) & 31, rg = unit & 3;
        const bf16* src = (kv ? VC : KC) + ((size_t)bh * SEQ + 16 * (32 * rg + r32)) * HD;
        const float* pe = kv ? pev : pek;
        const bf16* wb = W1T + (size_t)(kv * PHI + r32) * (CMP_BLOCK * HD);
        f32x16_t acc[4];
#pragma unroll
        for (int nb = 0; nb < 4; ++nb)
#pragma unroll
            for (int q = 0; q < 16; ++q) acc[nb][q] = 0.f;
#pragma unroll 2
        for (int s = 0; s < 16; ++s) {
            const int k0 = (wave * 16 + s) * 16 + 8 * hi;
            const v4u araw = *(const GAS v4u*)(src + k0);
            const f32x4 p0 = *(const GAS f32x4*)(pe + k0), p1 = *(const GAS f32x4*)(pe + k0 + 4);
            v4u af; af.x = pk2(bf_lo(araw.x) + p0.x, bf_hi(araw.x) + p0.y); af.y = pk2(bf_lo(araw.y) + p0.z, bf_hi(araw.y) + p0.w);
            af.z = pk2(bf_lo(araw.z) + p1.x, bf_hi(araw.z) + p1.y); af.w = pk2(bf_lo(araw.w) + p1.z, bf_hi(araw.w) + p1.w);
            const bf16x8 a8 = __builtin_bit_cast(bf16x8, af);
#pragma unroll
            for (int nb = 0; nb < 4; ++nb) { const bf16x8 b8 = __builtin_bit_cast(bf16x8, *(const GAS v4u*)(wb + (size_t)nb * 32 * (CMP_BLOCK * HD) + k0));
                acc[nb] = __builtin_amdgcn_mfma_f32_32x32x16_bf16(a8, b8, acc[nb], 0, 0, 0); }
        }
        __syncthreads();
#pragma unroll
        for (int nb = 0; nb < 4; ++nb)
#pragma unroll
            for (int q = 0; q < 16; ++q) P[(wave * 32 + crow(q, hi)) * 128 + nb * 32 + r32] = acc[nb][q];
        __syncthreads();
#pragma unroll
        for (int i = 0; i < 8; ++i) { const int e = tid + NTHR * i; float t = 0.f;
#pragma unroll
            for (int w = 0; w < 8; ++w) t += P[w * 4096 + e];
            P[e] = gelu_tanh_fast(t); }
        __syncthreads();
        { const int r = tid >> 4, dg = (tid & 15) * 4; const float* w2 = (kv ? wv2 : wk2) + dg; f32x4 o = (f32x4){0.f, 0.f, 0.f, 0.f};
#pragma unroll 8
          for (int jj = 0; jj < PHI; ++jj) o += *(const GAS f32x4*)(w2 + jj * HD) * P[r * 128 + jj];
          const int c = 32 * rg + r;
          if (c == NCMP) o = (f32x4){0.f, 0.f, 0.f, 0.f};
          if (kv == 0) { v2u w; w.x = pk2(o.x, o.y); w.y = pk2(o.z, o.w); *(GAS v2u*)(KCMP + ((size_t)bh * 128 + c) * HD + dg) = w; }
          else {
#pragma unroll
              for (int j = 0; j < 4; ++j) VCMPT[((size_t)bh * HD + dg + j) * 128 + c] = (bf16)f2bf(o[j]); } }
    }
    __syncthreads();
}

#ifndef ATT_LEVEL
#define ATT_LEVEL 4
#endif
constexpr int AT_KP = 144, AT_VP = 136;
#define AT_THR 8.0f
constexpr int AT_K = 0, AT_V = 2 * 64 * AT_KP, AT_IMP = AT_V + 2 * 64 * AT_VP, AT_SC = AT_IMP + 4 * 2 * 64 * 33 * 4, AT_SEL = AT_SC + 64 * 33 * 4, AT_WSF = AT_SEL + 512, AT_END = AT_WSF + 8 * 64 * 4;
static_assert(AT_END <= RING_BYTES, "attention LDS map");
struct AttTensors { const bf16 *Q, *KC, *KS, *VST, *KW, *VWT, *KCMP, *VCMPT; const float* GATE; bf16* O; };
__device__ __forceinline__ float swap_max(float v) { auto rr = __builtin_amdgcn_permlane32_swap(__float_as_uint(v), __float_as_uint(v), false, false); return fmaxf(__uint_as_float(rr[0]), __uint_as_float(rr[1])); }
__device__ __forceinline__ float swap_add(float v) { auto rr = __builtin_amdgcn_permlane32_swap(__float_as_uint(v), __float_as_uint(v), false, false); return __uint_as_float(rr[0]) + __uint_as_float(rr[1]); }

__device__ __forceinline__ void phase_nsa_attn(const AttTensors T, LAS unsigned char* lds, int tid, int wave, int lane) {
    const int r32 = lane & 31, hi = lane >> 5, g = wave >> 1, th = wave & 1, tl = 32 * th + r32;
    LAS float* wsf = (LAS float*)(lds + AT_WSF) + wave * 64;
    LAS float* IMP = (LAS float*)(lds + AT_IMP); LAS float* SC = (LAS float*)(lds + AT_SC); LAS unsigned* SEL = (LAS unsigned*)(lds + AT_SEL);
    const int ldrow = tid >> 3, ldch = tid & 7;
    const float NEG = -INFINITY;
    const int vcu = (gridDim.x % 8 == 0) ? (int)((blockIdx.x % 8) * (gridDim.x / 8) + blockIdx.x / 8) : (int)blockIdx.x;
    for (int ui = 0; ; ++ui) {
        int bh, qi;
        if (gridDim.x == 256) { if (ui >= 4) break; const int s = vcu & 7; bh = vcu >> 3; qi = (ui == 0) ? s : (ui == 1) ? 31 - s : (ui == 2) ? 8 + s : 23 - s; }
        else { const int u = blockIdx.x + ui * gridDim.x; if (u >= BATCH * NKV * NSLC) break; bh = u >> 5; qi = u & 31; }
        const int b = bh >> 2, hk = bh & 3, t = qi * 64 + tl;
        const size_t mrow = (size_t)b * SEQ + t;
        bf16x8 qf[4];
        { const bf16* qp = T.Q + (((size_t)(b * NH + hk * NG + g) * SEQ + t) * HD + 8 * hi);
#pragma unroll
          for (int s = 0; s < 4; ++s) qf[s] = __builtin_bit_cast(bf16x8, *(const GAS v4u*)(qp + 16 * s)); }
        const float* gp = T.GATE + mrow * 48 + hk * 12 + g * 3;
        const float g0 = gp[0], g1 = gp[1], g2 = gp[2];
        if (tid < 65) SEL[tid] = 0u;
        f32x16_t ot0, ot1;
#define AT_LOADK(dst, kptr) dst = *(const GAS v4u*)((kptr) + (size_t)ldrow * HD + ldch * 8)
#define AT_LOADV(dst, vptr, vstride) dst = *(const GAS v4u*)((vptr) + (size_t)ldrow * (vstride) + ldch * 8)
#define AT_STORE(buf, kreg, vreg) do { *(LAS v4u*)(lds + AT_K + (buf) * 64 * AT_KP + ldrow * AT_KP + ldch * 16) = kreg; \
        LAS v2u* vd_ = (LAS v2u*)(lds + AT_V + (buf) * 64 * AT_VP + ldrow * AT_VP + ldch * 16); vd_[0] = (v2u){vreg.x, vreg.y}; vd_[1] = (v2u){vreg.z, vreg.w}; } while (0)
#define AT_QK(buf, s0, s1) do { const LAS unsigned char* kb_ = lds + AT_K + (buf) * 64 * AT_KP + r32 * AT_KP + 16 * hi; \
        _Pragma("unroll") for (int r_ = 0; r_ < 16; ++r_) { s0[r_] = 0.f; s1[r_] = 0.f; } \
        _Pragma("unroll") for (int s_ = 0; s_ < 4; ++s_) { const bf16x8 k0_ = *(const LAS bf16x8*)(kb_ + 32 * s_), k1_ = *(const LAS bf16x8*)(kb_ + 32 * AT_KP + 32 * s_); \
            s0 = __builtin_amdgcn_mfma_f32_32x32x16_bf16(k0_, qf[s_], s0, 0, 0, 0); s1 = __builtin_amdgcn_mfma_f32_32x32x16_bf16(k1_, qf[s_], s1, 0, 0, 0); } } while (0)
#define AT_PV(buf, p0, p1, o0, o1) do { \
        v4u pa_[4]; \
        pa_[0] = (v4u){cvt_pk_bf16(p0[0], p0[1]), cvt_pk_bf16(p0[2], p0[3]), cvt_pk_bf16(p0[4], p0[5]), cvt_pk_bf16(p0[6], p0[7])}; \
        pa_[1] = (v4u){cvt_pk_bf16(p0[8], p0[9]), cvt_pk_bf16(p0[10], p0[11]), cvt_pk_bf16(p0[12], p0[13]), cvt_pk_bf16(p0[14], p0[15])}; \
        pa_[2] = (v4u){cvt_pk_bf16(p1[0], p1[1]), cvt_pk_bf16(p1[2], p1[3]), cvt_pk_bf16(p1[4], p1[5]), cvt_pk_bf16(p1[6], p1[7])}; \
        pa_[3] = (v4u){cvt_pk_bf16(p1[8], p1[9]), cvt_pk_bf16(p1[10], p1[11]), cvt_pk_bf16(p1[12], p1[13]), cvt_pk_bf16(p1[14], p1[15])}; \
        const LAS unsigned char* vb_ = lds + AT_V + (buf) * 64 * AT_VP + r32 * AT_VP + 8 * hi; \
        _Pragma("unroll") for (int ks_ = 0; ks_ < 4; ++ks_) { \
            const v2u a0_ = *(const LAS v2u*)(vb_ + 32 * ks_), a1_ = *(const LAS v2u*)(vb_ + 32 * ks_ + 16); \
            const v2u b0_ = *(const LAS v2u*)(vb_ + 32 * AT_VP + 32 * ks_), b1_ = *(const LAS v2u*)(vb_ + 32 * AT_VP + 32 * ks_ + 16); \
            const bf16x8 pf_ = __builtin_bit_cast(bf16x8, pa_[ks_]); \
            o0 = __builtin_amdgcn_mfma_f32_32x32x16_bf16(pf_, __builtin_bit_cast(bf16x8, ((v4u){a0_.x, a0_.y, a1_.x, a1_.y})), o0, 0, 0, 0); \
            o1 = __builtin_amdgcn_mfma_f32_32x32x16_bf16(pf_, __builtin_bit_cast(bf16x8, ((v4u){b0_.x, b0_.y, b1_.x, b1_.y})), o1, 0, 0, 0); } } while (0)
#define AT_ROWSCALE_LOAD(f) do { if (hi == 0) wsf[r32] = (f); asm volatile("s_waitcnt lgkmcnt(0)" ::: "memory"); } while (0)
#define AT_ROWF(r_) wsf[crow(r_, hi)]

        { v4u k0, v0, k1, v1;
          const bf16* kc = T.KCMP + (size_t)bh * 128 * HD; const bf16* vc = T.VCMPT + (size_t)bh * HD * 128;
          AT_LOADK(k0, kc); AT_LOADV(v0, vc, 128); AT_LOADK(k1, kc + 64 * HD); AT_LOADV(v1, vc + 64, 128);
          __syncthreads();
          AT_STORE(0, k0, v0); AT_STORE(1, k1, v1);
          __syncthreads(); }
        {
          f32x16_t s0, s1, s2, s3;
          AT_QK(0, s0, s1); AT_QK(1, s2, s3);
          float mx = NEG;
#pragma unroll
          for (int r = 0; r < 16; ++r) { const int c = crow(r, hi);
              s0[r] = (16 * c + 31 <= t) ? s0[r] : NEG; s1[r] = (16 * (c + 32) + 31 <= t) ? s1[r] : NEG; s2[r] = (16 * (c + 64) + 31 <= t) ? s2[r] : NEG; s3[r] = (16 * (c + 96) + 31 <= t) ? s3[r] : NEG;
              mx = fmaxf(fmaxf(mx, s0[r]), fmaxf(fmaxf(s1[r], s2[r]), s3[r])); }
          mx = fmaxf(swap_max(mx), -1e30f);
          float l = 0.f;
#pragma unroll
          for (int r = 0; r < 16; ++r) { s0[r] = __builtin_amdgcn_exp2f(s0[r] - mx); s1[r] = __builtin_amdgcn_exp2f(s1[r] - mx); s2[r] = __builtin_amdgcn_exp2f(s2[r] - mx); s3[r] = __builtin_amdgcn_exp2f(s3[r] - mx);
              l += (s0[r] + s1[r]) + (s2[r] + s3[r]); }
          l = swap_add(l);
          const float inv = 1.0f / fmaxf(l, 1e-30f);
#pragma unroll
          for (int r = 0; r < 16; ++r) { s0[r] *= inv; s1[r] *= inv; s2[r] *= inv; s3[r] *= inv; }
          { LAS float* I0 = IMP + ((g * 2 + 0) * 64 + tl) * 33; LAS float* I1 = IMP + ((g * 2 + 1) * 64 + tl) * 33;
#pragma unroll
            for (int a = 0; a < 4; ++a) { const int n = 2 * a + hi;
                I0[n] = (s0[4 * a] + s0[4 * a + 1]) + (s0[4 * a + 2] + s0[4 * a + 3]); I1[n + 1] = s0[4 * a + 3];
                I0[n + 8] = (s1[4 * a] + s1[4 * a + 1]) + (s1[4 * a + 2] + s1[4 * a + 3]); I1[n + 9] = s1[4 * a + 3];
                I0[n + 16] = (s2[4 * a] + s2[4 * a + 1]) + (s2[4 * a + 2] + s2[4 * a + 3]); I1[n + 17] = s2[4 * a + 3];
                I0[n + 24] = (s3[4 * a] + s3[4 * a + 1]) + (s3[4 * a + 2] + s3[4 * a + 3]); if (n + 25 < 33) I1[n + 25] = s3[4 * a + 3]; } }
          f32x16_t o0, o1;
#pragma unroll
          for (int r = 0; r < 16; ++r) { o0[r] = 0.f; o1[r] = 0.f; }
          AT_PV(0, s0, s1, o0, o1); AT_PV(1, s2, s3, o0, o1);
          AT_ROWSCALE_LOAD(g0);
#pragma unroll
          for (int r = 0; r < 16; ++r) { const float f = AT_ROWF(r); ot0[r] = o0[r] * f; ot1[r] = o1[r] * f; }
        }
        __syncthreads();
        { const int st = tid >> 3, grp = tid & 7;
#pragma unroll
          for (int i = 0; i < 4; ++i) { const int n = 4 * grp + i; float imp = 0.f;
#pragma unroll
              for (int gg = 0; gg < 4; ++gg) { imp += IMP[((gg * 2 + 0) * 64 + st) * 33 + n]; if (n > 0) imp += IMP[((gg * 2 + 1) * 64 + st) * 33 + n]; }
              const bool forced = (n == 0) || (n == qi) || (n == qi - 1);
              SC[st * 33 + n] = forced ? 1e4f : ((n <= qi) ? imp : -1e30f); }
          __syncthreads();
          unsigned bits = 0u;
#pragma unroll
          for (int i = 0; i < 4; ++i) { const int n = 4 * grp + i; const float sn = SC[st * 33 + n]; int rank = 0;
#pragma unroll 8
              for (int m2 = 0; m2 < NSLC; ++m2) { const float sm = SC[st * 33 + m2]; rank += (sm > sn || (sm == sn && m2 < n)) ? 1 : 0; }
              if (rank < TOPN && n <= qi) bits |= 1u << n; }
          if (bits) { __hip_atomic_fetch_or(SEL + st, bits, __ATOMIC_RELAXED, __HIP_MEMORY_SCOPE_WORKGROUP); __hip_atomic_fetch_or(SEL + 64, bits, __ATOMIC_RELAXED, __HIP_MEMORY_SCOPE_WORKGROUP); }
          __syncthreads(); }
        const unsigned selmask = SEL[tl]; const unsigned selunion = SEL[64];
#pragma unroll 1
        for (int mode = 0; mode < (ATT_LEVEL >= 4 ? 2 : (ATT_LEVEL == 3 ? 1 : 0)); ++mode) {
            const bf16* Kb = (mode == 0 ? T.KS : T.KW) + (size_t)bh * SEQ * HD; const bf16* Vb = (mode == 0 ? T.VST : T.VWT) + (size_t)bh * HD * SEQ;
            const int jlo = qi >= 8 ? qi - 8 : 0;
            unsigned todo = (mode == 0) ? selunion : (((2u << qi) - 1u) & ~((1u << jlo) - 1u));
            float mref = 0.f, l = 0.f; bool seen = false; f32x16_t o0, o1;
#pragma unroll
            for (int r = 0; r < 16; ++r) { o0[r] = 0.f; o1[r] = 0.f; }
            int cur = 0;
            v4u kA, vA, kB, vB;
            { const int j = __builtin_ctz(todo); v4u kr, vr; AT_LOADK(kr, Kb + (size_t)j * 64 * HD); AT_LOADV(vr, Vb + j * 64, SEQ);
              unsigned t1 = todo & (todo - 1u);
              if (t1) { const int jn = __builtin_ctz(t1); AT_LOADK(kA, Kb + (size_t)jn * 64 * HD); AT_LOADV(vA, Vb + jn * 64, SEQ); }
              AT_STORE(0, kr, vr); }
            __syncthreads();
#pragma unroll 1
            while (todo) {
                const int j = __builtin_ctz(todo); todo &= todo - 1u;
                const unsigned t2 = todo & (todo - 1u);
                if (t2) { const int jn = __builtin_ctz(t2); AT_LOADK(kB, Kb + (size_t)jn * 64 * HD); AT_LOADV(vB, Vb + jn * 64, SEQ); }
                const bool mine = (mode == 0) ? ((selmask >> j) & 1u) != 0u : true;
                if (__any(mine)) {
                    f32x16_t s0, s1;
                    { const float ci = mine ? -mref : NEG;
                      const LAS unsigned char* kb_ = lds + AT_K + cur * 64 * AT_KP + r32 * AT_KP + 16 * hi;
#pragma unroll
                      for (int r = 0; r < 16; ++r) { s0[r] = ci; s1[r] = ci; }
#pragma unroll
                      for (int s_ = 0; s_ < 4; ++s_) { const bf16x8 k0_ = *(const LAS bf16x8*)(kb_ + 32 * s_), k1_ = *(const LAS bf16x8*)(kb_ + 32 * AT_KP + 32 * s_);
                          s0 = __builtin_amdgcn_mfma_f32_32x32x16_bf16(k0_, qf[s_], s0, 0, 0, 0); s1 = __builtin_amdgcn_mfma_f32_32x32x16_bf16(k1_, qf[s_], s1, 0, 0, 0); } }
                    if (j == qi) {
#pragma unroll
                        for (int r = 0; r < 16; ++r) { const int k0 = crow(r, hi); s0[r] = (k0 <= tl) ? s0[r] : NEG; s1[r] = (k0 + 32 <= tl) ? s1[r] : NEG; } }
                    if (mode == 1 && j == qi - 8) {
#pragma unroll
                        for (int r = 0; r < 16; ++r) { const int k0 = crow(r, hi); s0[r] = (k0 > tl) ? s0[r] : NEG; s1[r] = (k0 + 32 > tl) ? s1[r] : NEG; } }
                    float mx = NEG;
#pragma unroll
                    for (int r = 0; r < 16; ++r) mx = fmaxf(mx, fmaxf(s0[r], s1[r]));
                    mx = swap_max(mx);
                    const float delta = seen ? (mx > AT_THR ? mx : 0.f) : (mx > -1e37f ? mx : 0.f);
                    if (__any(delta != 0.f)) {
                        const float f = seen ? __builtin_amdgcn_exp2f(-delta) : 1.0f; l *= f; mref += delta; seen = seen || (mx > -1e37f);
                        AT_ROWSCALE_LOAD(f);
#pragma unroll
                        for (int r = 0; r < 16; ++r) { const float fr_ = AT_ROWF(r); o0[r] *= fr_; o1[r] *= fr_; s0[r] -= delta; s1[r] -= delta; } }
                    float ls = 0.f;
#pragma unroll
                    for (int r = 0; r < 16; ++r) { s0[r] = __builtin_amdgcn_exp2f(s0[r]); s1[r] = __builtin_amdgcn_exp2f(s1[r]); ls += s0[r] + s1[r]; }
                    l += ls;
                    AT_PV(cur, s0, s1, o0, o1);
                }
                if (todo) AT_STORE(cur ^ 1, kA, vA);
                __syncthreads();
                cur ^= 1; kA = kB; vA = vB;
            }
            l = swap_add(l);
            AT_ROWSCALE_LOAD((mode == 0 ? g1 : g2) / fmaxf(l, 1e-30f));
#pragma unroll
            for (int r = 0; r < 16; ++r) { const float f = AT_ROWF(r); ot0[r] += o0[r] * f; ot1[r] += o1[r] * f; }
        }
        { bf16* ob = T.O + ((size_t)b * SEQ + qi * 64 + 32 * th) * DM + (hk * NG + g) * HD + r32;
#pragma unroll
          for (int r = 0; r < 16; ++r) { bf16* p = ob + (size_t)crow(r, hi) * DM; if (ATT_LEVEL < 2) { ot0[r] = 0.f; ot1[r] = 0.f; } p[0] = (bf16)f2bf(ot0[r]); p[32] = (bf16)f2bf(ot1[r]); } }
#undef AT_LOADK
#undef AT_LOADV
#undef AT_STORE
#undef AT_QK
#undef AT_PV
#undef AT_ROWSCALE_LOAD
#undef AT_ROWF
    }
    __syncthreads();
}

enum { PH_PRO = 0,
       PH0_WIN, PH0_DW, PH0_WOUT, PH0_LN1, PH0_GU, PH0_DOWN, PH0_LN2,
       PH1_WIN, PH1_CONV, PH1_WOUT, PH1_LN1, PH1_MGU, PH1_MDOWN, PH1_LN2,
       PH2_WIN, PH2_CMP, PH2_ATT, PH2_WOUT, PH2_LN1, PH2_GU, PH2_DOWN, PH2_LN2,
       PH3_WIN, PH3_DW, PH3_WOUT, PH3_LN1, PH3_MGU, PH3_MDOWN, PH3_LN2, PH_END };

#ifndef FAST_PREFIX
#define FAST_PREFIX 2
#endif
#ifndef MGU_ALIGN
#define MGU_ALIGN true
#endif
#ifndef MGU_SP2
#define MGU_SP2 true
#endif
#ifndef ONE_LAUNCH
#define ONE_LAUNCH 0
#endif
constexpr int kSubEnd[8] = {PH0_LN1, PH0_LN2, PH1_LN1, PH1_LN2, PH2_LN1, PH2_LN2, PH3_LN1, PH3_LN2};
constexpr int FAST_END = FAST_PREFIX == 0 ? 0 : kSubEnd[FAST_PREFIX - 1] + 1;

struct Ctx { LAS unsigned char* lds; int tid, lane, wave, G, bx, gw, NGW, lo, hi; XcdBarrier bar; };
#define IN(k) (c.lo <= (k) && (k) < c.hi)
#define SEAM(k) do { if (IN(k) && IN((k) + 1)) xcd_barrier(c.bar); } while (0)
#define WSP(T, off) ((T*)(a.ws + (off)))

template <int L, int PH, bool FFN_SIDE> __device__ __forceinline__ void ln_plain(const FArgs& a, const Ctx& c) {
    if (IN(PH)) { const float* g = a.in[FFN_SIDE ? I_LFG : I_LMG] + L * DM; const float* b = a.in[FFN_SIDE ? I_LFB : I_LMB] + L * DM;
        constexpr bool LAST = FFN_SIDE && L == DEPTH - 1; constexpr bool HANDOFF = (PH + 1 == FAST_END) && !LAST;
        phase_ln(WSP(bf16, WS_XBF), g, b, LAST ? a.out : (HANDOFF ? WSP(float, WS_X) : (float*)nullptr), !LAST, c.gw, c.NGW, c.lane); }
    SEAM(PH);
}
template <int L, int PH> __device__ __forceinline__ void ln_router(const FArgs& a, const Ctx& c) {
    constexpr int f = L / 2; constexpr bool HANDOFF = (PH + 1 == FAST_END);
    if (IN(PH)) phase_ln_router(WSP(bf16, WS_XBF), a.in[I_LMG] + L * DM, a.in[I_LMB] + L * DM, HANDOFF ? WSP(float, WS_X) : (float*)nullptr, a.in[I_MWR] + (size_t)f * DM * NEXP,
                                (unsigned*)WSP(unsigned, WS_CTL) + CW_MOE + 64 * f, WSP(int, MS_LIST), WSP(int, MS_TSEL), WSP(float, MS_TWT), c.lds, c.gw, c.NGW, c.tid, c.lane);
    SEAM(PH);
}
template <int L, int PH> __device__ __forceinline__ void conformer_mixer(const FArgs& a, const Ctx& c) {
    constexpr int j = L / 3;
    bf16* U = WSP(bf16, A_U); bf16* V = WSP(bf16, A_V);
    if (IN(PH)) { pg8::Gemm g{WSP(bf16, WS_XBF), WSP(bf16, W_CONF_IN + (size_t)j * 4 * MiB), DM, DM, DM, 0}; pg8::StaticOrder S; S.init(MTOK / 256, 8, c.G, c.bx);
        pg8::EpiPair<0> E{U, DM}; pg8::gemm_phase<pg8::EpiPair<0>, pg8::StaticOrder, true, true>(c.lds, g, S, E); } SEAM(PH);
    if (IN(PH + 1)) phase_conf_dw(U, a.in[I_CWDW] + (size_t)j * CONV_K * DM, a.in[I_CBDW] + j * DM, a.in[I_CLNG] + j * DM, a.in[I_CLNB] + j * DM, V, c.lds, c.tid, c.wave, c.lane);
    SEAM(PH + 1);
    if (IN(PH + 2)) { pg8::Gemm g{V, WSP(bf16, W_CONF_OUT + (size_t)j * 2 * MiB), DM, DM, DM, 0}; pg8::StaticOrder S; S.init(MTOK / 256, 4, c.G, c.bx);
        pg8::EpiResid E{WSP(bf16, WS_XBF), DM}; pg8::gemm_phase<pg8::EpiResid, pg8::StaticOrder, true, true>(c.lds, g, S, E); } SEAM(PH + 2);
}
template <int L, int PH> __device__ __forceinline__ void sc_mixer(const FArgs& a, const Ctx& c) {
    constexpr int j = L / 3;
    bf16* CH = WSP(bf16, A_CH); bf16* BG = WSP(bf16, A_BG); bf16* YS = WSP(bf16, A_YSC);
    if (IN(PH)) { pg8::Gemm g{WSP(bf16, WS_XBF), WSP(bf16, W_SC_IN), DM, DM, DM, 0}; pg8::StaticOrder S; S.init(MTOK / 256, 12, c.G, c.bx);
        pg8::EpiSC E{CH, BG}; pg8::gemm_phase<pg8::EpiSC, pg8::StaticOrder, true, true>(c.lds, g, S, E); } SEAM(PH);
    if (IN(PH + 1)) phase_shortconv(CH, BG, a.in[I_SWCONV] + (size_t)j * SHORT_K * DM, YS, c.tid);
    SEAM(PH + 1);
    if (IN(PH + 2)) { pg8::Gemm g{YS, WSP(bf16, W_SC_OUT), DM, DM, DM, 0}; pg8::StaticOrder S; S.init(MTOK / 256, 4, c.G, c.bx);
        pg8::EpiResid E{WSP(bf16, WS_XBF), DM}; pg8::gemm_phase<pg8::EpiResid, pg8::StaticOrder, true, true>(c.lds, g, S, E); } SEAM(PH + 2);
}
template <int L, int PH> __device__ __forceinline__ void dense_ffn(const FArgs& a, const Ctx& c) {
    constexpr int f = L / 2;
    bf16* HB = WSP(bf16, WS_H);
    if (IN(PH)) { pg8::Gemm g{WSP(bf16, WS_XBF), WSP(bf16, W_FFN_GU + (size_t)f * 11 * MiB), DM, DM, DM, 0}; pg8::StaticOrder S; S.init(MTOK / 256, DFF / 128, c.G, c.bx);
        pg8::EpiPair<1> E{HB, DFF}; pg8::gemm_phase<pg8::EpiPair<1>, pg8::StaticOrder, true, true>(c.lds, g, S, E); } SEAM(PH);
    if (IN(PH + 1)) { pg8::Gemm g{HB, WSP(bf16, W_FFN_D + (size_t)f * DM * DFF * 2), DFF, DFF, DFF, 0}; pg8::StaticOrder S; S.init(MTOK / 256, 4, c.G, c.bx);
        pg8::EpiResid E{WSP(bf16, WS_XBF), DM}; pg8::gemm_phase<pg8::EpiResid, pg8::StaticOrder, true, true>(c.lds, g, S, E); } SEAM(PH + 1);
}
template <int L, int PH> __device__ __forceinline__ void moe_ffn(const FArgs& a, const Ctx& c) {
    constexpr int f = L / 2;
    const unsigned* cnt = (const unsigned*)WSP(unsigned, WS_CTL) + CW_MOE + 64 * f;
    bf16* AP = WSP(bf16, A_PERM); bf16* HB = WSP(bf16, WS_H);
    if (IN(PH)) { pg8::Gemm g{WSP(bf16, WS_XBF), WSP(bf16, W_MOE_GU + (size_t)f * 112 * MiB), DM, DM, DM, (size_t)14 * MiB}; pg8::GroupedOrderWide S; S.pin = 0; moe_panels(cnt, S.pb); S.init(S.pb[NEXP], DFFE / 128, c.G, c.bx);
        LAS int* gidx = (LAS int*)(c.lds + GIDX_OFF); moe_fill_gidx(S, cnt, WSP(int, MS_LIST), gidx, c.tid);
        pg8::EpiPair<1> E{HB, DFFE}; pg8::gemm_phase<pg8::EpiPair<1>, pg8::GroupedOrderWide, true, true, true>(c.lds, g, S, E, gidx); } SEAM(PH);
    if (IN(PH + 1)) { pg8::Gemm g{HB, WSP(bf16, W_MOE_D + (size_t)f * 56 * MiB), DFFE, DFFE, DFFE / 2, (size_t)7 * MiB}; pg8::GroupedOrder S; moe_panels(cnt, S.pb); S.init(S.pb[NEXP], 8, c.G, c.bx);
        pg8::EpiBf16 E{AP, DM, 1.0f, MOE_SLAB}; pg8::gemm_phase<pg8::EpiBf16, pg8::GroupedOrder, true, true>(c.lds, g, S, E); } SEAM(PH + 1);
    if (IN(PH + 2)) { constexpr bool LAST = L == DEPTH - 1; constexpr bool HANDOFF = (PH + 3 == FAST_END) && !LAST;
        phase_ln_moe(WSP(bf16, WS_XBF), AP, cnt, WSP(int, MS_TSEL), WSP(float, MS_TWT), a.in[I_LFG] + L * DM, a.in[I_LFB] + L * DM, LAST ? a.out : (HANDOFF ? WSP(float, WS_X) : (float*)nullptr), !LAST, c.gw, c.NGW, c.lane); }
    SEAM(PH + 2);
}
template <int L, int PH> __device__ __forceinline__ void nsa_mixer(const FArgs& a, const Ctx& c) {
    if (IN(PH)) { pg8::Gemm g{WSP(bf16, WS_XBF), WSP(bf16, W_NSA_IN), DM, DM, DM, 0}; pg8::StaticOrder S; S.init(MTOK / 256, 11, c.G, c.bx);
        pg8::EpiNSA E{WSP(bf16, A_Q), WSP(bf16, A_KC), WSP(float, A_GATE)}; pg8::gemm_phase<pg8::EpiNSA, pg8::StaticOrder, true, true>(c.lds, g, S, E); } SEAM(PH);
    if (IN(PH + 1)) phase_compress(WSP(bf16, A_KC), WSP(bf16, A_VCT), WSP(bf16, W_CMP1), a.in[I_NPEK], a.in[I_NPEV], a.in[I_NWK2], a.in[I_NWV2], WSP(bf16, A_KCMP), WSP(bf16, A_VCMPT), c.lds, c.tid, c.wave, c.lane);
    SEAM(PH + 1);
    if (IN(PH + 2)) { AttTensors T{WSP(bf16, A_Q), WSP(bf16, A_KC), WSP(bf16, A_KS), WSP(bf16, A_VST), WSP(bf16, A_KW), WSP(bf16, A_VWT), WSP(bf16, A_KCMP), WSP(bf16, A_VCMPT), WSP(float, A_GATE), WSP(bf16, A_O)};
        phase_nsa_attn(T, c.lds, c.tid, c.wave, c.lane); }
    SEAM(PH + 2);
    if (IN(PH + 3)) { pg8::Gemm g{WSP(bf16, A_O), WSP(bf16, W_NSA_OUT), DM, DM, DM, 0}; pg8::StaticOrder S; S.init(MTOK / 256, 4, c.G, c.bx);
        pg8::EpiResid E{WSP(bf16, WS_XBF), DM}; pg8::gemm_phase<pg8::EpiResid, pg8::StaticOrder, true, true>(c.lds, g, S, E); } SEAM(PH + 3);
}

__global__ void __launch_bounds__(NTHR, 2) mega(FArgs a) {
    extern __shared__ __attribute__((aligned(16))) unsigned char lds_raw[];
    Ctx c; c.lds = (LAS unsigned char*)lds_raw;
    c.tid = threadIdx.x; c.lane = c.tid & 63; c.wave = __builtin_amdgcn_readfirstlane(c.tid >> 6);
    c.G = gridDim.x; c.bx = blockIdx.x; const int vcu = (c.G % 8 == 0) ? (c.bx % 8) * (c.G / 8) + c.bx / 8 : c.bx;
    c.gw = vcu * NWAVES + c.wave; c.NGW = c.G * NWAVES; c.lo = a.ph_lo; c.hi = a.ph_hi;
    for (int u = c.tid; u < (LDS_BYTES - LDSCTL_OFF) / 4; u += NTHR) ((LAS unsigned*)(c.lds + LDSCTL_OFF))[u] = 0u;
    __syncthreads();
    c.bar = xcd_barrier_post((unsigned*)(a.ws + WS_CTL) + CW_BAR, (volatile LAS unsigned*)(c.lds + LDSCTL_OFF + 32));

    if (IN(PH_PRO)) phase_prologue(a, c.lds, c.gw, c.NGW, c.wave, c.lane);
    SEAM(PH_PRO);
    conformer_mixer<0, PH0_WIN>(a, c); ln_plain<0, PH0_LN1, false>(a, c); dense_ffn<0, PH0_GU>(a, c); ln_plain<0, PH0_LN2, true>(a, c);
#if FAST_PREFIX > 2
    sc_mixer<1, PH1_WIN>(a, c); ln_router<1, PH1_LN1>(a, c); moe_ffn<1, PH1_MGU>(a, c);
#endif
#if FAST_PREFIX > 4
    nsa_mixer<2, PH2_WIN>(a, c); ln_plain<2, PH2_LN1, false>(a, c); dense_ffn<2, PH2_GU>(a, c); ln_plain<2, PH2_LN2, true>(a, c);
#endif
#if FAST_PREFIX > 6
    conformer_mixer<3, PH3_WIN>(a, c); ln_router<3, PH3_LN1>(a, c); moe_ffn<3, PH3_MGU>(a, c);
#endif
}
#undef IN
#undef SEAM
#undef WSP


#ifndef DEBUG_MODE
#define DEBUG_MODE 0
#endif
__global__ void dbg_sqdiff(const float* a, const float* b, size_t n, float* acc2) {
    float d = 0.f, r = 0.f;
    for (size_t i = (size_t)blockIdx.x * blockDim.x + threadIdx.x; i < n; i += (size_t)gridDim.x * blockDim.x) { const float x = a[i], y = b[i]; const float t = x - y; d += (t == t) ? t * t : 1e6f; r += y * y; }
    d = wave_sum(d); r = wave_sum(r);
    if ((threadIdx.x & 63) == 0) { atomicAdd(acc2, d); atomicAdd(acc2 + 1, r); }
}
__global__ void dbg_scale(float* out, size_t n, const float* acc2) {
    float e = sqrtf(acc2[0] / fmaxf(acc2[1], 1e-30f)); e = e < 10.f ? e : 10.f;
    for (size_t i = (size_t)blockIdx.x * blockDim.x + threadIdx.x; i < n; i += (size_t)gridDim.x * blockDim.x) out[i] *= (1.0f + e);
}

static void gemm(hipStream_t st, const float* A, int lda, const int* gather, const int* mcount, int M, const float* W, int ldw, int N, int K, float* C, int ldc) {
    hipLaunchKernelGGL(ngemm, dim3((N + 127) / 128, (M + 127) / 128), dim3(256), 0, st, A, lda, gather, mcount, M, W, ldw, N, K, C, ldc);
}
struct NaiveBufs { float *BA, *BB, *BC, *BD; int *cnt, *list, *tsel; float *twt, *cmp; };
static void naive_sublayer(hipStream_t stream, const float* const* in, int s, const float* x, float* xo, const NaiveBufs& nb) {
    const int i = s / 2, kind = i % 3, j = i / 3, f = i / 2, EW = 256;
    constexpr int CR = MTOK / 2, CB = BATCH / 2;
    float *BA = nb.BA, *BB = nb.BB, *BC = nb.BC, *BD = nb.BD;
    for (int c = 0; c < 2; ++c) {
        const float* xc = x + (size_t)c * CR * DM; float* xoc = xo + (size_t)c * CR * DM;
        if ((s & 1) == 0) {
            if (kind == 0) {
                gemm(stream, xc, DM, nullptr, nullptr, CR, in[I_CWIN] + (size_t)j * DM * 2 * DM, 2 * DM, 2 * DM, DM, BA, 2 * DM);
                hipLaunchKernelGGL(n_glu, dim3(CR * DM / EW), dim3(EW), 0, stream, BA, BB, CR);
                hipLaunchKernelGGL(n_conf_dw, dim3(CR), dim3(256), 0, stream, BB, in[I_CWDW] + (size_t)j * CONV_K * DM, in[I_CBDW] + j * DM, in[I_CLNG] + j * DM, in[I_CLNB] + j * DM, BD);
                gemm(stream, BD, DM, nullptr, nullptr, CR, in[I_CWOUT] + (size_t)j * DM * DM, DM, DM, DM, BC, DM);
            } else if (kind == 1) {
                gemm(stream, xc, DM, nullptr, nullptr, CR, in[I_SWIN] + (size_t)j * DM * 3 * DM, 3 * DM, 3 * DM, DM, BA, 3 * DM);
                hipLaunchKernelGGL(n_shortconv, dim3(CR * DM / EW), dim3(EW), 0, stream, BA, in[I_SWCONV] + (size_t)j * SHORT_K * DM, BD, CR);
                gemm(stream, BD, DM, nullptr, nullptr, CR, in[I_SWOUT] + (size_t)j * DM * DM, DM, DM, DM, BC, DM);
            } else {
                gemm(stream, xc, DM, nullptr, nullptr, CR, in[I_NWIN] + (size_t)j * DM * NSA_COLS, NSA_COLS, NSA_COLS, DM, BA, NSA_COLS);
                hipLaunchKernelGGL(n_compress, dim3(NCMP, CB * NKV, 2), dim3(128), 0, stream, BA, in[I_NPEK] + j * CMP_BLOCK * HD, in[I_NPEV] + j * CMP_BLOCK * HD,
                                   in[I_NWK1] + (size_t)j * CMP_BLOCK * HD * PHI, in[I_NWK2] + j * PHI * HD, in[I_NWV1] + (size_t)j * CMP_BLOCK * HD * PHI, in[I_NWV2] + j * PHI * HD, nb.cmp);
                hipLaunchKernelGGL(n_nsa_attn, dim3(SEQ / 64, CB * NKV), dim3(256), 0, stream, BA, nb.cmp, BD);
                gemm(stream, BD, DM, nullptr, nullptr, CR, in[I_NWOUT] + (size_t)j * DM * DM, DM, DM, DM, BC, DM);
            }
            hipLaunchKernelGGL(n_ln_res, dim3(CR), dim3(256), 0, stream, xc, BC, in[I_LMG] + i * DM, in[I_LMB] + i * DM, xoc);
        } else {
            if (i % 2 == 0) {
                gemm(stream, xc, DM, nullptr, nullptr, CR, in[I_FWG] + (size_t)f * DM * DFF, DFF, DFF, DM, BA, DFF);
                gemm(stream, xc, DM, nullptr, nullptr, CR, in[I_FWU] + (size_t)f * DM * DFF, DFF, DFF, DM, BB, DFF);
                hipLaunchKernelGGL(n_swiglu, dim3((unsigned)(((size_t)CR * DFF + EW - 1) / EW)), dim3(EW), 0, stream, BA, BB, BA, (const int*)nullptr, CR, DFF);
                gemm(stream, BA, DFF, nullptr, nullptr, CR, in[I_FWD] + (size_t)f * DFF * DM, DM, DM, DFF, BC, DM);
            } else {
                (void)hipMemsetAsync(nb.cnt, 0, 256, stream);
                (void)hipMemsetAsync(BC, 0, (size_t)CR * DM * 4, stream);
                hipLaunchKernelGGL(n_router, dim3(CR / 4), dim3(256), 0, stream, xc, in[I_MWR] + (size_t)f * DM * NEXP, nb.cnt, nb.list, nb.tsel, nb.twt);
                for (int e = 0; e < NEXP; ++e) {
                    const size_t wo = ((size_t)f * NEXP + e) * DM * DFFE;
                    gemm(stream, xc, DM, nb.list + e * MOE_CAP, nb.cnt + e, MOE_CAP, in[I_MWG] + wo, DFFE, DFFE, DM, BA, DFFE);
                    gemm(stream, xc, DM, nb.list + e * MOE_CAP, nb.cnt + e, MOE_CAP, in[I_MWU] + wo, DFFE, DFFE, DM, BB, DFFE);
                    hipLaunchKernelGGL(n_swiglu, dim3((unsigned)(((size_t)MOE_CAP * DFFE + EW - 1) / EW)), dim3(EW), 0, stream, BA, BB, BA, (const int*)(nb.cnt + e), MOE_CAP, DFFE);
                    gemm(stream, BA, DFFE, nullptr, nb.cnt + e, MOE_CAP, in[I_MWD] + wo, DM, DM, DFFE, BD, DM);
                    hipLaunchKernelGGL(n_moe_scatter, dim3(MOE_CAP), dim3(256), 0, stream, BD, nb.cnt, nb.list, nb.tsel, nb.twt, e, BC);
                }
            }
            hipLaunchKernelGGL(n_ln_res, dim3(CR), dim3(256), 0, stream, xc, BC, in[I_LFG] + i * DM, in[I_LFB] + i * DM, xoc);
        }
    }
}

extern "C" void kernel_launch(void* const* d_in, const int* in_sizes, int n_in, void* d_out, int out_size, void* d_ws, size_t ws_size, hipStream_t stream) {
    (void)in_sizes; (void)out_size;
    static int grid = 0;
    if (grid == 0) {
        if (n_in != 29 || ws_size < WS_END) { fprintf(stderr, "kernel_launch: unexpected n_in %d / ws_size %zu (need %zu)\n", n_in, ws_size, (size_t)WS_END); grid = -1; return; }
        int dev = 0, cus = 0, per_cu = 0;
        if (hipGetDevice(&dev) != hipSuccess || hipDeviceGetAttribute(&cus, hipDeviceAttributeMultiprocessorCount, dev) != hipSuccess) { grid = -1; return; }
        if (hipFuncSetAttribute((const void*)mega, hipFuncAttributeMaxDynamicSharedMemorySize, LDS_BYTES) != hipSuccess) { fprintf(stderr, "kernel_launch: hipFuncSetAttribute failed\n"); grid = -1; return; }
        if (hipOccupancyMaxActiveBlocksPerMultiprocessor(&per_cu, (const void*)mega, NTHR, LDS_BYTES) != hipSuccess || per_cu < 1) { fprintf(stderr, "kernel_launch: occupancy query says %d\n", per_cu); }
        (void)hipGetLastError();
        grid = cus;
    }
    if (grid < 0) return;
    unsigned char* ws = (unsigned char*)d_ws;
    const float* in[29]; for (int i = 0; i < 29; ++i) in[i] = (const float*)d_in[i];
    auto run_fast = [&]() {
        (void)hipMemsetAsync(ws + WS_CTL, 0, CTL_ZERO_BYTES, stream);
        FArgs a{}; for (int i = 0; i < 29; ++i) a.in[i] = in[i];
        a.out = (float*)d_out; a.ws = ws;
        if (ONE_LAUNCH) { a.ph_lo = 0; a.ph_hi = FAST_END; hipLaunchKernelGGL(mega, dim3(grid), dim3(NTHR), LDS_BYTES, stream, a); }
        else for (int p = 0; p < FAST_END; ++p) { a.ph_lo = p; a.ph_hi = p + 1;
#ifdef REP_PHASE
            const int nrep = (p == REP_PHASE) ? 1 + REP_N : 1;
#else
            const int nrep = 1;
#endif
            for (int r = 0; r < nrep; ++r) { a.dbg = (r + 1 < nrep) ? 1 : 0; hipLaunchKernelGGL(mega, dim3(grid), dim3(NTHR), LDS_BYTES, stream, a); } }
    };
    NaiveBufs nb; unsigned char* nbase = ws + WS_ACT;
    nb.BA = (float*)nbase; nb.BB = (float*)(nbase + 96 * MiB); nb.BC = (float*)(nbase + 192 * MiB); nb.BD = (float*)(nbase + 224 * MiB);
    unsigned char* sm = nbase + 256 * MiB; nb.cnt = (int*)sm; nb.list = nb.cnt + 64; nb.tsel = nb.list + NEXP * MOE_CAP; nb.twt = (float*)(nb.tsel + (MTOK / 2) * 4); nb.cmp = (float*)(sm + 2 * MiB);
    float* X = (float*)(ws + WS_X);
#if DEBUG_MODE
    static_assert(FAST_PREFIX >= 1 && FAST_PREFIX <= 6 && !ONE_LAUNCH, "debug builds compare a fast prefix that leaves its result in X");
    float* XF1 = (float*)(ws + W_MOE_GU + 112 * MiB);
    float* acc2 = (float*)(sm + 1 * MiB);
    run_fast();
    (void)hipMemcpyAsync(XF1, X, (size_t)MTOK * DM * 4, hipMemcpyDeviceToDevice, stream);
    (void)hipMemsetAsync(acc2, 0, 64, stream);
    if (DEBUG_MODE == 2) { run_fast(); hipLaunchKernelGGL(dbg_sqdiff, dim3(2048), dim3(256), 0, stream, (const float*)X, (const float*)XF1, (size_t)MTOK * DM, acc2); }
    { const float* x = in[I_X];
      for (int s = 0; s < 8; ++s) { float* xo = (s == 7) ? (float*)d_out : X; naive_sublayer(stream, in, s, x, xo, nb); x = xo;
          if (DEBUG_MODE == 1 && s == FAST_PREFIX - 1) hipLaunchKernelGGL(dbg_sqdiff, dim3(2048), dim3(256), 0, stream, (const float*)XF1, (const float*)X, (size_t)MTOK * DM, acc2); } }
    hipLaunchKernelGGL(dbg_scale, dim3(2048), dim3(256), 0, stream, (float*)d_out, (size_t)MTOK * DM, (const float*)acc2);
#else
    if (FAST_END > 0) run_fast();
    if (FAST_PREFIX < 8) {
        const float* x = FAST_PREFIX == 0 ? in[I_X] : (const float*)X;
        for (int s = FAST_PREFIX; s < 8; ++s) { float* xo = (s == 7) ? (float*)d_out : X; naive_sublayer(stream, in, s, x, xo, nb); x = xo; }
    }
#endif
}
```
